# Optimizing an MI355X kernel written in HIP

```python
import math
import jax
import jax.numpy as jnp
from jax import lax
import numpy as np

D_MODEL = 2048
BATCH = 2
SEQ = 4096
DEPTH = 4

GRID_W = 64
CTX_LEN = 256
N_MOD = 9
FFN_RES = 0.5
D_FF = 5632
RMS_EPS = 1e-6
LN_EPS = 1e-5

D_MIX = D_MODEL
GROUP_W = D_MIX // 4

N_HEADS = 8
N_KV_HEADS = 2
HEAD_DIM = GROUP_W // N_HEADS
WINDOW = 128
BLOCK = 128
ROPE_BASE = 10000.0
NEG_INF = -1e30

SSM_H = 16
SSM_G = GROUP_W // SSM_H
SSM_P = 64
DT_MIN = 1e-3
DT_MAX = 1e-1
LAMBDA_RE_MAX = -1e-4

CONV_K = 31

FFT_HEADS = 4

KV_W = N_KV_HEADS * HEAD_DIM
K_OFF = 0
V_OFF = K_OFF + KV_W
SSM_OFF = V_OFF + KV_W
Q_OFF = SSM_OFF + GROUP_W
CONV_OFF = Q_OFF + GROUP_W
FFT_OFF = CONV_OFF + 2 * GROUP_W
D_IN = FFT_OFF + GROUP_W
CTX_COLS = Q_OFF

kernel_name = 'hybrid_parallel_group_diffusion_block'


def _rms_norm(x, g):
    xf = x.astype(jnp.float32)
    y = xf * lax.rsqrt(jnp.mean(xf * xf, axis=-1, keepdims=True) + RMS_EPS)
    return (y * g.astype(jnp.float32)).astype(x.dtype)


def _layer_norm(x, g, b):
    xf = x.astype(jnp.float32)
    mu = jnp.mean(xf, axis=-1, keepdims=True)
    var = jnp.mean(jnp.square(xf - mu), axis=-1, keepdims=True)
    y = (xf - mu) * lax.rsqrt(var + LN_EPS)
    return (y * g.astype(jnp.float32) + b.astype(jnp.float32)).astype(x.dtype)


def _swiglu(h, wi, wo):
    gt, up = jnp.split(h @ wi, 2, axis=-1)
    return (jax.nn.silu(gt) * up) @ wo


def _ffn_sublayer(s, mod, k, g_pre, g_post, wi, wo):
    shift, scale, gate = mod[3 * k], mod[3 * k + 1], mod[3 * k + 2]
    h = _rms_norm(s, g_pre) * (1 + scale) + shift
    return s + FFN_RES * gate * _rms_norm(_swiglu(h, wi, wo), g_post)


def _rope_1d(x, pos):
    half = x.shape[-1] // 2
    inv = ROPE_BASE ** (-jnp.arange(half, dtype=jnp.float32) / half)
    ang = pos.astype(jnp.float32)[:, None] * inv[None, :]
    cos = jnp.cos(ang)[:, None, :]
    sin = jnp.sin(ang)[:, None, :]
    xf = x.astype(jnp.float32)
    x1, x2 = xf[..., :half], xf[..., half:]
    return jnp.concatenate([x1 * cos - x2 * sin, x2 * cos + x1 * sin], axis=-1).astype(x.dtype)


def _axial_rope(x, row, col):
    r = x.shape[-1] // 2
    return jnp.concatenate([_rope_1d(x[..., :r], row), _rope_1d(x[..., r:], col)], axis=-1)


def _window_attention(q, k, v, kc, vc, sink):
    bsz, L = q.shape[0], q.shape[1]
    C = kc.shape[1]
    nb = L // BLOCK
    grp = N_HEADS // N_KV_HEADS
    scale = HEAD_DIM ** -0.5
    qb = q.reshape(bsz, nb, BLOCK, N_KV_HEADS, grp, HEAD_DIM)

    def band(t):
        tp = jnp.pad(t, ((0, 0), (BLOCK, BLOCK), (0, 0), (0, 0)))
        tp = tp.reshape(bsz, nb + 2, BLOCK, N_KV_HEADS, HEAD_DIM)
        return jnp.concatenate([tp[:, :-2], tp[:, 1:-1], tp[:, 2:]], axis=2)

    kb, vb = band(k), band(v)
    s_loc = jnp.einsum('bnqkgd,bnskd->bnkgqs', qb, kb, preferred_element_type=jnp.float32) * scale
    qpos = jnp.arange(nb)[:, None, None] * BLOCK + jnp.arange(BLOCK)[None, :, None]
    kpos = jnp.arange(nb)[:, None, None] * BLOCK - BLOCK + jnp.arange(3 * BLOCK)[None, None, :]
    valid = (jnp.abs(qpos - kpos) <= WINDOW) & (kpos >= 0) & (kpos < L)
    s_loc = jnp.where(valid[None, :, None, None], s_loc, NEG_INF)
    s_ctx = jnp.einsum('bnqkgd,bckd->bnkgqc', qb, kc, preferred_element_type=jnp.float32) * scale
    s_sink = jnp.broadcast_to(
        sink.astype(jnp.float32).reshape(N_KV_HEADS, grp)[None, None, :, :, None, None],
        s_loc.shape[:-1] + (1,))
    p = jax.nn.softmax(jnp.concatenate([s_loc, s_ctx, s_sink], axis=-1), axis=-1)
    n_loc = 3 * BLOCK
    p_loc = p[..., :n_loc].astype(vb.dtype)
    p_ctx = p[..., n_loc:n_loc + C].astype(vc.dtype)
    o = (jnp.einsum('bnkgqs,bnskd->bnqkgd', p_loc, vb)
         + jnp.einsum('bnkgqc,bckd->bnqkgd', p_ctx, vc))
    return o.reshape(bsz, L, N_HEADS * HEAD_DIM)


def _ctx_attention(qc, kc, vc, sink):
    bsz, C = qc.shape[0], qc.shape[1]
    grp = N_HEADS // N_KV_HEADS
    qg = qc.reshape(bsz, C, N_KV_HEADS, grp, HEAD_DIM)
    s = jnp.einsum('bqkgd,bskd->bkgqs', qg, kc, preferred_element_type=jnp.float32) * HEAD_DIM ** -0.5
    s_sink = jnp.broadcast_to(
        sink.astype(jnp.float32).reshape(N_KV_HEADS, grp)[None, :, :, None, None], s.shape[:-1] + (1,))
    p = jax.nn.softmax(jnp.concatenate([s, s_sink], axis=-1), axis=-1)[..., :C].astype(vc.dtype)
    o = jnp.einsum('bkgqs,bskd->bqkgd', p, vc)
    return o.reshape(bsz, C, N_HEADS * HEAD_DIM)


def _ssm_discretize(lam_re, lam_im, log_dt, b_re, b_im):
    lr = jnp.minimum(lam_re.astype(jnp.float32), LAMBDA_RE_MAX)
    li = lam_im.astype(jnp.float32)
    dt = jnp.exp(log_dt.astype(jnp.float32))[:, None]
    mag = jnp.exp(lr * dt)
    a_re = mag * jnp.cos(li * dt)
    a_im = mag * jnp.sin(li * dt)
    den = lr * lr + li * li
    nr = a_re - 1.0
    coef_re = ((nr * lr + a_im * li) / den)[..., None]
    coef_im = ((a_im * lr - nr * li) / den)[..., None]
    br = b_re.astype(jnp.float32)
    bi = b_im.astype(jnp.float32)
    return a_re, a_im, coef_re * br - coef_im * bi, coef_re * bi + coef_im * br


def _scan_combine(e1, e2):
    a1r, a1i, b1r, b1i = e1
    a2r, a2i, b2r, b2i = e2
    return (a2r * a1r - a2i * a1i, a2r * a1i + a2i * a1r,
            a2r * b1r - a2i * b1i + b2r, a2r * b1i + a2i * b1r + b2i)


def _complex_scan(a_re, a_im, bu_re, bu_im, h0_re, h0_im, reverse):
    if h0_re is not None:
        first = -1 if reverse else 0
        bu_re = bu_re.at[:, first].add(a_re * h0_re - a_im * h0_im)
        bu_im = bu_im.at[:, first].add(a_re * h0_im + a_im * h0_re)
    ar = jnp.broadcast_to(a_re, bu_re.shape)
    ai = jnp.broadcast_to(a_im, bu_im.shape)
    _, _, h_re, h_im = lax.associative_scan(_scan_combine, (ar, ai, bu_re, bu_im), reverse=reverse, axis=1)
    return h_re, h_im


def _ssm_drive(u, bb_re, bb_im):
    return jnp.einsum('blgh,gph->blgp', u, bb_re), jnp.einsum('blgh,gph->blgp', u, bb_im)


def _ssm_readout(h_re, h_im, c_re, c_im):
    return jnp.einsum('blgp,ghp->blgh', h_re, c_re) - jnp.einsum('blgp,ghp->blgh', h_im, c_im)


def _ssm_glu(y, w, b):
    y = jax.nn.gelu(y)
    return y * jax.nn.sigmoid(y @ w.astype(jnp.float32) + b.astype(jnp.float32))


def _ssm_branch(u, uc, need_ctx, lam_re, lam_im, log_dt, b_re, b_im, c_re, c_im, d_skip, glu_w, glu_b):
    bsz, L = u.shape[0], u.shape[1]
    C = uc.shape[1]
    ul = u.astype(jnp.float32).reshape(bsz, L, SSM_G, SSM_H)
    ucg = uc.astype(jnp.float32).reshape(bsz, C, SSM_G, SSM_H)
    dsk = d_skip.astype(jnp.float32).reshape(SSM_G, SSM_H)
    y_l = dsk * ul
    y_c = dsk * ucg if need_ctx else None
    for dr, reverse in enumerate((False, True)):
        a_re, a_im, bb_re, bb_im = _ssm_discretize(lam_re[dr], lam_im[dr], log_dt[dr], b_re[dr], b_im[dr])
        cr = c_re[dr].astype(jnp.float32)
        ci = c_im[dr].astype(jnp.float32)
        bc_re, bc_im = _ssm_drive(ucg, bb_re, bb_im)
        hc_re, hc_im = _complex_scan(a_re, a_im, bc_re, bc_im, None, None, reverse)
        fin = 0 if reverse else -1
        bl_re, bl_im = _ssm_drive(ul, bb_re, bb_im)
        hl_re, hl_im = _complex_scan(a_re, a_im, bl_re, bl_im, hc_re[:, fin], hc_im[:, fin], reverse)
        y_l = y_l + _ssm_readout(hl_re, hl_im, cr, ci)
        if need_ctx:
            y_c = y_c + _ssm_readout(hc_re, hc_im, cr, ci)
    out_l = _ssm_glu(y_l.reshape(bsz, L, GROUP_W), glu_w, glu_b).astype(u.dtype)
    out_c = _ssm_glu(y_c.reshape(bsz, C, GROUP_W), glu_w, glu_b).astype(uc.dtype) if need_ctx else None
    return out_l, out_c


def _conv_branch(p, conv_w, conv_b, ln_g, ln_b):
    val, gt = jnp.split(p, 2, axis=-1)
    h = val * jax.nn.sigmoid(gt)
    h = lax.conv_general_dilated(
        h, conv_w.astype(h.dtype)[:, None, :], window_strides=(1,),
        padding=[(CONV_K // 2, CONV_K // 2)], dimension_numbers=('NWC', 'WIO', 'NWC'),
        feature_group_count=GROUP_W) + conv_b
    return jax.nn.silu(_layer_norm(h, ln_g, ln_b))


def _fourier_branch(p):
    bsz, L = p.shape[0], p.shape[1]
    f = p.astype(jnp.float32).reshape(bsz, L, FFT_HEADS, GROUP_W // FFT_HEADS)
    f = jnp.fft.fft2(f, axes=(1, 3), norm='ortho').real
    return f.reshape(bsz, L, GROUP_W).astype(p.dtype)


def _mixer(h, hc, row, col, need_ctx, w_in, w_out, sink, lam_re, lam_im, log_dt, b_re, b_im,
           c_re, c_im, d_skip, glu_w, glu_b, conv_w, conv_b, ln_g, ln_b):
    bsz, L = h.shape[0], h.shape[1]
    C = hc.shape[1]
    p = h @ w_in
    pc = hc @ (w_in if need_ctx else w_in[:, :CTX_COLS])
    q = _axial_rope(p[..., Q_OFF:CONV_OFF].reshape(bsz, L, N_HEADS, HEAD_DIM), row, col)
    k = _axial_rope(p[..., K_OFF:V_OFF].reshape(bsz, L, N_KV_HEADS, HEAD_DIM), row, col)
    v = p[..., V_OFF:SSM_OFF].reshape(bsz, L, N_KV_HEADS, HEAD_DIM)
    kc = pc[..., K_OFF:V_OFF].reshape(bsz, C, N_KV_HEADS, HEAD_DIM)
    vc = pc[..., V_OFF:SSM_OFF].reshape(bsz, C, N_KV_HEADS, HEAD_DIM)
    att = _window_attention(q, k, v, kc, vc, sink)
    ssm_l, ssm_c = _ssm_branch(p[..., SSM_OFF:Q_OFF], pc[..., SSM_OFF:Q_OFF], need_ctx, lam_re, lam_im,
                               log_dt, b_re, b_im, c_re, c_im, d_skip, glu_w, glu_b)
    conv_l = _conv_branch(p[..., CONV_OFF:FFT_OFF], conv_w, conv_b, ln_g, ln_b)
    fft_l = _fourier_branch(p[..., FFT_OFF:D_IN])
    out = jnp.concatenate([att, ssm_l, conv_l, fft_l], axis=-1) @ w_out
    if not need_ctx:
        return out, None
    qc = pc[..., Q_OFF:CONV_OFF].reshape(bsz, C, N_HEADS, HEAD_DIM)
    att_c = _ctx_attention(qc, kc, vc, sink)
    conv_c = _conv_branch(pc[..., CONV_OFF:FFT_OFF], conv_w, conv_b, ln_g, ln_b)
    fft_c = _fourier_branch(pc[..., FFT_OFF:D_IN])
    out_c = jnp.concatenate([att_c, ssm_c, conv_c, fft_c], axis=-1) @ w_out
    return out, out_c


def setup_inputs(seed: int = 0) -> dict:
    key = jax.random.key(seed)
    ks = jax.random.split(key, 26)
    f32 = jnp.float32
    D = D_MODEL

    def nrm(k, shape, s):
        return s * jax.random.normal(k, shape, f32)

    ssm_shape = (DEPTH, 2, SSM_G, SSM_P)
    lam_im0 = math.pi * jnp.arange(SSM_P, dtype=f32)
    return {
        'x': nrm(ks[0], (BATCH, SEQ, D), 1.0),
        'c': nrm(ks[1], (BATCH, D), 1.0),
        'ctx': nrm(ks[2], (BATCH, CTX_LEN, D), 1.0),
        'c_ctx': nrm(ks[3], (D,), 1.0),
        'w_mod': nrm(ks[4], (DEPTH, D, N_MOD * D), 0.5 * D ** -0.5),
        'b_mod': nrm(ks[5], (DEPTH, N_MOD * D), 0.02),
        'norm_g': 1.0 + nrm(ks[6], (DEPTH, 6, D), 0.05),
        'ffn_wi': nrm(ks[7], (DEPTH, 2, D, 2 * D_FF), D ** -0.5),
        'ffn_wo': nrm(ks[8], (DEPTH, 2, D_FF, D), D_FF ** -0.5),
        'w_in': nrm(ks[9], (DEPTH, D, D_IN), D ** -0.5),
        'w_out': nrm(ks[10], (DEPTH, D_MIX, D), D_MIX ** -0.5),
        'attn_sink': nrm(ks[11], (DEPTH, N_HEADS), 0.5),
        'ssm_lam_re': -0.5 + nrm(ks[12], ssm_shape, 0.01),
        'ssm_lam_im': lam_im0 + nrm(ks[13], ssm_shape, 0.01),
        'ssm_log_dt': jax.random.uniform(ks[14], (DEPTH, 2, SSM_G), f32, math.log(DT_MIN), math.log(DT_MAX)),
        'ssm_b_re': nrm(ks[15], (DEPTH, 2, SSM_G, SSM_P, SSM_H), (2 * SSM_H) ** -0.5),
        'ssm_b_im': nrm(ks[16], (DEPTH, 2, SSM_G, SSM_P, SSM_H), (2 * SSM_H) ** -0.5),
        'ssm_c_re': nrm(ks[17], (DEPTH, 2, SSM_G, SSM_H, SSM_P), 0.5 ** 0.5),
        'ssm_c_im': nrm(ks[18], (DEPTH, 2, SSM_G, SSM_H, SSM_P), 0.5 ** 0.5),
        'ssm_d': nrm(ks[19], (DEPTH, GROUP_W), 1.0),
        'ssm_glu_w': nrm(ks[20], (DEPTH, GROUP_W, GROUP_W), GROUP_W ** -0.5),
        'ssm_glu_b': nrm(ks[21], (DEPTH, GROUP_W), 0.02),
        'conv_w': nrm(ks[22], (DEPTH, CONV_K, GROUP_W), CONV_K ** -0.5),
        'conv_b': nrm(ks[23], (DEPTH, GROUP_W), 0.02),
        'conv_ln_g': 1.0 + nrm(ks[24], (DEPTH, GROUP_W), 0.05),
        'conv_ln_b': nrm(ks[25], (DEPTH, GROUP_W), 0.02),
    }


def reference(x, c, ctx, c_ctx, w_mod, b_mod, norm_g, ffn_wi, ffn_wo, w_in, w_out, attn_sink,
              ssm_lam_re, ssm_lam_im, ssm_log_dt, ssm_b_re, ssm_b_im, ssm_c_re, ssm_c_im, ssm_d,
              ssm_glu_w, ssm_glu_b, conv_w, conv_b, conv_ln_g, conv_ln_b):
    bsz, L = x.shape[0], x.shape[1]
    rows = L // GRID_W
    row = jnp.repeat(jnp.arange(rows), GRID_W)
    col = jnp.tile(jnp.arange(GRID_W), rows)
    sc = jax.nn.silu(c)
    scc = jax.nn.silu(c_ctx)
    for l in range(DEPTH):
        need_ctx = l < DEPTH - 1
        g = norm_g[l]
        m = (sc @ w_mod[l] + b_mod[l]).reshape(bsz, N_MOD, D_MODEL).transpose(1, 0, 2)[:, :, None, :]
        mc = (scc @ w_mod[l] + b_mod[l]).reshape(N_MOD, D_MODEL)[:, None, None, :]
        x = _ffn_sublayer(x, m, 0, g[0], g[1], ffn_wi[l, 0], ffn_wo[l, 0])
        ctx = _ffn_sublayer(ctx, mc, 0, g[0], g[1], ffn_wi[l, 0], ffn_wo[l, 0])
        h = _rms_norm(x, g[2]) * (1 + m[4]) + m[3]
        hc = _rms_norm(ctx, g[2]) * (1 + mc[4]) + mc[3]
        out, out_c = _mixer(h, hc, row, col, need_ctx, w_in[l], w_out[l], attn_sink[l],
                            ssm_lam_re[l], ssm_lam_im[l], ssm_log_dt[l], ssm_b_re[l], ssm_b_im[l],
                            ssm_c_re[l], ssm_c_im[l], ssm_d[l], ssm_glu_w[l], ssm_glu_b[l],
                            conv_w[l], conv_b[l], conv_ln_g[l], conv_ln_b[l])
        x = x + m[5] * _rms_norm(out, g[3])
        x = _ffn_sublayer(x, m, 2, g[4], g[5], ffn_wi[l, 1], ffn_wo[l, 1])
        if need_ctx:
            ctx = ctx + mc[5] * _rms_norm(out_c, g[3])
            ctx = _ffn_sublayer(ctx, mc, 2, g[4], g[5], ffn_wi[l, 1], ffn_wo[l, 1])
    return x
```

```cpp
#include <hip/hip_runtime.h>
#include <cstdio>
#include <cstdint>
namespace pg8 {
#define PG8_LAS __attribute__((address_space(3)))
typedef unsigned short bf16_t;
typedef short bf16x8 __attribute__((ext_vector_type(8)));
typedef float f32x4 __attribute__((ext_vector_type(4)));
typedef unsigned u32x4 __attribute__((ext_vector_type(4)));
constexpr int BM = 256, BK = 64, HALF = 128, HTB = HALF * BK * 2  , STAGE_BYTES = 8 * HTB, NXCD = 8, WGM = 8;

__host__ __device__ __forceinline__ int lds_byte(int r, int c) { const int st = (r >> 4) * 2 + (c >> 5), rr = r & 15, cc = c & 31, ob = rr * 64 + cc * 2; return st * 1024 + (ob ^ (((ob >> 9) & 1) << 5)); }
__host__ __device__ __forceinline__ void stage_rc(int b, int& R, int& C) { const int st = b / 1024, sb = b % 1024, swz = sb ^ (((sb >> 9) & 1) << 5); R = (st >> 1) * 16 + swz / 64; C = (st & 1) * 32 + (swz % 64) / 2; }
__host__ __device__ __forceinline__ int perm32(int rho) { const int n = rho >> 4, i = rho & 15; return 8 * (i >> 2) + 4 * n + (i & 3); }

struct Unit { int pm, pn, k0, nt, ks; };
struct Gemm { const bf16_t* A; const bf16_t* Bt; int M, N, K; };

struct StaticOrder {
    int nM, nN, nwg, G, c, ntf;
    __host__ __device__ void init(int M, int N, int K, int G_, int c_) { nM = M / BM; nN = N / BM; nwg = nM * nN; G = G_; c = c_; ntf = K / BK; }
    __host__ __device__ __forceinline__ bool next(int i, Unit& u) const {
        const long L = (long)i * G + c; if (L >= nwg) return false;
        int wgid = (int)L; { const int q = nwg / NXCD, r = nwg % NXCD, xcd = wgid % NXCD, off = wgid / NXCD; wgid = (xcd < r ? xcd * (q + 1) : r * (q + 1) + (xcd - r) * q) + off; }
        const int nig = WGM * nN, gid = wgid / nig, fm = gid * WGM, gsz = (nM - fm) < WGM ? (nM - fm) : WGM;
        u.pm = fm + ((wgid % nig) % gsz); u.pn = (wgid % nig) / gsz; u.k0 = 0; u.nt = ntf; u.ks = 0; return true;
    }
    __device__ __forceinline__ void a_ready(const Unit&) const {}
    __device__ __forceinline__ void done(const Unit&) const {}
};

template <int M_, int N_, int K_> struct StaticOrderT {
    int G, c;
    __host__ __device__ void init(int G_, int c_) { G = G_; c = c_; }
    __host__ __device__ __forceinline__ bool next(int i, Unit& u) const {
        constexpr int nM = M_ / BM, nN = N_ / BM, nwg = nM * nN;
        const long L = (long)i * G + c; if (L >= nwg) return false;
        int wgid = (int)L; { constexpr int q = nwg / NXCD, r = nwg % NXCD; const int xcd = wgid % NXCD, off = wgid / NXCD; wgid = (xcd < r ? xcd * (q + 1) : r * (q + 1) + (xcd - r) * q) + off; }
        constexpr int nig = WGM * nN; const int gid = wgid / nig, fm = gid * WGM, gsz = (nM - fm) < WGM ? (nM - fm) : WGM;
        u.pm = fm + ((wgid % nig) % gsz); u.pn = (wgid % nig) / gsz; u.k0 = 0; u.nt = K_ / BK; u.ks = 0; return true;
    }
    __device__ __forceinline__ void a_ready(const Unit&) const {}
    __device__ __forceinline__ void done(const Unit&) const {}
};
template <int K_, int NS> struct SplitTailOrder {
    int G, c;
    __host__ __device__ void init(int G_, int c_) { G = G_; c = c_; }
    __host__ __device__ __forceinline__ bool next(int i, Unit& u) const {
        constexpr int ntsub = K_ / BK / NS, nN = 8, nwg = 256, nig = WGM * nN;
        const int L = i * G + c;
        if (L >= 256 + 16 * NS) return false;
        const bool tail = L >= 256;
        const int Lc = tail ? 0 : L; const int wgid = (Lc % NXCD) * (nwg / NXCD) + Lc / NXCD;
        const int gid = wgid / nig, fm = gid * WGM; const int pm0 = fm + ((wgid % nig) % WGM), pn0 = (wgid % nig) / WGM;
        const int j = tail ? L - 256 : 0, tile = j / NS, ks = j % NS;
        u.pm = tail ? 32 + tile / 8 : pm0; u.pn = tail ? tile % 8 : pn0; u.ks = tail ? ks : 0; u.nt = tail ? ntsub : K_ / BK; u.k0 = tail ? ks * ntsub * BK : 0;
        return true;
    }
    __device__ __forceinline__ void a_ready(const Unit&) const {}
    __device__ __forceinline__ void done(const Unit&) const {}
};

__device__ __forceinline__ unsigned cvt_pk_bf16(float lo, float hi) { unsigned r; asm volatile("v_cvt_pk_bf16_f32 %0, %1, %2" : "=v"(r) : "v"(lo), "v"(hi)); return r; }
typedef float f32x2 __attribute__((ext_vector_type(2)));
__device__ __forceinline__ f32x2 gelu_pk(f32x2 v) {
    const f32x2 av = __builtin_elementwise_abs(v), d = av * 0.2316418882f + 1.0f;
    f32x2 t; t.x = __builtin_amdgcn_rcpf(d.x); t.y = __builtin_amdgcn_rcpf(d.y);
    f32x2 q = t * 0.5307027145f + (-0.7265760135f); q = q * t + 0.7107068705f; q = q * t + (-0.142248368f); q = q * t + 0.127414796f; q = q * t;
    const f32x2 s = (v * v) * (-0.72134752044f);
    f32x2 e; e.x = __builtin_amdgcn_exp2f(s.x); e.y = __builtin_amdgcn_exp2f(s.y);
    const f32x2 m = v * (q * e), r = v - m;
    f32x2 o; o.x = v.x < 0.f ? m.x : r.x; o.y = v.y < 0.f ? m.y : r.y; return o;
}

template <int ACT  > struct EpiBf16 {
    static constexpr bool PERM = true, AFTER_DRAIN = false; static_assert(ACT == 0 || ACT == 1, "EpiBf16: ACT is 0 (none) or 1 (gelu_pk)");
    bf16_t* O; int ldc; const float* bias; int split_cols; size_t split_stride; float scale0;
    __device__ __forceinline__ void operator()(const f32x4 (&acc)[2][2][4][2], const Unit& u, int wr, int wc, int fr, int fq) const {
        const int row0 = u.pm * BM + wr * 64 + fr; int colt = u.pn * BM; bf16_t* base = O;
        float sc = 1.f; if (split_cols) { const int t = colt / split_cols; base += (size_t)t * split_stride; colt -= t * split_cols; if (t == 0) sc = scale0; }
        const int col0 = colt + wc * 32 + 8 * fq, bcol0 = u.pn * BM + wc * 32 + 8 * fq;
        f32x4 bv[2][2];
#pragma unroll
        for (int bj = 0; bj < 2; ++bj)
#pragma unroll
            for (int n = 0; n < 2; ++n) bv[bj][n] = bias ? *(const f32x4*)(bias + bcol0 + bj * HALF + 4 * n) : (f32x4){0.f, 0.f, 0.f, 0.f};
#pragma unroll
        for (int ai = 0; ai < 2; ++ai)
#pragma unroll
            for (int m = 0; m < 4; ++m) { bf16_t* rowp = base + (size_t)(row0 + ai * HALF + m * 16) * ldc + col0;
#pragma unroll
                for (int bj = 0; bj < 2; ++bj) { f32x4 v0 = acc[ai][bj][m][0] + bv[bj][0], v1 = acc[ai][bj][m][1] + bv[bj][1];
                    if (ACT == 1) { f32x2 a = gelu_pk((f32x2){v0[0], v0[1]}), b = gelu_pk((f32x2){v0[2], v0[3]}), c = gelu_pk((f32x2){v1[0], v1[1]}), d = gelu_pk((f32x2){v1[2], v1[3]});
                        v0 = (f32x4){a.x, a.y, b.x, b.y}; v1 = (f32x4){c.x, c.y, d.x, d.y}; }
                    v0 = v0 * sc; v1 = v1 * sc; u32x4 w; w.x = cvt_pk_bf16(v0[0], v0[1]); w.y = cvt_pk_bf16(v0[2], v0[3]); w.z = cvt_pk_bf16(v1[0], v1[1]); w.w = cvt_pk_bf16(v1[2], v1[3]);
                    *(u32x4*)(rowp + bj * HALF) = w; } }
    }
};
struct EpiF32 {
    static constexpr bool PERM = false, AFTER_DRAIN = false;
    float* C; int ldc; const float* bias;
    __device__ __forceinline__ void operator()(const f32x4 (&acc)[2][2][4][2], const Unit& u, int wr, int wc, int fr, int fq) const {
        const int row0 = u.pm * BM + wr * 64 + fr, col0 = u.pn * BM + wc * 32 + 4 * fq;
        f32x4 bv[2][2];
#pragma unroll
        for (int bj = 0; bj < 2; ++bj)
#pragma unroll
            for (int n = 0; n < 2; ++n) bv[bj][n] = bias ? *(const f32x4*)(bias + col0 + bj * HALF + n * 16) : (f32x4){0.f, 0.f, 0.f, 0.f};
#pragma unroll
        for (int ai = 0; ai < 2; ++ai)
#pragma unroll
            for (int m = 0; m < 4; ++m) { float* rowp = C + (size_t)(row0 + ai * HALF + m * 16) * ldc + col0;
#pragma unroll
                for (int bj = 0; bj < 2; ++bj)
#pragma unroll
                    for (int n = 0; n < 2; ++n) *(f32x4*)(rowp + bj * HALF + n * 16) = acc[ai][bj][m][n] + bv[bj][n]; }
    }
};
__device__ __forceinline__ void store16_wt(void* p, u32x4 v) { asm volatile("global_store_dwordx4 %0, %1, off sc1\n\ts_nop 1" :: "v"(p), "v"(v) : "memory");     }
#ifndef NT_ACT
#define NT_ACT 0
#endif
struct EpiSwiglu {
    static constexpr bool PERM = true, AFTER_DRAIN = false;
    bf16_t* O; int ldc; int skip;
    __device__ __forceinline__ void operator()(const f32x4 (&acc)[2][2][4][2], const Unit& u, int wr, int wc, int fr, int fq) const {
        if (skip) return;
        const int row0 = u.pm * BM + wr * 64 + fr, col0 = u.pn * HALF + wc * 32 + 8 * fq;
#pragma unroll
        for (int ai = 0; ai < 2; ++ai)
#pragma unroll
            for (int m = 0; m < 4; ++m) { bf16_t* rowp = O + (size_t)(row0 + ai * HALF + m * 16) * ldc + col0;
                float v[8];
#pragma unroll
                for (int n = 0; n < 2; ++n)
#pragma unroll
                    for (int j = 0; j < 4; ++j) { const float g = acc[ai][0][m][n][j], up = acc[ai][1][m][n][j];
                        v[n * 4 + j] = g * __builtin_amdgcn_rcpf(1.0f + __expf(-g)) * up; }
                u32x4 w; w.x = cvt_pk_bf16(v[0], v[1]); w.y = cvt_pk_bf16(v[2], v[3]); w.z = cvt_pk_bf16(v[4], v[5]); w.w = cvt_pk_bf16(v[6], v[7]);
                if (NT_ACT) __builtin_nontemporal_store(w, (u32x4*)rowp); else *(u32x4*)rowp = w; }
    }
};
struct EpiGlu {
    static constexpr bool PERM = true, AFTER_DRAIN = false;
    const bf16_t* YG; int ldy; bf16_t* O; int ldc; const float* bias;
    __device__ __forceinline__ void operator()(const f32x4 (&acc)[2][2][4][2], const Unit& u, int wr, int wc, int fr, int fq) const {
        const int row0 = u.pm * BM + wr * 64 + fr, col0 = u.pn * BM + wc * 32 + 8 * fq;
#pragma unroll
        for (int ai = 0; ai < 2; ++ai)
#pragma unroll
            for (int m = 0; m < 4; ++m) { const int row = row0 + ai * HALF + m * 16;
#pragma unroll
                for (int bj = 0; bj < 2; ++bj) { const int c = col0 + bj * HALF;
                    const u32x4 y = *(const u32x4*)(YG + (size_t)row * ldy + c);
                    const f32x4 b0 = *(const f32x4*)(bias + c), b1 = *(const f32x4*)(bias + c + 4);
                    const f32x4 z0 = acc[ai][bj][m][0] + b0, z1 = acc[ai][bj][m][1] + b1;
                    float v[8];
                    v[0] = __builtin_bit_cast(float, y.x << 16); v[1] = __builtin_bit_cast(float, y.x & 0xffff0000u); v[2] = __builtin_bit_cast(float, y.y << 16); v[3] = __builtin_bit_cast(float, y.y & 0xffff0000u);
                    v[4] = __builtin_bit_cast(float, y.z << 16); v[5] = __builtin_bit_cast(float, y.z & 0xffff0000u); v[6] = __builtin_bit_cast(float, y.w << 16); v[7] = __builtin_bit_cast(float, y.w & 0xffff0000u);
#pragma unroll
                    for (int j = 0; j < 4; ++j) { v[j] *= __builtin_amdgcn_rcpf(1.0f + __expf(-z0[j])); v[4 + j] *= __builtin_amdgcn_rcpf(1.0f + __expf(-z1[j])); }
                    u32x4 w; w.x = cvt_pk_bf16(v[0], v[1]); w.y = cvt_pk_bf16(v[2], v[3]); w.z = cvt_pk_bf16(v[4], v[5]); w.w = cvt_pk_bf16(v[6], v[7]);
                    *(u32x4*)(O + (size_t)row * ldc + c) = w; } }
    }
};
#ifndef NT_Y
#define NT_Y 0
#endif
struct EpiYSplit {
    static constexpr bool PERM = true, AFTER_DRAIN = false;
    bf16_t* C; float* CP; int ldc;
    __device__ __forceinline__ void operator()(const f32x4 (&acc)[2][2][4][2], const Unit& u, int wr, int wc, int fr, int fq) const {
        const int row0 = u.pm * BM + wr * 64 + fr, col0 = u.pn * BM + wc * 32 + 8 * fq;
        if (u.pm < 32) {
#pragma unroll
            for (int ai = 0; ai < 2; ++ai)
#pragma unroll
                for (int m = 0; m < 4; ++m) { bf16_t* rowp = C + (size_t)(row0 + ai * HALF + m * 16) * ldc + col0;
#pragma unroll
                    for (int bj = 0; bj < 2; ++bj) { const f32x4 v0 = acc[ai][bj][m][0], v1 = acc[ai][bj][m][1];
                        u32x4 w; w.x = cvt_pk_bf16(v0[0], v0[1]); w.y = cvt_pk_bf16(v0[2], v0[3]); w.z = cvt_pk_bf16(v1[0], v1[1]); w.w = cvt_pk_bf16(v1[2], v1[3]);
                        if (NT_Y) __builtin_nontemporal_store(w, (u32x4*)(rowp + bj * HALF)); else *(u32x4*)(rowp + bj * HALF) = w; } }
        } else {
            float* base = CP + ((size_t)u.ks * 512 + (row0 - 8192)) * ldc + col0;
#pragma unroll
            for (int ai = 0; ai < 2; ++ai)
#pragma unroll
                for (int m = 0; m < 4; ++m) { float* rowp = base + (size_t)(ai * HALF + m * 16) * ldc;
#pragma unroll
                    for (int bj = 0; bj < 2; ++bj) { *(f32x4*)(rowp + bj * HALF) = acc[ai][bj][m][0]; *(f32x4*)(rowp + bj * HALF + 4) = acc[ai][bj][m][1]; } }
        }
    }
};

template <class Epi, class Sched, bool ALIGN_EPI = false, bool SP2 = false, int KP = 0>
__device__ __forceinline__ void gemm_phase(PG8_LAS unsigned char* lds, const Gemm g, const Sched& S, const Epi& E) {
    int tid_ = threadIdx.x; asm volatile("" : "+v"(tid_)); const int tid = tid_, wid = __builtin_amdgcn_readfirstlane(tid >> 6), lane = tid & 63, wr = wid >> 2, wc = wid & 3, fr = lane & 15, fq = lane >> 4;
    const int K = KP ? KP : g.K;
    unsigned voffA[2], voffB[2];
#pragma unroll
    for (int i = 0; i < 2; ++i) { int R, C; stage_rc(tid * 16 + i * 8192, R, C); const int Rb = Epi::PERM ? ((R & ~31) + perm32(R & 31)) : R;
        voffA[i] = (unsigned)(R * K + C) * 2u; voffB[i] = (unsigned)(Rb * K + C) * 2u; }
    const size_t kstep = (size_t)(BK * 2);
    const size_t hstep = (size_t)HALF * K * 2;
    const size_t tstep = 2 * hstep;
    const unsigned ldsw = (unsigned)wid * 1024u;
    const int aoff = lds_byte(wr * 64 + fr, fq * 8), boff = lds_byte(wc * 32 + fr, fq * 8);
#define PG8_SA(b, h) (((b) * 2 + (h)) * HTB)
#define PG8_SB(b, h) ((4 + (b) * 2 + (h)) * HTB)
#ifndef PG8_AUX_voffB
#define PG8_AUX_voffB 0
#endif
#define PG8_AUX_voffA 0
#define PG8_STAGE(bufoff, gbase, voff) do { _Pragma("unroll") for (int _i = 0; _i < 2; ++_i) \
        __builtin_amdgcn_global_load_lds((const unsigned*)((const char*)(gbase) + (voff)[_i]), (PG8_LAS unsigned*)(lds + (bufoff) + ldsw + _i * 8192), 16, 0, PG8_AUX_##voff); } while (0)
#define PG8_LDA(dst, b, h) do { _Pragma("unroll") for (int m = 0; m < 4; ++m) _Pragma("unroll") for (int k = 0; k < 2; ++k) dst[m][k] = *(const PG8_LAS bf16x8*)(lds + PG8_SA(b, h) + aoff + m * 2048 + k * 1024); } while (0)
#define PG8_LDB(dst, b, h) do { _Pragma("unroll") for (int n = 0; n < 2; ++n) _Pragma("unroll") for (int k = 0; k < 2; ++k) dst[n][k] = *(const PG8_LAS bf16x8*)(lds + PG8_SB(b, h) + boff + n * 2048 + k * 1024); } while (0)
#define PG8_MMA(ai, bj, At, Bt) do { __builtin_amdgcn_s_setprio(1); _Pragma("unroll") for (int m = 0; m < 4; ++m) _Pragma("unroll") for (int n = 0; n < 2; ++n) _Pragma("unroll") for (int k = 0; k < 2; ++k) \
        acc[ai][bj][m][n] = __builtin_amdgcn_mfma_f32_16x16x32_bf16(Bt[n][k], At[m][k], acc[ai][bj][m][n], 0, 0, 0); __builtin_amdgcn_s_setprio(0); } while (0)
#define PG8_WAIT_V(n) asm volatile("s_waitcnt vmcnt(" #n ")" ::: "memory")
#define PG8_WAIT_L(n) asm volatile("s_waitcnt lgkmcnt(" #n ")" ::: "memory")
#define PG8_BAR __builtin_amdgcn_s_barrier()
#define PG8_SCHED __builtin_amdgcn_sched_barrier(0)
    Unit cur, nxt; int ui = 0;
    if (!S.next(0, cur)) return;
    f32x4 acc[2][2][4][2];
#pragma unroll
    for (int a = 0; a < 2; ++a)
#pragma unroll
        for (int b = 0; b < 2; ++b)
#pragma unroll
            for (int m = 0; m < 4; ++m)
#pragma unroll
                for (int n = 0; n < 2; ++n) acc[a][b][m][n] = (f32x4){0.f, 0.f, 0.f, 0.f};
    bf16x8 At[4][2], B0[2][2], B1[2][2];
    const char* cA = (const char*)g.A + (size_t)cur.pm * tstep + (size_t)cur.k0 * 2; const char* cB = (const char*)g.Bt + (size_t)cur.pn * tstep + (size_t)cur.k0 * 2;
    S.a_ready(cur);
    if constexpr (SP2) {
        PG8_STAGE(PG8_SB(0, 0), cB, voffB); PG8_STAGE(PG8_SB(0, 1), cB + hstep, voffB); PG8_STAGE(PG8_SA(0, 0), cA, voffA); PG8_STAGE(PG8_SA(0, 1), cA + hstep, voffA);
        if (wr == 1) PG8_BAR;
        PG8_WAIT_V(2); PG8_BAR;
        PG8_STAGE(PG8_SB(1, 0), cB + kstep, voffB); PG8_STAGE(PG8_SA(1, 0), cA + kstep, voffA); PG8_STAGE(PG8_SB(1, 1), cB + hstep + kstep, voffB);
        PG8_WAIT_V(6); PG8_BAR;
    } else {
        PG8_STAGE(PG8_SB(0, 0), cB, voffB); PG8_STAGE(PG8_SA(0, 0), cA, voffA); PG8_STAGE(PG8_SB(0, 1), cB + hstep, voffB); PG8_STAGE(PG8_SA(0, 1), cA + hstep, voffA);
        if (wr == 1) PG8_BAR;
        PG8_WAIT_V(4); PG8_BAR;
        PG8_STAGE(PG8_SB(1, 0), cB + kstep, voffB); PG8_STAGE(PG8_SA(1, 0), cA + kstep, voffA); PG8_STAGE(PG8_SB(1, 1), cB + hstep + kstep, voffB);
        PG8_WAIT_V(6); PG8_BAR;
    }
    for (;;) {
        const bool has_next = S.next(ui + 1, nxt);
        const char* nA = has_next ? (const char*)g.A + (size_t)nxt.pm * tstep + (size_t)nxt.k0 * 2 : cA; const char* nB = has_next ? (const char*)g.Bt + (size_t)nxt.pn * tstep + (size_t)nxt.k0 * 2 : cB;
        const int nt = cur.nt;
        for (int t = 0; t < nt; t += 2) {
            const bool last = (t == nt - 2);
            const char* a1 = cA + (size_t)(t + 1) * kstep;
            const char* a2 = last ? nA : cA + (size_t)(t + 2) * kstep; const char* b2 = last ? nB : cB + (size_t)(t + 2) * kstep;
            const char* a3 = a2 + kstep; const char* b3 = b2 + kstep;
            if (last && has_next) S.a_ready(nxt);
            if constexpr (SP2) {
            PG8_LDB(B0, 0, 0); PG8_LDB(B1, 0, 1); PG8_SCHED; PG8_LDA(At, 0, 0); PG8_STAGE(PG8_SA(1, 1), a1 + hstep, voffA);
            PG8_WAIT_V(8); PG8_WAIT_L(0); PG8_BAR; PG8_MMA(0, 0, At, B0); PG8_MMA(0, 1, At, B1); PG8_BAR; PG8_SCHED;
            PG8_LDA(At, 0, 1); PG8_STAGE(PG8_SB(0, 0), b2, voffB); PG8_STAGE(PG8_SB(0, 1), b2 + hstep, voffB); PG8_STAGE(PG8_SA(0, 0), a2, voffA);
            PG8_WAIT_V(8); PG8_WAIT_L(0); PG8_BAR; PG8_MMA(1, 0, At, B0); PG8_MMA(1, 1, At, B1); PG8_BAR; PG8_SCHED;
            PG8_LDB(B0, 1, 0); PG8_LDB(B1, 1, 1); PG8_SCHED; PG8_LDA(At, 1, 0); PG8_STAGE(PG8_SA(0, 1), a2 + hstep, voffA);
            PG8_WAIT_V(8); PG8_WAIT_L(0); PG8_BAR; PG8_MMA(0, 0, At, B0); PG8_MMA(0, 1, At, B1); PG8_BAR; PG8_SCHED;
            PG8_LDA(At, 1, 1); PG8_STAGE(PG8_SB(1, 0), b3, voffB); PG8_STAGE(PG8_SB(1, 1), b3 + hstep, voffB); PG8_STAGE(PG8_SA(1, 0), a3, voffA);
            PG8_WAIT_V(8); PG8_WAIT_L(0); PG8_BAR; PG8_MMA(1, 0, At, B0); PG8_MMA(1, 1, At, B1); PG8_BAR; PG8_SCHED;
            } else {
            PG8_LDB(B0, 0, 0); PG8_SCHED; PG8_LDA(At, 0, 0); PG8_STAGE(PG8_SA(1, 1), a1 + hstep, voffA);
            PG8_WAIT_L(8); PG8_BAR; PG8_WAIT_L(0); PG8_MMA(0, 0, At, B0); PG8_BAR; PG8_SCHED;
            PG8_LDB(B1, 0, 1); PG8_STAGE(PG8_SB(0, 0), b2, voffB);
            PG8_BAR; PG8_WAIT_L(0); PG8_MMA(0, 1, At, B1); PG8_BAR;
            PG8_LDA(At, 0, 1); PG8_STAGE(PG8_SA(0, 0), a2, voffA);
            PG8_BAR; PG8_WAIT_L(0); PG8_MMA(1, 0, At, B0); PG8_BAR; PG8_SCHED;
            PG8_STAGE(PG8_SB(0, 1), b2 + hstep, voffB);
            PG8_WAIT_V(6); PG8_BAR; PG8_MMA(1, 1, At, B1); PG8_BAR;
            PG8_LDB(B0, 1, 0); PG8_SCHED; PG8_LDA(At, 1, 0); PG8_STAGE(PG8_SA(0, 1), a2 + hstep, voffA);
            PG8_WAIT_L(8); PG8_BAR; PG8_WAIT_L(0); PG8_MMA(0, 0, At, B0); PG8_BAR; PG8_SCHED;
            PG8_LDB(B1, 1, 1); PG8_STAGE(PG8_SB(1, 0), b3, voffB);
            PG8_BAR; PG8_WAIT_L(0); PG8_MMA(0, 1, At, B1); PG8_BAR;
            PG8_LDA(At, 1, 1); PG8_STAGE(PG8_SA(1, 0), a3, voffA);
            PG8_BAR; PG8_WAIT_L(0); PG8_MMA(1, 0, At, B0); PG8_BAR; PG8_SCHED;
            PG8_STAGE(PG8_SB(1, 1), b3 + hstep, voffB);
            PG8_WAIT_V(6); PG8_BAR; PG8_MMA(1, 1, At, B1); PG8_BAR;
            }
        }
        if constexpr (ALIGN_EPI) { if (wr == 0) PG8_BAR; }
        if constexpr (!Epi::AFTER_DRAIN) { E(acc, cur, wr, wc, fr, fq); S.done(cur); }
        if (!has_next) break;
#pragma unroll
        for (int a = 0; a < 2; ++a)
#pragma unroll
            for (int b = 0; b < 2; ++b)
#pragma unroll
                for (int m = 0; m < 4; ++m)
#pragma unroll
                    for (int n = 0; n < 2; ++n) acc[a][b][m][n] = (f32x4){0.f, 0.f, 0.f, 0.f};
        cur = nxt; cA = nA; cB = nB; ++ui;
        if constexpr (ALIGN_EPI) { if (wr == 1) PG8_BAR; }
    }
    PG8_WAIT_V(0);
    if constexpr (!ALIGN_EPI) { if (wr == 0) PG8_BAR; }
    PG8_BAR;
    if constexpr (Epi::AFTER_DRAIN) { E.fused(acc, cur, wr, wc, fr, fq, lds, wid, lane); S.done(cur); }
#undef PG8_SA
#undef PG8_SB
#undef PG8_STAGE
#undef PG8_LDA
#undef PG8_LDB
#undef PG8_MMA
#undef PG8_WAIT_V
#undef PG8_WAIT_L
#undef PG8_BAR
#undef PG8_SCHED
}
}
#ifndef MK_PER_PHASE
#define MK_PER_PHASE 0
#endif
constexpr int DM = 2048, NBATCH = 2, SEQ = 4096, DEPTH = 4, CTXL = 256, DFF = 5632, DIN = 2816;
constexpr int R_LAT = NBATCH * SEQ, R_CTX = NBATCH * CTXL, R = R_LAT + R_CTX;
constexpr int K_OFF = 0, V_OFF = 128, SSM_OFF = 256, Q_OFF = 768, CONV_OFF = 1280, FFT_OFF = 2304;
constexpr int MODW = 9 * DM;
constexpr int NWAVES = 8, NTHR = 512;
constexpr int MOD_CHUNKS = 32;

constexpr size_t MiB = 1u << 20;
constexpr size_t WS_CTL = 0, CTL_ZERO_BYTES = 1 * MiB;
constexpr size_t WS_MOD = 1 * MiB;
constexpr size_t WS_ROPE = 2 * MiB;
constexpr size_t WS_TW = WS_ROPE + 65536;
constexpr size_t WS_SSMA = WS_ROPE + 131072;
constexpr size_t WS_SSMBB = 3 * MiB;
constexpr size_t WS_SSMCT = 5 * MiB;
constexpr size_t WS_WFOLD = 7 * MiB;
constexpr size_t WS_MODP = 23 * MiB;
constexpr size_t WS_WI = 50 * MiB;
constexpr size_t WS_WO = WS_WI + 352 * MiB;
constexpr size_t WS_WIN = WS_WO + 176 * MiB;
constexpr size_t WS_WOUT = WS_WIN + 44 * MiB;
constexpr size_t WS_X = WS_WOUT + 32 * MiB;
constexpr size_t WS_H = WS_X + 68 * MiB;
constexpr size_t WS_ACT = WS_H + 34 * MiB;
constexpr size_t WS_Y = WS_ACT + 94 * MiB;
constexpr size_t WS_P = WS_Y + 68 * MiB;
constexpr size_t WS_CAT = WS_P + 47 * MiB;
constexpr size_t WS_SSMWS = WS_CAT + 34 * MiB;
constexpr size_t WS_SSMWY = WS_SSMWS + 16 * MiB;
constexpr size_t WS_SSMS = WS_SSMWY + 32 * MiB;
constexpr size_t WS_HIN = WS_SSMS + 17 * MiB;
constexpr size_t WS_YG = WS_HIN + 9 * MiB;
constexpr size_t WS_GLUW = WS_YG + 9 * MiB;
constexpr size_t WS_A16 = WS_GLUW + 2 * MiB;
constexpr size_t WS_YP = WS_A16 + 1 * MiB;
constexpr size_t WS_COMB = WS_YP + 44 * MiB;
constexpr size_t WS_END = WS_COMB + 1 * MiB;
constexpr int NCR = R / 16;
constexpr int CW_CONVQ = 10240, CW_DONE = 12288;
constexpr int CW_QUEUE = 8192;
constexpr int CW_BAR = 4096;

constexpr int RING_BYTES = 131072;
constexpr int MISC_OFF = 147456 - 256;
constexpr int LDS_BYTES = 147456;

#define GAS __attribute__((address_space(1)))
#define LAS __attribute__((address_space(3)))
typedef unsigned short bf16;
typedef unsigned v4u __attribute__((ext_vector_type(4)));
typedef unsigned v2u __attribute__((ext_vector_type(2)));
typedef float f32x4 __attribute__((ext_vector_type(4)));
typedef float f32x2 __attribute__((ext_vector_type(2)));
#define LDS_WAIT() asm volatile("s_waitcnt lgkmcnt(0)" ::: "memory")
#define VM_WAIT() asm volatile("s_waitcnt vmcnt(0)" ::: "memory")
typedef float f32x2cv __attribute__((ext_vector_type(2))); typedef __bf16 bf16x2cv __attribute__((ext_vector_type(2)));
__device__ __forceinline__ unsigned pk2(float lo, float hi) { const f32x2cv v = {lo, hi}; return __builtin_bit_cast(unsigned, __builtin_convertvector(v, bf16x2cv)); }
__device__ __forceinline__ unsigned f2bf(float f) { return pk2(f, 0.0f) & 0xffffu; }
__device__ __forceinline__ float bflo(unsigned w) { return __builtin_bit_cast(float, w << 16); }
__device__ __forceinline__ float bfhi(unsigned w) { return __builtin_bit_cast(float, w & 0xffff0000u); }
__device__ __forceinline__ float bf1(bf16 v) { return __builtin_bit_cast(float, (unsigned)v << 16); }
__device__ __forceinline__ float sigmoidf_(float x) { return __builtin_amdgcn_rcpf(1.0f + __expf(-x)); }
__device__ __forceinline__ float wave_sum(float v) {
#pragma unroll
    for (int o = 1; o < 64; o <<= 1) v += __shfl_xor(v, o);
    return v;
}

#define XB_TMO      128
#define XB_XCNT(j)  (256  + 64 * (j))
#define XB_XSUB(j)  (1280 + 64 * (j))
#define XB_XGEN(j)  (2304 + 64 * (j))
#define XB_TOP      3328
#define XB_TOPGEN   3392
#define XCD_BAR_WORDS 3456
#define XB_SPIN_CAP (1u << 18)

__device__ __forceinline__ unsigned xb_ld(unsigned* p)              { return __hip_atomic_load(p, __ATOMIC_RELAXED, __HIP_MEMORY_SCOPE_AGENT); }
__device__ __forceinline__ unsigned xb_add(unsigned* p, unsigned v) { return __hip_atomic_fetch_add(p, v, __ATOMIC_RELAXED, __HIP_MEMORY_SCOPE_AGENT); }
__device__ __forceinline__ unsigned xb_xcc_id() { return (unsigned)__builtin_amdgcn_s_getreg((3 << 11) | 20) & 0xFu; }
#define XB_SPIN(cond, bar) do { unsigned _sp = 0; while (cond) { __builtin_amdgcn_s_sleep(1); \
    if ((++_sp & 255u) == 0u) { if (xb_ld(&(bar)[XB_TMO])) break; if (_sp > XB_SPIN_CAP) { atomicAdd(&(bar)[XB_TMO], 1u); break; } } } } while (0)

struct XcdBarrier {
    unsigned* bar; unsigned x;
    volatile LAS unsigned* st;
};

__device__ __forceinline__ XcdBarrier xcd_barrier_post(unsigned* bar, volatile LAS unsigned* st) {
    XcdBarrier b; b.bar = bar; b.x = xb_xcc_id(); b.st = st;
    if (threadIdx.x == 0) (void)xb_add(&bar[XB_XCNT(b.x)], 1u);
    return b;
}
__device__ __forceinline__ void xcd_barrier_complete(unsigned* bar, unsigned x, unsigned& nloc, unsigned& nx) {
    const unsigned G = gridDim.x * gridDim.y * gridDim.z;
    unsigned sum, cnt, mine, sp = 0u;
    for (;;) {
        sum = 0u; cnt = 0u; mine = 0u;
#pragma unroll
        for (unsigned j = 0; j < 16; ++j) { const unsigned c = xb_ld(&bar[XB_XCNT(j)]); sum += c; cnt += (c > 0u) ? 1u : 0u; mine = (j == x) ? c : mine; }
        if (sum == G) break;
        __builtin_amdgcn_s_sleep(1);
        if ((++sp & 255u) == 0u) { if (xb_ld(&bar[XB_TMO])) break; if (sp > XB_SPIN_CAP) { atomicAdd(&bar[XB_TMO], 1u); break; } }
    }
    nloc = mine > 0u ? mine : 1u; nx = cnt > 0u ? cnt : 1u;
}

__device__ __forceinline__ void xcd_barrier(const XcdBarrier& b) {
    asm volatile("s_waitcnt vmcnt(0)" ::: "memory");
    __syncthreads();
    if (threadIdx.x == 0) {
        unsigned* bar = b.bar;
        __builtin_amdgcn_s_waitcnt(0);
        unsigned nloc = b.st[0], nx = b.st[1];
        if (nloc == 0u) { xcd_barrier_complete(bar, b.x, nloc, nx); b.st[0] = nloc; b.st[1] = nx; }
        const unsigned old = xb_add(&bar[XB_XSUB(b.x)], 1u);
        const unsigned gen = old / nloc;
        if (old + 1u == (gen + 1u) * nloc) {
            __builtin_amdgcn_fence(__ATOMIC_RELEASE, "agent");
            asm volatile("s_waitcnt vmcnt(0)" ::: "memory");
            const unsigned og = xb_add(&bar[XB_TOP], 1u);
            const unsigned tg = og / nx;
            if (og + 1u == (tg + 1u) * nx) xb_add(&bar[XB_TOPGEN], 1u);
            else XB_SPIN(xb_ld(&bar[XB_TOPGEN]) == tg, bar);
            __builtin_amdgcn_fence(__ATOMIC_ACQUIRE, "agent");
            xb_add(&bar[XB_XGEN(b.x)], 1u);
            asm volatile("s_waitcnt vmcnt(0)" ::: "memory");
        } else {
            XB_SPIN(xb_ld(&bar[XB_XGEN(b.x)]) == gen, bar);
            __builtin_amdgcn_fence(__ATOMIC_ACQUIRE, "agent");
            asm volatile("s_waitcnt vmcnt(0)" ::: "memory");
        }
    }
    __syncthreads();
}

struct Frame {
    LAS unsigned char* lds;
    int tid, lane, wave, G, bid;
    float* out; unsigned char* ws;
};
struct Args { const float* in[26]; float* out; unsigned char* ws; int ph_lo, ph_hi; };
enum { I_X = 0, I_C, I_CTX, I_CCTX, I_WMOD, I_BMOD, I_NORMG, I_WI, I_WO, I_WIN, I_WOUT, I_SINK, I_LAMRE, I_LAMIM, I_LOGDT, I_BRE, I_BIM, I_CRE, I_CIM, I_SSMD, I_GLUW, I_GLUB,
       I_CONVW, I_CONVB, I_LNG, I_LNB };

constexpr int TR_STRIDE = 65, TR_WAVE_BYTES = 64 * TR_STRIDE * 4;
#ifndef TR_NT
#define TR_NT 1
#endif
struct TrItem { const float* src; bf16* dst; int ldw, K; };
__device__ __forceinline__ void tr_load(const TrItem& t, f32x4 (&v)[16], int lane) {
    const int rr = lane >> 4, c4 = (lane & 15) * 4;
#pragma unroll
    for (int i = 0; i < 16; ++i) v[i] = TR_NT ? __builtin_nontemporal_load((const f32x4*)(t.src + (size_t)(4 * i + rr) * t.ldw + c4)) : *(const f32x4*)(t.src + (size_t)(4 * i + rr) * t.ldw + c4);
}
__device__ __forceinline__ void tr_store(const TrItem& t, const f32x4 (&v)[16], LAS float* scr, int lane) {
    const int rr = lane >> 4, c4 = (lane & 15) * 4;
#pragma unroll
    for (int i = 0; i < 16; ++i) { LAS float* d = scr + (4 * i + rr) * TR_STRIDE + c4; d[0] = v[i].x; d[1] = v[i].y; d[2] = v[i].z; d[3] = v[i].w; }
    LDS_WAIT(); asm volatile("" ::: "memory");
    const int c = lane & 7;
#pragma unroll
    for (int j = 0; j < 8; ++j) { const int n = (lane >> 3) + 8 * j; const LAS float* s = scr + (8 * c) * TR_STRIDE + n;
        v4u o; o.x = pk2(s[0 * TR_STRIDE], s[1 * TR_STRIDE]); o.y = pk2(s[2 * TR_STRIDE], s[3 * TR_STRIDE]); o.z = pk2(s[4 * TR_STRIDE], s[5 * TR_STRIDE]); o.w = pk2(s[6 * TR_STRIDE], s[7 * TR_STRIDE]);
        if (TR_NT) __builtin_nontemporal_store(o, (v4u*)(t.dst + (size_t)n * t.K + 8 * c)); else *(GAS v4u*)(t.dst + (size_t)n * t.K + 8 * c) = o; }
    LDS_WAIT(); asm volatile("" ::: "memory");
}
__device__ __forceinline__ void transpose_item(const float* W, int ldw, int k0, int n0, bf16* WT, int K, int drow0, LAS float* scr, int lane) {
    TrItem t{W + (size_t)k0 * ldw + n0, WT + (size_t)drow0 * K + k0, ldw, K}; f32x4 v[16]; tr_load(t, v, lane); tr_store(t, v, scr, lane);
}

constexpr int CV_WI = 32 * 176, CV_WO = 88 * 32, CV_WOUT = 32 * 32, CV_WIN = 32 * 36, CV_GLU = 8 * 8, CV_FOLD = 32 * 8;
constexpr int CV_NOFOLD = 2 * CV_WI + 2 * CV_WO + CV_WOUT + CV_WIN + CV_GLU, CV_TILES = CV_NOFOLD + CV_FOLD, CV_ITEMS = CV_TILES / 8;
static_assert(CV_TILES % 8 == 0, "workgroup items of 8 wave tiles");
__device__ __forceinline__ void conv_decode(const Args& AR, unsigned char* ws, int L, int it, TrItem& t) {
    int r = it;
    if (r < 2 * CV_WI) { const int mat = L * 2 + r / CV_WI, q = r % CV_WI, kb = q / 176, nb = q % 176, n0 = nb * 64, half = n0 / DFF, j = n0 % DFF, drow = (j / 128) * 256 + half * 128 + (j % 128);
        t.src = AR.in[I_WI] + (size_t)mat * DM * 2 * DFF + (size_t)(kb * 64) * (2 * DFF) + n0; t.dst = (bf16*)(ws + WS_WI) + (size_t)mat * 2 * DFF * DM + (size_t)drow * DM + kb * 64; t.ldw = 2 * DFF; t.K = DM; return; }
    r -= 2 * CV_WI;
    if (r < 2 * CV_WO) { const int mat = L * 2 + r / CV_WO, q = r % CV_WO, kb = q / 32, nb = q % 32;
        t.src = AR.in[I_WO] + (size_t)mat * DFF * DM + (size_t)(kb * 64) * DM + nb * 64; t.dst = (bf16*)(ws + WS_WO) + (size_t)mat * DM * DFF + (size_t)(nb * 64) * DFF + kb * 64; t.ldw = DM; t.K = DFF; return; }
    r -= 2 * CV_WO;
    if (r < CV_WOUT) { const int kb = r / 32, nb = r % 32;
        t.src = AR.in[I_WOUT] + (size_t)L * DM * DM + (size_t)(kb * 64) * DM + nb * 64; t.dst = (bf16*)(ws + WS_WOUT) + (size_t)L * DM * DM + (size_t)(nb * 64) * DM + kb * 64; t.ldw = DM; t.K = DM; return; }
    r -= CV_WOUT;
    if (r < CV_WIN) { const int kb = r / 36, nb = r % 36;
        t.src = AR.in[I_WIN] + (size_t)L * DM * DIN + (size_t)(kb * 64) * DIN + nb * 64; t.dst = (bf16*)(ws + WS_WIN) + (size_t)L * DIN * DM + (size_t)(nb * 64) * DM + kb * 64; t.ldw = DIN; t.K = DM; return; }
    r -= CV_WIN;
    if (r < CV_GLU) { const int kb = r / 8, nb = r % 8;
        t.src = AR.in[I_GLUW] + (size_t)L * 512 * 512 + (size_t)(kb * 64) * 512 + nb * 64; t.dst = (bf16*)(ws + WS_GLUW) + (size_t)L * 512 * 512 + (size_t)(nb * 64) * 512 + kb * 64; t.ldw = 512; t.K = 512; return; }
    r -= CV_GLU;
    { const int kb = r / 8, nb = r % 8;
        t.src = (const float*)(ws + WS_WFOLD) + (size_t)L * DM * 512 + (size_t)(kb * 64) * 512 + nb * 64; t.dst = (bf16*)(ws + WS_WIN) + (size_t)L * DIN * DM + (size_t)(FFT_OFF + nb * 64) * DM + kb * 64; t.ldw = 512; t.K = DM; }
}
__device__ __forceinline__ void bg_static(Frame& F, const Args& AR, int L, int first, int n, int stride) {
    __syncthreads();
    LAS float* scr = (LAS float*)(F.lds + F.wave * TR_WAVE_BYTES);
    int it = first, left = n;
    if (left <= 0 || it >= CV_ITEMS) return;
    TrItem cur; conv_decode(AR, F.ws, L, it * 8 + F.wave, cur); f32x4 va[16]; tr_load(cur, va, F.lane);
#pragma unroll 1
    for (;;) {
        const int nx = it + stride; const bool more = left > 1 && nx < CV_ITEMS;
        TrItem nxt = cur; f32x4 vb[16];
        if (more) { conv_decode(AR, F.ws, L, nx * 8 + F.wave, nxt); tr_load(nxt, vb, F.lane); }
        tr_store(cur, va, scr, F.lane);
        if (!more) break;
#pragma unroll
        for (int i = 0; i < 16; ++i) va[i] = vb[i];
        cur = nxt; it = nx; --left;
    }
}
constexpr int BG_UP = 8, BG_IN = 7, BG_DN = 1, BG_OUT = 1, BG_CA = 3;
constexpr int BGB_UP1 = 0, BGB_UP2 = BGB_UP1 + 40 * BG_UP, BGB_IN = BGB_UP2 + 40 * BG_UP, BGB_DN1 = BGB_IN + 138 * BG_IN, BGB_DN2 = BGB_DN1 + 80 * BG_DN, BGB_OUT = BGB_DN2 + 80 * BG_DN,
              BGB_CA = BGB_OUT + 192 * BG_OUT, BGB_REST = BGB_CA + 128 * BG_CA;
static_assert(BGB_REST <= CV_ITEMS, "background item map");
__device__ __forceinline__ void bg_site(Frame& F, const Args& AR, int L, int base, int c0, int n) {
    if (F.G == 256 && F.bid >= c0) bg_static(F, AR, L, base + (F.bid - c0) * n, n, 1);
}
__device__ __forceinline__ void bg_drain(Frame& F, const Args& AR, int L) {
    const int base = F.G == 256 ? BGB_REST : 0;
    bg_static(F, AR, L, base + F.bid, (CV_ITEMS - base - F.bid + F.G - 1) / F.G, F.G);
}

__device__ __forceinline__ void p0a(Frame& F, const Args& AR) {
    unsigned char* ws = F.ws;
    const int gw = F.bid * NWAVES + F.wave, NGW = F.G * NWAVES;
    const int gt = F.bid * NTHR + F.tid, NGT = F.G * NTHR;
    {
        float* rope = (float*)(ws + WS_ROPE);
        for (int i = gt; i < 64 * 16; i += NGT) { const int pos = i >> 4, j = i & 15;
            const double inv = exp(-(double)j * (9.210340371976184 / 16.0)); const double t = (double)pos * inv * 0.15915494309189535; const double fr = t - rint(t);
            rope[2 * i] = (float)cospi(2.0 * fr); rope[2 * i + 1] = (float)sinpi(2.0 * fr); }
        float* tw = (float*)(ws + WS_TW);
        for (int i = gt; i < 4096; i += NGT) { const double fr = (double)i / 4096.0; tw[2 * i] = (float)cospi(2.0 * fr); tw[2 * i + 1] = (float)(-sinpi(2.0 * fr)); }
        float* sa = (float*)(ws + WS_SSMA); float* sbb = (float*)(ws + WS_SSMBB);
        for (int i = gt; i < DEPTH * 2 * 32 * 64; i += NGT) {
            const int ldg = i >> 6;
            const double lr = fmin((double)AR.in[I_LAMRE][i], -1e-4), li = (double)AR.in[I_LAMIM][i], dt = exp((double)AR.in[I_LOGDT][ldg]);
            const double mag = exp(lr * dt); const double t = li * dt * 0.15915494309189535; const double fr = t - rint(t);
            const double are = mag * cospi(2.0 * fr), aim = mag * sinpi(2.0 * fr);
            const double den = lr * lr + li * li, nr = are - 1.0;
            const double cre = (nr * lr + aim * li) / den, cim = (aim * lr - nr * li) / den;
            sa[2 * i] = (float)are; sa[2 * i + 1] = (float)aim;
            { const double mag16 = exp(lr * dt * 16.0); const double t16 = li * dt * 16.0 * 0.15915494309189535; const double f16 = t16 - rint(t16);
              float* a16 = (float*)(ws + WS_A16); a16[2 * i] = (float)(mag16 * cospi(2.0 * f16)); a16[2 * i + 1] = (float)(mag16 * sinpi(2.0 * f16)); }
            for (int h = 0; h < 16; ++h) { const double br = (double)AR.in[I_BRE][(size_t)i * 16 + h], bi = (double)AR.in[I_BIM][(size_t)i * 16 + h];
                sbb[((size_t)i * 16 + h) * 2] = (float)(cre * br - cim * bi); sbb[((size_t)i * 16 + h) * 2 + 1] = (float)(cre * bi + cim * br); }
        }
        float* sct = (float*)(ws + WS_SSMCT);
        for (int i = gt; i < DEPTH * 2 * 64 * 512; i += NGT) { const int ch = i & 511, p = (i >> 9) & 63, ld = i >> 15;
            const size_t src = ((size_t)ld * 512 + ch) * 64 + p; sct[2 * (size_t)i] = AR.in[I_CRE][src]; sct[2 * (size_t)i + 1] = AR.in[I_CIM][src]; }
    }
    {
        LAS float* sv = (LAS float*)F.lds;
        for (int i = F.tid; i < 3 * DM; i += NTHR) { const int v = i / DM, d = i % DM; const float c = v < 2 ? AR.in[I_C][v * DM + d] : AR.in[I_CCTX][d]; sv[i] = c * sigmoidf_(c); }
        __syncthreads();
        float* modp = (float*)(ws + WS_MODP);
        constexpr int DCH = DM / MOD_CHUNKS;
        for (int it = F.bid; it < DEPTH * 9 * MOD_CHUNKS; it += F.G) {
            const int ch = it % MOD_CHUNKS, lj = it / MOD_CHUNKS, jg = lj % 9, l = lj / 9;
            const float* wp = AR.in[I_WMOD] + ((size_t)l * DM + (size_t)ch * DCH) * MODW + jg * 2048 + F.tid * 4;
            f32x4 a0 = {0.f, 0.f, 0.f, 0.f}, a1 = a0, a2 = a0;
#pragma unroll 8
            for (int d = 0; d < DCH; ++d) { const f32x4 w = __builtin_nontemporal_load((const f32x4*)(wp + (size_t)d * MODW)); const int dd = ch * DCH + d;
                a0 += w * sv[dd]; a1 += w * sv[DM + dd]; a2 += w * sv[2 * DM + dd]; }
            float* o = modp + ((size_t)(ch * DEPTH + l) * 3) * MODW + jg * 2048 + F.tid * 4;
            *(f32x4*)(o) = a0; *(f32x4*)(o + MODW) = a1; *(f32x4*)(o + 2 * MODW) = a2;
        }
        __syncthreads();
    }
    {
        LAS float* scr = (LAS float*)(F.lds + F.wave * 16384);
        scr[F.lane] = cospif((float)F.lane * (1.0f / 64.0f)); scr[F.lane + 64] = cospif((float)(F.lane + 64) * (1.0f / 64.0f));
        float* wf = (float*)(ws + WS_WFOLD);
        for (int it = gw; it < DEPTH * DM * 4; it += NGW) {
            const int h = it & 3, ld = it >> 2;
            const float* src = AR.in[I_WIN] + (size_t)ld * DIN + FFT_OFF + 128 * h;
            LDS_WAIT(); asm volatile("" ::: "memory");
            scr[128 + F.lane] = src[F.lane]; scr[192 + F.lane] = src[F.lane + 64];
            LDS_WAIT(); asm volatile("" ::: "memory");
#pragma unroll
            for (int q = 0; q < 2; ++q) { const int jj = F.lane + 64 * q, mp = jj >> 1, odd = jj & 1;
                const int mult = mp == 0 ? (odd ? 64 : 0) : mp, shift = (mp != 0 && odd) ? 96 : 0; const float sgn = (mp != 0 && odd) ? -1.f : 1.f;
                float s = 0.f;
                for (int c = 0; c < 128; ++c) s += scr[128 + c] * scr[(mult * c + shift) & 127];
                wf[(size_t)ld * 512 + 128 * h + jj] = s * sgn; }
        }
        LDS_WAIT(); asm volatile("" ::: "memory");
    }
    {
        __syncthreads();
        LAS float* scr = (LAS float*)(F.lds + F.wave * TR_WAVE_BYTES);
        constexpr int NIT = CV_NOFOLD;
        auto decode = [&](int it, TrItem& t) { conv_decode(AR, ws, 0, it, t); };
        int it = gw;
        if (it < NIT) {
            TrItem cur; decode(it, cur); f32x4 va[16]; tr_load(cur, va, F.lane);
#pragma unroll 1
            for (;;) {
                const int nx = it + NGW; const bool more = nx < NIT;
                TrItem nxt = cur; f32x4 vb[16];
                if (more) { decode(nx, nxt); tr_load(nxt, vb, F.lane); }
                tr_store(cur, va, scr, F.lane);
                if (!more) break;
#pragma unroll
                for (int i = 0; i < 16; ++i) va[i] = vb[i];
                cur = nxt; it = nx;
            }
        }
    }
}
__device__ __forceinline__ void ssm_build_mats(Frame& F, const Args& AR, int item2) {
    const int item = item2 >> 1, half = item2 & 1;
    const int l = item >> 5, g = item & 31;
    LAS float* apow = (LAS float*)F.lds;
    LAS float* cc = apow + 2 * 17 * 64 * 2;
    LAS float* bb = cc + 4096;
    LAS float* kt = bb + 4096;
    const float* ssmbb = (const float*)(F.ws + WS_SSMBB);
    __syncthreads();
    for (int i = F.tid; i < 2 * 17 * 64; i += NTHR) { const int p = i & 63, j = (i >> 6) % 17, dir = i / (17 * 64);
        const int idx = ((l * 2 + dir) * 32 + g) * 64 + p;
        const double lr = fmin((double)AR.in[I_LAMRE][idx], -1e-4), li = (double)AR.in[I_LAMIM][idx], dt = exp((double)AR.in[I_LOGDT][(l * 2 + dir) * 32 + g]);
        const double mag = exp(lr * dt * (double)j); const double t = li * dt * (double)j * 0.15915494309189535; const double fr = t - rint(t);
        apow[2 * i] = (float)(mag * cospi(2.0 * fr)); apow[2 * i + 1] = (float)(mag * sinpi(2.0 * fr)); }
    for (int i = F.tid; i < 2 * 16 * 64; i += NTHR) { const int p = i & 63, h = (i >> 6) & 15, dir = i >> 10;
        const size_t src = ((size_t)((l * 2 + dir) * 32 + g) * 16 + h) * 64 + p;
        cc[2 * i] = AR.in[I_CRE][src]; cc[2 * i + 1] = AR.in[I_CIM][src]; }
    for (int i = F.tid; i < 2 * 64 * 16; i += NTHR) { const int h = i & 15, p = (i >> 4) & 63, dir = i >> 10;
        const size_t src = ((size_t)((l * 2 + dir) * 32 + g) * 64 + p) * 16 + h;
        bb[2 * i] = ssmbb[2 * src]; bb[2 * i + 1] = ssmbb[2 * src + 1]; }
    __syncthreads();
    for (int i = F.tid; i < 8192; i += NTHR) { const int h = i & 15, hp = (i >> 4) & 15, j = (i >> 8) & 15, dir = i >> 12;
        float s = 0.f;
        for (int p = 0; p < 64; ++p) { const LAS float* c = cc + ((dir * 16 + hp) * 64 + p) * 2; const LAS float* a = apow + ((dir * 17 + j) * 64 + p) * 2; const LAS float* b = bb + ((dir * 64 + p) * 16 + h) * 2;
            const float car = c[0] * a[0] - c[1] * a[1], cai = c[0] * a[1] + c[1] * a[0]; s += car * b[0] - cai * b[1]; }
        kt[i] = s; }
    __syncthreads();
    bf16* wy = (bf16*)(F.ws + WS_SSMWY) + (size_t)item * 256 * 512;
    for (int e = half * 128 * 64 + F.tid; e < (half + 1) * 128 * 64; e += NTHR) { const int n = e >> 6, k0 = (e & 63) * 8, i = n >> 4, hp = n & 15;
        float v[8];
#pragma unroll
        for (int t = 0; t < 8; ++t) { const int k = k0 + t; float val;
            if (k < 256) { const int ip = k >> 4, h = k & 15; val = 0.f;
                if (ip <= i) val += kt[((0 * 16 + (i - ip)) * 16 + hp) * 16 + h];
                if (ip >= i) val += kt[((1 * 16 + (ip - i)) * 16 + hp) * 16 + h];
                if (ip == i && h == hp) val += AR.in[I_SSMD][l * 512 + g * 16 + h]; }
            else { const int kk = k - 256, dir = kk >> 7, part = (kk >> 6) & 1, p = kk & 63, ee = dir == 0 ? i + 1 : 16 - i;
                const LAS float* c = cc + ((dir * 16 + hp) * 64 + p) * 2; const LAS float* a = apow + ((dir * 17 + ee) * 64 + p) * 2;
                val = part == 0 ? c[0] * a[0] - c[1] * a[1] : -(c[0] * a[1] + c[1] * a[0]); }
            v[t] = val; }
        v4u o; o.x = pk2(v[0], v[1]); o.y = pk2(v[2], v[3]); o.z = pk2(v[4], v[5]); o.w = pk2(v[6], v[7]);
        *(v4u*)(wy + (size_t)n * 512 + k0) = o; }
    bf16* wsm = (bf16*)(F.ws + WS_SSMWS) + (size_t)item * 256 * 256;
    for (int e = half * 128 * 32 + F.tid; e < (half + 1) * 128 * 32; e += NTHR) { const int n = e >> 5, k0 = (e & 31) * 8, dir = n >> 7, part = (n >> 6) & 1, p = n & 63;
        float v[8];
#pragma unroll
        for (int t = 0; t < 8; ++t) { const int k = k0 + t, ip = k >> 4, h = k & 15, ee = dir == 0 ? 15 - ip : ip;
            const LAS float* a = apow + ((dir * 17 + ee) * 64 + p) * 2; const LAS float* b = bb + ((dir * 64 + p) * 16 + h) * 2;
            v[t] = part == 0 ? a[0] * b[0] - a[1] * b[1] : a[0] * b[1] + a[1] * b[0]; }
        v4u o; o.x = pk2(v[0], v[1]); o.y = pk2(v[2], v[3]); o.z = pk2(v[4], v[5]); o.w = pk2(v[6], v[7]);
        *(v4u*)(wsm + (size_t)n * 256 + k0) = o; }
}
__device__ __forceinline__ void p0b(Frame& F, const Args& AR) {
    unsigned char* ws = F.ws;
    const int gw = F.bid * NWAVES + F.wave, NGW = F.G * NWAVES;
    const int gt = F.bid * NTHR + F.tid, NGT = F.G * NTHR;
    {
        const float* modp = (const float*)(ws + WS_MODP); float* comb = (float*)(ws + WS_COMB); const float* ng = AR.in[I_NORMG];
        auto modval = [&](int l, int v, int j) { float s = AR.in[I_BMOD][l * MODW + j]; const float* q = modp + (size_t)(l * 3 + v) * MODW + j;
            for (int ch = 0; ch < MOD_CHUNKS; ++ch) s += q[(size_t)ch * DEPTH * 3 * MODW]; return s; };
        for (int e = gt; e < 13 * 3 * DM; e += NGT) { const int c = e % DM, v = (e / DM) % 3, idx = e / (3 * DM);
            float vg = 0.f, vs = 0.f, vh = 0.f;
            if (idx == 12) { vs = ng[c] * (1.0f + modval(0, v, 1 * DM + c)); vh = modval(0, v, c); }
            else { const int l = idx / 3, k = idx % 3;
                vg = (k == 1 ? 1.0f : 0.5f) * modval(l, v, (2 + 3 * k) * DM + c) * ng[(l * 6 + 1 + 2 * k) * DM + c];
                if (k < 2) { vs = ng[(l * 6 + 2 + 2 * k) * DM + c] * (1.0f + modval(l, v, (4 + 3 * k) * DM + c)); vh = modval(l, v, (3 + 3 * k) * DM + c); }
                else if (l < DEPTH - 1) { vs = ng[((l + 1) * 6) * DM + c] * (1.0f + modval(l + 1, v, 1 * DM + c)); vh = modval(l + 1, v, c); } }
            float* o = comb + ((size_t)(idx * 3 + v) * 3) * DM + c; o[0] = vg; o[DM] = vs; o[2 * DM] = vh; }
    }
    for (int it = F.bid; it < DEPTH * 32 * 2; it += F.G) ssm_build_mats(F, AR, it);
    __syncthreads();
    {
        LAS float* scr = (LAS float*)(F.lds + F.wave * TR_WAVE_BYTES);
        bf16* win_t = (bf16*)(ws + WS_WIN); const float* wf = (const float*)(ws + WS_WFOLD);
        for (int it = gw; it < CV_FOLD; it += NGW) { TrItem t; conv_decode(AR, ws, 0, CV_NOFOLD + it, t); f32x4 v[16]; tr_load(t, v, F.lane); tr_store(t, v, scr, F.lane); }
        (void)win_t; (void)wf;
    }
}
#ifndef NT_H
#define NT_H 1
#endif
#ifndef NT_X
#define NT_X 1
#endif
#ifndef NORM_CUS
#define NORM_CUS 0
#endif
__device__ __forceinline__ void norm_phase(Frame& F, const Args& AR, bool first, bool has_y, int nsplit, const float* comb, float res_mul, bool write_h, bool write_out) {
    if (NORM_CUS && F.bid >= NORM_CUS) return;
    const int gw = F.bid * NWAVES + F.wave, NGW = (NORM_CUS ? NORM_CUS : F.G) * NWAVES;
    float* X = (float*)(F.ws + WS_X); const bf16* Y = (const bf16*)(F.ws + WS_Y); bf16* H = (bf16*)(F.ws + WS_H);
#pragma unroll 1
    for (int r = gw; r < R; r += NGW) {
        const int v = r < SEQ ? 0 : (r < R_LAT ? 1 : 2);
        const float* cb = comb + (size_t)v * 3 * DM + 4 * F.lane;
        const float* xr = (first ? (r < R_LAT ? AR.in[I_X] + (size_t)r * DM : AR.in[I_CTX] + (size_t)(r - R_LAT) * DM) : X + (size_t)r * DM) + 4 * F.lane;
        f32x4 x[8], y[8], vg[8], vs[8], vh[8];
#pragma unroll
        for (int j = 0; j < 8; ++j) x[j] = NT_X ? __builtin_nontemporal_load((const f32x4*)(xr + 256 * j)) : *(const f32x4*)(xr + 256 * j);
        if (has_y) {
            if (r < R_LAT) {
#pragma unroll
                for (int j = 0; j < 8; ++j) { const v2u w = __builtin_nontemporal_load((const v2u*)(Y + (size_t)r * DM + 4 * F.lane + 256 * j)); y[j] = (f32x4){bflo(w.x), bfhi(w.x), bflo(w.y), bfhi(w.y)}; }
            } else {
                const float* yp = (const float*)(F.ws + WS_YP) + (size_t)(r - R_LAT) * DM + 4 * F.lane;
#pragma unroll
                for (int j = 0; j < 8; ++j) y[j] = __builtin_nontemporal_load((const f32x4*)(yp + 256 * j));
#pragma unroll 1
                for (int s = 1; s < nsplit; ++s) {
#pragma unroll
                    for (int j = 0; j < 8; ++j) y[j] += __builtin_nontemporal_load((const f32x4*)(yp + (size_t)s * R_CTX * DM + 256 * j)); }
            }
#pragma unroll
            for (int j = 0; j < 8; ++j) vg[j] = *(const f32x4*)(cb + 256 * j);
        }
        if (write_h) {
#pragma unroll
            for (int j = 0; j < 8; ++j) { vs[j] = *(const f32x4*)(cb + DM + 256 * j); vh[j] = *(const f32x4*)(cb + 2 * DM + 256 * j); }
        }
        if (has_y) {
            float ss = 0.f;
#pragma unroll
            for (int j = 0; j < 8; ++j) ss += (y[j].x * y[j].x + y[j].y * y[j].y) + (y[j].z * y[j].z + y[j].w * y[j].w);
            const float rs = rsqrtf(wave_sum(ss) * (1.0f / DM) + 1e-6f) * res_mul;
#pragma unroll
            for (int j = 0; j < 8; ++j) x[j] += vg[j] * (y[j] * rs);
        }
        if (has_y) {
#pragma unroll
            for (int j = 0; j < 8; ++j) { if (NT_X) __builtin_nontemporal_store(x[j], (f32x4*)(X + (size_t)r * DM + 4 * F.lane + 256 * j)); else *(f32x4*)(X + (size_t)r * DM + 4 * F.lane + 256 * j) = x[j]; }
        }
        if (write_out && r < R_LAT) {
#pragma unroll
            for (int j = 0; j < 8; ++j) *(f32x4*)(F.out + (size_t)r * DM + 4 * F.lane + 256 * j) = x[j];
        }
        if (write_h) {
            float ss = 0.f;
#pragma unroll
            for (int j = 0; j < 8; ++j) ss += (x[j].x * x[j].x + x[j].y * x[j].y) + (x[j].z * x[j].z + x[j].w * x[j].w);
            const float rs = rsqrtf(wave_sum(ss) * (1.0f / DM) + 1e-6f);
#pragma unroll
            for (int j = 0; j < 8; ++j) { const f32x4 hv = x[j] * rs * vs[j] + vh[j];
                v2u o; o.x = pk2(hv.x, hv.y); o.y = pk2(hv.z, hv.w); if (NT_H) __builtin_nontemporal_store(o, (v2u*)(H + (size_t)r * DM + 4 * F.lane + 256 * j)); else *(v2u*)(H + (size_t)r * DM + 4 * F.lane + 256 * j) = o; }
        }
    }
}

typedef short bf16x8v __attribute__((ext_vector_type(8)));
template <int K> __device__ __forceinline__ void wave_bfrags(const bf16* Bt, int kb, bf16x8v (&bfr)[8][2], int lane) {
    const int fr = lane & 15, fq = lane >> 4;
#pragma unroll
    for (int ks = 0; ks < 8; ++ks)
#pragma unroll
        for (int n = 0; n < 2; ++n) bfr[ks][n] = *(const bf16x8v*)(Bt + (size_t)(n * 16 + fr) * K + kb * 256 + ks * 32 + 8 * fq);
}
template <int K, int MT> __device__ __forceinline__ void wave_mma_batch(const LAS unsigned char* a_lds, int lda, int kb, const bf16x8v (&bfr)[8][2], f32x4 (&acc)[MT][2], int lane) {
    const int fr = lane & 15, fq = lane >> 4;
#pragma unroll
    for (int ks = 0; ks < 8; ++ks)
#pragma unroll
        for (int m = 0; m < MT; ++m) { const bf16x8v af = *(const LAS bf16x8v*)(a_lds + (m * 16 + fr) * lda + (kb * 256 + ks * 32 + 8 * fq) * 2);
#pragma unroll
            for (int n = 0; n < 2; ++n) acc[m][n] = __builtin_amdgcn_mfma_f32_16x16x32_bf16(bfr[ks][n], af, acc[m][n], 0, 0, 0); }
}
template <int PH, int MT> __device__ __forceinline__ void ssm_gemm_rows(Frame& F, const Args& AR, int l, int g, int row0) {
    constexpr int K = PH ? 512 : 256, LDA = K * 2 + 16, NROW = 16 * MT;
    const bf16* P = (const bf16*)(F.ws + WS_P);
    LAS unsigned char* at = F.lds;
    const bf16* Bt = (PH ? (const bf16*)(F.ws + WS_SSMWY) + (size_t)(l * 32 + g) * 256 * 512 : (const bf16*)(F.ws + WS_SSMWS) + (size_t)(l * 32 + g) * 256 * 256) + (size_t)(F.wave * 32) * K;
    bf16x8v b0[8][2];
    wave_bfrags<K>(Bt, 0, b0, F.lane);
    __syncthreads();
    for (int idx = F.tid; idx < NROW * 32; idx += NTHR) { const int piece = idx & 1, tok = (idx >> 1) & 15, row = idx >> 5, cr = row0 + row;
        v4u v = {0u, 0u, 0u, 0u}; if (cr < NCR) v = *(const v4u*)(P + (size_t)(cr * 16 + tok) * DIN + SSM_OFF + g * 16 + piece * 8);
        *(LAS v4u*)(at + row * LDA + (tok * 16 + piece * 8) * 2) = v; }
    if (PH) { const bf16* HIN = (const bf16*)(F.ws + WS_HIN);
        for (int idx = F.tid; idx < NROW * 32; idx += NTHR) { const int pc = idx & 31, row = idx >> 5, cr = row0 + row;
            v4u v = {0u, 0u, 0u, 0u}; if (cr < NCR) v = *(const v4u*)(HIN + ((size_t)cr * 32 + g) * 256 + pc * 8);
            *(LAS v4u*)(at + row * LDA + 512 + pc * 16) = v; } }
    __syncthreads();
    f32x4 acc[MT][2];
#pragma unroll
    for (int m = 0; m < MT; ++m)
#pragma unroll
        for (int n = 0; n < 2; ++n) acc[m][n] = (f32x4){0.f, 0.f, 0.f, 0.f};
    if (PH) { bf16x8v b1[8][2]; wave_bfrags<K>(Bt, 1, b1, F.lane); wave_mma_batch<K, MT>(at, LDA, 0, b0, acc, F.lane); wave_mma_batch<K, MT>(at, LDA, 1, b1, acc, F.lane); }
    else wave_mma_batch<K, MT>(at, LDA, 0, b0, acc, F.lane);
    const int fr = F.lane & 15, fq = F.lane >> 4;
#pragma unroll
    for (int m = 0; m < MT; ++m) { const int cr = row0 + m * 16 + fr;
        if (cr < NCR) {
#pragma unroll
            for (int n = 0; n < 2; ++n) { const int col = F.wave * 32 + n * 16 + 4 * fq;
                if (PH == 0) *(f32x4*)((float*)(F.ws + WS_SSMS) + ((size_t)cr * 32 + g) * 256 + col) = acc[m][n];
                else { const int i = col >> 4, hp = col & 15; float yv[4];
#pragma unroll
                    for (int j = 0; j < 4; ++j) { const float y = acc[m][n][j]; const float z = 0.7978845608028654f * (y + 0.044715f * y * y * y);
                        const float th = 1.0f - 2.0f * __builtin_amdgcn_rcpf(1.0f + __expf(2.0f * z)); yv[j] = 0.5f * y * (1.0f + th); }
                    v2u o; o.x = pk2(yv[0], yv[1]); o.y = pk2(yv[2], yv[3]);
                    *(v2u*)((bf16*)(F.ws + WS_YG) + (size_t)(cr * 16 + i) * 512 + g * 16 + hp) = o; } } } }
}
template <int PH> __device__ __forceinline__ void ssm_gemm_item(Frame& F, const Args& AR, int l, int item) { ssm_gemm_rows<PH, 4>(F, AR, l, item & 31, (item >> 5) * 64); }
__device__ __forceinline__ void glu_item(Frame& F, const Args& AR, int l, int item) {
    constexpr int K = 512, LDA = K * 2 + 16, NROW = 68, MT = 5;
    const int half = item & 1, row0 = (item >> 1) * NROW;
    const bf16* YG = (const bf16*)(F.ws + WS_YG); bf16* CAT = (bf16*)(F.ws + WS_CAT);
    LAS unsigned char* at = F.lds;
    const int colw = half * 256 + F.wave * 32;
    const bf16* Bt = (const bf16*)(F.ws + WS_GLUW) + (size_t)l * 512 * 512 + (size_t)colw * K;
    bf16x8v b0[8][2];
    wave_bfrags<K>(Bt, 0, b0, F.lane);
    __syncthreads();
    for (int idx = F.tid; idx < 80 * 64; idx += NTHR) { const int pc = idx & 63, row = idx >> 6;
        v4u v = {0u, 0u, 0u, 0u}; if (row < NROW) v = *(const v4u*)(YG + (size_t)(row0 + row) * 512 + pc * 8);
        *(LAS v4u*)(at + row * LDA + pc * 16) = v; }
    __syncthreads();
    f32x4 acc[MT][2];
#pragma unroll
    for (int m = 0; m < MT; ++m)
#pragma unroll
        for (int n = 0; n < 2; ++n) acc[m][n] = (f32x4){0.f, 0.f, 0.f, 0.f};
    { bf16x8v b1[8][2]; wave_bfrags<K>(Bt, 1, b1, F.lane); wave_mma_batch<K, MT>(at, LDA, 0, b0, acc, F.lane); wave_mma_batch<K, MT>(at, LDA, 1, b1, acc, F.lane); }
    const int fr = F.lane & 15, fq = F.lane >> 4;
#pragma unroll
    for (int n = 0; n < 2; ++n) { const int col = colw + n * 16 + 4 * fq; const f32x4 bias = *(const f32x4*)(AR.in[I_GLUB] + l * 512 + col);
#pragma unroll
        for (int m = 0; m < MT; ++m) { const int row = m * 16 + fr;
            if (row < NROW) { const v2u yw = *(const LAS v2u*)(at + row * LDA + col * 2); const f32x4 z = acc[m][n] + bias;
                const float o0 = bflo(yw.x) * sigmoidf_(z.x), o1 = bfhi(yw.x) * sigmoidf_(z.y), o2 = bflo(yw.y) * sigmoidf_(z.z), o3 = bfhi(yw.y) * sigmoidf_(z.w);
                v2u o; o.x = pk2(o0, o1); o.y = pk2(o2, o3); *(v2u*)(CAT + (size_t)(row0 + row) * DM + 512 + col) = o; } } }
}
__device__ __forceinline__ int carry_row(int dir, int b, int step) {
    return dir == 0 ? (step < 16 ? 512 + b * 16 + step : b * 256 + (step - 16)) : (step < 16 ? 512 + b * 16 + (15 - step) : b * 256 + (255 - (step - 16)));
}
__device__ __forceinline__ void ssm_carry_task(Frame& F, int l, int task) {
    const int dir = task & 1, g = (task >> 1) & 31, b = task >> 6, p = F.lane, w = F.wave;
    const float* S = (const float*)(F.ws + WS_SSMS); bf16* HIN = (bf16*)(F.ws + WS_HIN);
    LAS float* ex = (LAS float*)F.lds;
    const f32x2 a = *(const f32x2*)((const float*)(F.ws + WS_A16) + ((size_t)((l * 2 + dir) * 32 + g) * 64 + p) * 2);
    const size_t soff = (size_t)g * 256 + dir * 128 + p;
    float sr[34], si[34];
#pragma unroll
    for (int i = 0; i < 34; ++i) { const float* sp = S + (size_t)carry_row(dir, b, 34 * w + i) * 32 * 256 + soff; sr[i] = sp[0]; si[i] = sp[64]; }
    float hr = 0.f, hi = 0.f;
#pragma unroll
    for (int i = 0; i < 34; ++i) { const float nr = a.x * hr - a.y * hi + sr[i], ni = a.x * hi + a.y * hr + si[i]; hr = nr; hi = ni; }
    __syncthreads();
    ex[(w * 64 + p) * 2] = hr; ex[(w * 64 + p) * 2 + 1] = hi;
    float pr = 1.f, pi = 0.f;
#pragma unroll 1
    for (int i = 0; i < 34; ++i) { const float nr = pr * a.x - pi * a.y, ni = pr * a.y + pi * a.x; pr = nr; pi = ni; }
    __syncthreads();
    hr = 0.f; hi = 0.f;
    for (int ww = 0; ww < w; ++ww) { const float er = ex[(ww * 64 + p) * 2], ei = ex[(ww * 64 + p) * 2 + 1]; const float nr = pr * hr - pi * hi + er, ni = pr * hi + pi * hr + ei; hr = nr; hi = ni; }
#pragma unroll
    for (int i = 0; i < 34; ++i) { bf16* hp = HIN + (size_t)carry_row(dir, b, 34 * w + i) * 32 * 256 + soff; hp[0] = (bf16)f2bf(hr); hp[64] = (bf16)f2bf(hi);
        const float nr = a.x * hr - a.y * hi + sr[i], ni = a.x * hi + a.y * hr + si[i]; hr = nr; hi = ni; }
}
typedef float f32x16 __attribute__((ext_vector_type(16)));
constexpr int AT_ROW = 144, AT_KB = 64 * AT_ROW, AT_BUF = 2 * AT_KB;
__device__ __forceinline__ int crow16(int r, int hi) { return (r & 3) + 8 * (r >> 2) + 4 * hi; }
__device__ __forceinline__ void unpack8(const v4u w, float (&x)[8]) { x[0] = bflo(w.x); x[1] = bfhi(w.x); x[2] = bflo(w.y); x[3] = bfhi(w.y); x[4] = bflo(w.z); x[5] = bfhi(w.z); x[6] = bflo(w.w); x[7] = bfhi(w.w); }
__device__ __forceinline__ void attn_item_mfma(Frame& F, const Args& AR, int l, int item) {
    const bf16* P = (const bf16*)(F.ws + WS_P); bf16* CAT = (bf16*)(F.ws + WS_CAT); const float* rope = (const float*)(F.ws + WS_ROPE);
    const bool latent = item < 256;
    int b, kv, n, hq;
    if (latent) { hq = item & 1; n = (item >> 1) & 31; kv = (item >> 6) & 1; b = item >> 7; } else { const int c = item - 256; hq = c & 1; n = (c >> 1) & 1; kv = (c >> 2) & 1; b = c >> 3; }
    const int g = F.wave >> 1, wq = F.wave & 1, h = kv * 4 + g, r32 = F.lane & 31, hi = F.lane >> 5;
    constexpr float C2 = 0.125f * 1.4426950408889634f;
    const int qq = 32 * wq + r32;
    const int qpos = n * 128 + 64 * hq + qq;
    const int qrow = latent ? b * SEQ + qpos : R_LAT + b * CTXL + qpos;
    bf16x8v qf[4];
    {
        const bf16* qp = P + (size_t)qrow * DIN + Q_OFF + h * 64 + 8 * hi;
        float x[4][8];
#pragma unroll
        for (int ks = 0; ks < 4; ++ks) unpack8(*(const v4u*)(qp + 16 * ks), x[ks]);
        if (latent) {
#pragma unroll
            for (int part = 0; part < 2; ++part) { const int pos = part ? (qpos & 63) : (qpos >> 6);
#pragma unroll
                for (int t = 0; t < 8; ++t) { const f32x2 cs = *(const f32x2*)(rope + (pos * 16 + 8 * hi + t) * 2);
                    const float x1 = x[2 * part][t], x2 = x[2 * part + 1][t]; x[2 * part][t] = x1 * cs.x - x2 * cs.y; x[2 * part + 1][t] = x2 * cs.x + x1 * cs.y; } }
        }
#pragma unroll
        for (int ks = 0; ks < 4; ++ks) { v4u w; w.x = pk2(x[ks][0] * C2, x[ks][1] * C2); w.y = pk2(x[ks][2] * C2, x[ks][3] * C2); w.z = pk2(x[ks][4] * C2, x[ks][5] * C2); w.w = pk2(x[ks][6] * C2, x[ks][7] * C2);
            qf[ks] = __builtin_bit_cast(bf16x8v, w); }
    }
    float mrun = AR.in[I_SINK][l * 8 + h] * 1.4426950408889634f, lsum = hi == 0 ? 1.0f : 0.0f;
    f32x16 o[2];
#pragma unroll
    for (int db = 0; db < 2; ++db)
#pragma unroll
        for (int r = 0; r < 16; ++r) o[db][r] = 0.f;
    int tlo = hq, thi = hq + 4;
    if (latent) { if (n == 0 && tlo < 2) tlo = 2; if (n == 31 && thi > 3) thi = 3; } else { tlo = 0; thi = -1; }
    const int nloc = thi - tlo + 1, ntile = nloc + 4;
    const int sj = F.tid >> 3, sd0 = (F.tid & 7) * 8;
    v4u kw, kp, vw;
    { const bool lc = 0 < nloc; const int kp0 = lc ? 128 * (n - 1) + 64 * tlo : 0; const int krow = lc ? b * SEQ + kp0 + sj : R_LAT + b * CTXL + kp0 + sj;
      const bf16* kp_ = P + (size_t)krow * DIN + K_OFF + kv * 64; kw = *(const v4u*)(kp_ + sd0); kp = *(const v4u*)(kp_ + (sd0 ^ 16)); vw = *(const v4u*)(P + (size_t)krow * DIN + V_OFF + kv * 64 + sd0); }
    __syncthreads();
#pragma unroll 1
    for (int s = 0; s < ntile; ++s) {
        const bool local = s < nloc; const int kpos0 = local ? 128 * (n - 1) + 64 * (tlo + s) : 64 * (s - nloc);
        LAS unsigned char* kb_ = F.lds + (s & 1) * AT_BUF; LAS unsigned char* vb_ = kb_ + AT_KB;
        {
            float kk[8], kq[8], vv[8]; unpack8(kw, kk); unpack8(kp, kq); unpack8(vw, vv);
            if (local) { const int kpos = kpos0 + sj, part = sd0 >> 5, e0 = sd0 & 31; const bool firsth = e0 < 16; const int pp = part ? (kpos & 63) : (kpos >> 6);
#pragma unroll
                for (int t = 0; t < 8; ++t) { const f32x2 cs = *(const f32x2*)(rope + (pp * 16 + (e0 & 15) + t) * 2); kk[t] = firsth ? kk[t] * cs.x - kq[t] * cs.y : kk[t] * cs.x + kq[t] * cs.y; } }
            v4u w; w.x = pk2(kk[0], kk[1]); w.y = pk2(kk[2], kk[3]); w.z = pk2(kk[4], kk[5]); w.w = pk2(kk[6], kk[7]);
            *(LAS v4u*)(kb_ + sj * AT_ROW + sd0 * 2) = w;
#pragma unroll
            for (int t = 0; t < 8; ++t) *(LAS bf16*)(vb_ + (sd0 + t) * AT_ROW + sj * 2) = (bf16)f2bf(vv[t]);
        }
        __syncthreads();
        if (s + 1 < ntile) { const bool lc = s + 1 < nloc; const int kp0 = lc ? 128 * (n - 1) + 64 * (tlo + s + 1) : 64 * (s + 1 - nloc); const int krow = lc ? b * SEQ + kp0 + sj : R_LAT + b * CTXL + kp0 + sj;
            const bf16* kp_ = P + (size_t)krow * DIN + K_OFF + kv * 64; kw = *(const v4u*)(kp_ + sd0); kp = *(const v4u*)(kp_ + (sd0 ^ 16)); vw = *(const v4u*)(P + (size_t)krow * DIN + V_OFF + kv * 64 + sd0); }
        const int rel = local ? (tlo + s) - hq : 2;
        f32x16 st[2];
#pragma unroll
        for (int kb = 0; kb < 2; ++kb) {
#pragma unroll
            for (int r = 0; r < 16; ++r) st[kb][r] = 0.f;
#pragma unroll
            for (int ks = 0; ks < 4; ++ks) { const bf16x8v kf = *(const LAS bf16x8v*)(kb_ + (32 * kb + r32) * AT_ROW + (16 * ks + 8 * hi) * 2);
                st[kb] = __builtin_amdgcn_mfma_f32_32x32x16_bf16(kf, qf[ks], st[kb], 0, 0, 0); }
        }
        if (rel == 0 || rel == 4) {
#pragma unroll
            for (int kb = 0; kb < 2; ++kb)
#pragma unroll
                for (int r = 0; r < 16; ++r) { const int kk = 32 * kb + crow16(r, hi); const bool bad = rel == 0 ? kk < qq : kk > qq; st[kb][r] = bad ? -1e30f : st[kb][r]; } }
        float mx = st[0][0];
#pragma unroll
        for (int kb = 0; kb < 2; ++kb)
#pragma unroll
            for (int r = 0; r < 16; ++r) mx = fmaxf(mx, st[kb][r]);
        mx = fmaxf(mx, __shfl_xor(mx, 32));
        const float mnew = mx > mrun + 8.0f ? mx : mrun, corr = __builtin_amdgcn_exp2f(mrun - mnew);
        mrun = mnew;
        float ps = 0.f;
#pragma unroll
        for (int kb = 0; kb < 2; ++kb)
#pragma unroll
            for (int r = 0; r < 16; ++r) { st[kb][r] = __builtin_amdgcn_exp2f(st[kb][r] - mnew); ps += st[kb][r]; }
        lsum = lsum * corr + ps;
        if (__builtin_amdgcn_ballot_w64(corr != 1.0f) != 0ull) {
#pragma unroll
            for (int db = 0; db < 2; ++db)
#pragma unroll
                for (int r = 0; r < 16; ++r) o[db][r] *= corr; }
#pragma unroll
        for (int m = 0; m < 4; ++m) { const int kb = m >> 1, r0 = 8 * (m & 1); v4u pw;
            pw.x = pk2(st[kb][r0 + 0], st[kb][r0 + 1]); pw.y = pk2(st[kb][r0 + 2], st[kb][r0 + 3]); pw.z = pk2(st[kb][r0 + 4], st[kb][r0 + 5]); pw.w = pk2(st[kb][r0 + 6], st[kb][r0 + 7]);
            const bf16x8v pf = __builtin_bit_cast(bf16x8v, pw);
#pragma unroll
            for (int db = 0; db < 2; ++db) { const LAS unsigned char* vp = vb_ + (32 * db + r32) * AT_ROW + (16 * m + 4 * hi) * 2;
                const v2u lo = *(const LAS v2u*)vp, hh = *(const LAS v2u*)(vp + 16); const v4u w = {lo.x, lo.y, hh.x, hh.y};
                o[db] = __builtin_amdgcn_mfma_f32_32x32x16_bf16(__builtin_bit_cast(bf16x8v, w), pf, o[db], 0, 0, 0); } }
    }
    {
        const float lt = lsum + __shfl_xor(lsum, 32), inv = 1.0f / lt;
        bf16* op = CAT + (size_t)qrow * DM + h * 64;
#pragma unroll
        for (int db = 0; db < 2; ++db)
#pragma unroll
            for (int rq = 0; rq < 4; ++rq) { v2u w; w.x = pk2(o[db][4 * rq] * inv, o[db][4 * rq + 1] * inv); w.y = pk2(o[db][4 * rq + 2] * inv, o[db][4 * rq + 3] * inv);
                *(v2u*)(op + 32 * db + 8 * rq + 4 * hi) = w; }
    }
}
__device__ __forceinline__ void conv_tile_v1(Frame& F, const Args& AR, int l, int tile) {
    const bf16* P = (const bf16*)(F.ws + WS_P); bf16* CAT = (bf16*)(F.ws + WS_CAT);
    LAS float* hh = (LAS float*)F.lds;
    LAS float* red = hh + 47 * 512;
    const int c = F.tid;
    int base, t0, Ls;
    if (tile < R_LAT / 16) { const int b = tile / (SEQ / 16); t0 = (tile % (SEQ / 16)) * 16; base = b * SEQ; Ls = SEQ; }
    else { const int q = tile - R_LAT / 16; const int b = q / (CTXL / 16); t0 = (q % (CTXL / 16)) * 16; base = R_LAT + b * CTXL; Ls = CTXL; }
    __syncthreads();
#pragma unroll 1
    for (int kb = 0; kb < 6; kb += 3) {
        v4u vv[3], gg[3];
#pragma unroll
        for (int k = 0; k < 3; ++k) { const int q = F.tid + NTHR * (kb + k), i = q >> 6, c8 = (q & 63) * 8, t = t0 - 15 + i;
            vv[k] = (v4u){0u, 0u, 0u, 0u}; gg[k] = vv[k];
            if (i < 46 && t >= 0 && t < Ls) { const bf16* pr = P + (size_t)(base + t) * DIN + CONV_OFF + c8; vv[k] = *(const v4u*)pr; gg[k] = *(const v4u*)(pr + 512); } }
#pragma unroll
        for (int k = 0; k < 3; ++k) { const int q = F.tid + NTHR * (kb + k), i = q >> 6, c8 = (q & 63) * 8;
            if (i < 46) { float a[8], g[8]; unpack8(vv[k], a); unpack8(gg[k], g);
#pragma unroll
                for (int e = 0; e < 8; ++e) a[e] *= sigmoidf_(g[e]);
                *(LAS f32x4*)(hh + i * 512 + c8) = (f32x4){a[0], a[1], a[2], a[3]}; *(LAS f32x4*)(hh + i * 512 + c8 + 4) = (f32x4){a[4], a[5], a[6], a[7]}; } }
    }
    hh[46 * 512 + c] = 0.f;
    const float cb = AR.in[I_CONVB][l * 512 + c];
    __syncthreads();
    float ov[16];
#pragma unroll
    for (int i = 0; i < 16; ++i) ov[i] = cb;
    {
        const float* wp = AR.in[I_CONVW] + (size_t)l * 31 * 512 + c;
        float wc[8];
#pragma unroll
        for (int t = 0; t < 8; ++t) wc[t] = wp[t * 512];
#pragma unroll 1
        for (int kb = 0; kb < 4; ++kb) {
            float wn[8];
#pragma unroll
            for (int t = 0; t < 8; ++t) { const int k = 8 * (kb + 1) + t; wn[t] = wp[(k < 31 ? k : 30) * 512]; if (k >= 31) wn[t] = 0.f; }
            const LAS float* hb = hh + (8 * kb) * 512 + c;
            float hv[23];
#pragma unroll
            for (int j = 0; j < 23; ++j) hv[j] = hb[j * 512];
#pragma unroll
            for (int t = 0; t < 8; ++t)
#pragma unroll
                for (int i = 0; i < 16; ++i) ov[i] += hv[i + t] * wc[t];
#pragma unroll
            for (int t = 0; t < 8; ++t) wc[t] = wn[t];
        }
    }
    __syncthreads();
#pragma unroll
    for (int i = 0; i < 16; ++i) hh[i * 512 + c] = ov[i];
    __syncthreads();
    {
        float a0[8], a1[8]; float s0 = 0.f, s1 = 0.f;
#pragma unroll
        for (int j = 0; j < 8; ++j) { a0[j] = hh[(2 * F.wave) * 512 + F.lane + 64 * j]; a1[j] = hh[(2 * F.wave + 1) * 512 + F.lane + 64 * j]; s0 += a0[j]; s1 += a1[j]; }
        const float m0 = wave_sum(s0) * (1.0f / 512.0f), m1 = wave_sum(s1) * (1.0f / 512.0f);
        float q0 = 0.f, q1 = 0.f;
#pragma unroll
        for (int j = 0; j < 8; ++j) { const float d0 = a0[j] - m0, d1 = a1[j] - m1; q0 += d0 * d0; q1 += d1 * d1; }
        q0 = wave_sum(q0); q1 = wave_sum(q1);
        if (F.lane == 0) { red[4 * F.wave] = m0; red[4 * F.wave + 1] = rsqrtf(q0 * (1.0f / 512.0f) + 1e-5f); red[4 * F.wave + 2] = m1; red[4 * F.wave + 3] = rsqrtf(q1 * (1.0f / 512.0f) + 1e-5f); }
    }
    __syncthreads();
    const float lg = AR.in[I_LNG][l * 512 + c], lb = AR.in[I_LNB][l * 512 + c];
#pragma unroll
    for (int i = 0; i < 16; ++i) { const float mean = red[2 * i], rstd = red[2 * i + 1];
        const float y = (ov[i] - mean) * rstd * lg + lb;
        CAT[(size_t)(base + t0 + i) * DM + 1024 + c] = (bf16)f2bf(y * sigmoidf_(y)); }
}
__device__ __forceinline__ f32x2 cmul(f32x2 a, f32x2 b) { return (f32x2){a.x * b.x - a.y * b.y, a.x * b.y + a.y * b.x}; }
__device__ __forceinline__ void dft4(f32x2& a, f32x2& b, f32x2& c, f32x2& d) {
    const f32x2 s0 = a + c, s1 = a - c, s2 = b + d, s3 = b - d;
    a = s0 + s2; c = s0 - s2; b = (f32x2){s1.x + s3.y, s1.y - s3.x}; d = (f32x2){s1.x - s3.y, s1.y + s3.x};
}
__device__ __forceinline__ void dft16(f32x2 (&x)[16]) {
#pragma unroll
    for (int q0 = 0; q0 < 4; ++q0) dft4(x[q0], x[4 + q0], x[8 + q0], x[12 + q0]);
    const f32x2 w1 = {0.9238795325112867f, -0.3826834323650898f}, w2 = {0.7071067811865476f, -0.7071067811865476f}, w3 = {0.3826834323650898f, -0.9238795325112867f},
                w6 = {-0.7071067811865476f, -0.7071067811865476f}, w9 = {-0.9238795325112867f, 0.3826834323650898f};
    x[5] = cmul(x[5], w1); x[6] = cmul(x[6], w2); x[7] = cmul(x[7], w3);
    x[9] = cmul(x[9], w2); x[10] = (f32x2){x[10].y, -x[10].x}; x[11] = cmul(x[11], w6);
    x[13] = cmul(x[13], w3); x[14] = cmul(x[14], w6); x[15] = cmul(x[15], w9);
#pragma unroll
    for (int p1 = 0; p1 < 4; ++p1) dft4(x[4 * p1], x[4 * p1 + 1], x[4 * p1 + 2], x[4 * p1 + 3]);
}
template <int LOG2N> __device__ __forceinline__ void fft_item(Frame& F, const Args& AR, int item) {
    constexpr int N = 1 << LOG2N, TP = N / 16, PP = NTHR / TP, NST = LOG2N / 4, SLOTS = N + N / 16;
    const bf16* P = (const bf16*)(F.ws + WS_P); bf16* CAT = (bf16*)(F.ws + WS_CAT); const f32x2* twg = (const f32x2*)(F.ws + WS_TW);
    const int pr = F.tid / TP, j = F.tid % TP;
    int b, h, mA;
    if (LOG2N == 12) { const int grp = item & 15; h = (item >> 4) & 3; b = item >> 6; mA = 4 * grp + 2 * pr; } else { h = item & 3; b = item >> 2; mA = 2 * pr; }
    const int rbase = (LOG2N == 12) ? b * SEQ : R_LAT + b * CTXL;
    LAS f32x2* bufA = (LAS f32x2*)F.lds + (size_t)(2 * pr) * SLOTS; LAS f32x2* bufB = bufA + SLOTS;
    const float norm = (LOG2N == 12) ? 0.001381067932004975f : 0.005524271728019903f;
    f32x2 xa[16], xb[16];
    {
        const bf16* src = P + (size_t)(rbase + j) * DIN + FFT_OFF + 128 * h + 2 * mA;
#pragma unroll
        for (int q = 0; q < 16; ++q) { const v2u w = *(const v2u*)(src + (size_t)(TP * q) * DIN); xa[q] = (f32x2){bflo(w.x), bfhi(w.x)}; xb[q] = (f32x2){bflo(w.y), bfhi(w.y)}; }
        dft16(xa); dft16(xb);
    }
    __syncthreads();
#pragma unroll
    for (int st = 1; st < NST; ++st) {
        const int Ns0 = 1 << (4 * (st - 1));
        { const int k = j & (Ns0 - 1), o0 = (j - k) * 16 + k;
#pragma unroll
          for (int p1 = 0; p1 < 4; ++p1)
#pragma unroll
              for (int p0 = 0; p0 < 4; ++p0) { const int idx = o0 + (p1 + 4 * p0) * Ns0, s = idx + (idx >> 4); bufA[s] = xa[4 * p1 + p0]; bufB[s] = xb[4 * p1 + p0]; } }
        __syncthreads();
        const int Ns = Ns0 * 16, k = j & (Ns - 1);
#pragma unroll
        for (int q = 0; q < 16; ++q) { const int idx = j + TP * q, s = idx + (idx >> 4); xa[q] = bufA[s]; xb[q] = bufB[s]; }
        const f32x2 w1 = twg[k * (256 / Ns)]; f32x2 w = w1;
#pragma unroll
        for (int q = 1; q < 16; ++q) { xa[q] = cmul(xa[q], w); xb[q] = cmul(xb[q], w); w = cmul(w, w1); }
        dft16(xa); dft16(xb);
        __syncthreads();
    }
    const bool special = (mA == 0);
    if (LOG2N == 8 || (item & 15) == 0) {
        if (special) {
#pragma unroll
            for (int p1 = 0; p1 < 4; ++p1)
#pragma unroll
                for (int p0 = 0; p0 < 4; ++p0) { const int idx = j + TP * (p1 + 4 * p0); bufA[idx + (idx >> 4)] = xa[4 * p1 + p0]; } }
        __syncthreads();
        if (special) {
#pragma unroll
            for (int p1 = 0; p1 < 4; ++p1)
#pragma unroll
                for (int p0 = 0; p0 < 4; ++p0) { const int idx = j + TP * (p1 + 4 * p0), mi = (N - idx) & (N - 1); const f32x2 zr = bufA[mi + (mi >> 4)], z = xa[4 * p1 + p0];
                    xa[4 * p1 + p0] = (f32x2){(z.x + zr.x) * 0.5f, (z.y + zr.y) * 0.5f}; } }
        __syncthreads();
    }
#pragma unroll
    for (int p1 = 0; p1 < 4; ++p1)
#pragma unroll
        for (int p0 = 0; p0 < 4; ++p0) { const int idx = j + TP * (p1 + 4 * p0), mi = (N - idx) & (N - 1); const f32x2 za = xa[4 * p1 + p0], zb = xb[4 * p1 + p0];
            bf16* orow = CAT + (size_t)(rbase + idx) * DM + 1536 + 128 * h; bf16* mrow = CAT + (size_t)(rbase + mi) * DM + 1536 + 128 * h;
            if (special) { orow[0] = (bf16)f2bf(za.x * norm); orow[64] = (bf16)f2bf(za.y * norm); orow[1] = (bf16)f2bf(zb.x * norm); mrow[127] = (bf16)f2bf(zb.x * norm); }
            else { *(unsigned*)(orow + mA) = pk2(za.x * norm, zb.x * norm); mrow[128 - mA] = (bf16)f2bf(za.x * norm); mrow[127 - mA] = (bf16)f2bf(zb.x * norm); } }
}
#ifndef UP_ALIGN
#define UP_ALIGN true
#endif
#ifndef UP_SP2
#define UP_SP2 true
#endif

#ifndef NLAYER_RUN
#define NLAYER_RUN DEPTH
#endif
constexpr int N_PRO = 3, PH_PER_LAYER = 13, N_PHASES = N_PRO + DEPTH * PH_PER_LAYER;

__device__ __forceinline__ void ffn_up(Frame& F, int lf, int skip_epi) {
    pg8::Gemm g{(const bf16*)(F.ws + WS_H), (const bf16*)(F.ws + WS_WI) + (size_t)lf * 2 * DFF * DM, R, 2 * DFF, DM}; pg8::StaticOrderT<R, 2 * DFF, DM> S; S.init(F.G, F.bid);
    pg8::EpiSwiglu E{(bf16*)(F.ws + WS_ACT), DFF, skip_epi};
    pg8::gemm_phase<pg8::EpiSwiglu, pg8::StaticOrderT<R, 2 * DFF, DM>, UP_ALIGN, UP_SP2, DM>(F.lds, g, S, E);
}
template <int K, int NS> __device__ __forceinline__ void gemm_to_y(Frame& F, const bf16* A, const bf16* Bt) {
    pg8::Gemm g{A, Bt, R, DM, K}; pg8::SplitTailOrder<K, NS> S; S.init(F.G, F.bid);
    pg8::EpiYSplit E{(bf16*)(F.ws + WS_Y), (float*)(F.ws + WS_YP), DM};
    pg8::gemm_phase<pg8::EpiYSplit, pg8::SplitTailOrder<K, NS>, true, true, K>(F.lds, g, S, E);
}

__global__ void __launch_bounds__(NTHR, 2) fwd_kernel(Args args) {
    extern __shared__ __attribute__((aligned(16))) unsigned char lds_raw[];
    Frame F;
    F.lds = (LAS unsigned char*)lds_raw;
    F.tid = threadIdx.x; F.lane = F.tid & 63; F.wave = __builtin_amdgcn_readfirstlane(F.tid >> 6);
    F.G = gridDim.x; F.bid = blockIdx.x;
    F.out = args.out; F.ws = args.ws;
    volatile LAS unsigned* MISC = (volatile LAS unsigned*)(F.lds + MISC_OFF);
    if (F.tid < 32) MISC[F.tid] = 0u;
    __syncthreads();
    unsigned* ctl = (unsigned*)(F.ws + WS_CTL);
#if MK_PER_PHASE
    XcdBarrier bar; bar.bar = ctl + CW_BAR; bar.x = 0; bar.st = nullptr;
#define GRID_BAR() do { } while (0)
#else
    XcdBarrier bar = xcd_barrier_post(ctl + CW_BAR, MISC + 8);
#define GRID_BAR() xcd_barrier(bar)
#endif
    const int lo = args.ph_lo, hi = args.ph_hi;
    int ph = 0;
#ifndef BG_CONV
#define BG_CONV 1
#endif
#ifndef PROBE_SKIPEPI
#define PROBE_SKIPEPI 0
#endif
#ifndef PROBE_DUP
#define PROBE_DUP 0
#endif
#define PHASE(id, ...) if (ph >= lo && ph < hi) { { int t_ = threadIdx.x; asm volatile("" : "+v"(t_)); F.tid = t_; F.lane = t_ & 63; F.wave = __builtin_amdgcn_readfirstlane(t_ >> 6); } \
        { const int rep = 0; (void)rep; __VA_ARGS__; } if (PROBE_DUP != 0 && PROBE_DUP == (id)) { GRID_BAR(); { const int rep = 1; (void)rep; __VA_ARGS__; } } if (ph + 1 < hi) GRID_BAR(); } ++ph;

    PHASE(5, p0a(F, args))
    PHASE(10, p0b(F, args))
    const float* COMB = (const float*)(F.ws + WS_COMB);
    PHASE(0, norm_phase(F, args, true, false, 0, COMB + (size_t)12 * 9 * DM, 1.0f, true, false))

#pragma unroll 1
    for (int l = 0; l < NLAYER_RUN; ++l) {
        PHASE(1, { ffn_up(F, l * 2 + 0, (PROBE_SKIPEPI && rep && lo == 0) ? 1 : 0); if (BG_CONV && l < DEPTH - 1) bg_site(F, args, l + 1, BGB_UP1, 216, BG_UP); })
        PHASE(2, { gemm_to_y<DFF, 11>(F, (const bf16*)(F.ws + WS_ACT), (const bf16*)(F.ws + WS_WO) + (size_t)(l * 2 + 0) * DM * DFF); if (BG_CONV && l < DEPTH - 1) bg_site(F, args, l + 1, BGB_DN1, 176, BG_DN); })
        PHASE(11, norm_phase(F, args, l == 0, true, 11, COMB + (size_t)(l * 3 + 0) * 9 * DM, rep ? 0.0f : 1.0f, true, false))
        PHASE(3, {
            pg8::Gemm g{(const bf16*)(F.ws + WS_H), (const bf16*)(F.ws + WS_WIN) + (size_t)l * DIN * DM, R, DIN, DM}; pg8::StaticOrderT<R, DIN, DM> S; S.init(F.G, F.bid);
            pg8::EpiBf16<0> E{(bf16*)(F.ws + WS_P), DIN, nullptr, 0, 0, 1.f};
            pg8::gemm_phase<pg8::EpiBf16<0>, pg8::StaticOrderT<R, DIN, DM>, true, true, DM>(F.lds, g, S, E);
            if (BG_CONV && l < DEPTH - 1) bg_site(F, args, l + 1, BGB_IN, 118, BG_IN);
        })
        PHASE(6, {
            constexpr int W_ATT = 272, W_CFFT = W_ATT + 8, W_FFT = W_CFFT + 128, W_CONV = W_FFT + R / 16, W_SG = W_CONV + 32 * 9, W_END = W_SG;
            unsigned* qhead = ctl + CW_QUEUE + 64 * (l + 4 * rep);
            int it = F.bid;
            unsigned nxt = 0u;
            if (F.tid == 0) nxt = __hip_atomic_fetch_add(qhead, 1u, __ATOMIC_RELAXED, __HIP_MEMORY_SCOPE_AGENT) + (unsigned)F.G;
            while (it < W_END) {
                { int t_ = threadIdx.x; asm volatile("" : "+v"(t_)); F.tid = t_; F.lane = t_ & 63; F.wave = __builtin_amdgcn_readfirstlane(t_ >> 6); }
                if (it < W_ATT) { _Pragma("unroll 1") for (int rr = 0; rr < (PROBE_DUP == 61 ? 2 : 1); ++rr) attn_item_mfma(F, args, l, it); }
                else if (it < W_CFFT) fft_item<8>(F, args, it - W_ATT);
                else if (it < W_FFT) { _Pragma("unroll 1") for (int rr = 0; rr < (PROBE_DUP == 62 ? 2 : 1); ++rr) fft_item<12>(F, args, it - W_CFFT); }
                else if (it < W_CONV) { _Pragma("unroll 1") for (int rr = 0; rr < (PROBE_DUP == 63 ? 2 : 1); ++rr) conv_tile_v1(F, args, l, it - W_FFT); }
                else { ssm_gemm_item<0>(F, args, l, it - W_CONV); if (PROBE_DUP == 64) ssm_gemm_item<0>(F, args, l, it - W_CONV); }
                if (threadIdx.x == 0) MISC[0] = nxt;
                __syncthreads();
                it = __builtin_amdgcn_readfirstlane((int)MISC[0]);
                if (threadIdx.x == 0 && it < W_END) nxt = __hip_atomic_fetch_add(qhead, 1u, __ATOMIC_RELAXED, __HIP_MEMORY_SCOPE_AGENT) + (unsigned)F.G;
            }
            __syncthreads();
        })
        PHASE(7, {
            for (int it = F.bid; it < 128; it += F.G) ssm_carry_task(F, l, it);
            __syncthreads();
            if (BG_CONV && l < DEPTH - 1) bg_site(F, args, l + 1, BGB_CA, 128, BG_CA);
        })
        PHASE(8, {
            for (int it = F.bid; it < 32 * 8; it += F.G) {
                const int g = it & 31, rt = it >> 5;
                if (rt < 7) ssm_gemm_rows<1, 4>(F, args, l, g, rt * 64); else ssm_gemm_rows<1, 6>(F, args, l, g, 448);
            }
            __syncthreads();
        })
        PHASE(9, {
            for (int it = F.bid; it < 256; it += F.G) glu_item(F, args, l, it);
            __syncthreads();
        })
        PHASE(4, { gemm_to_y<DM, 4>(F, (const bf16*)(F.ws + WS_CAT), (const bf16*)(F.ws + WS_WOUT) + (size_t)l * DM * DM); if (BG_CONV && l < DEPTH - 1) bg_site(F, args, l + 1, BGB_OUT, 64, BG_OUT); })
        PHASE(11, norm_phase(F, args, false, true, 4, COMB + (size_t)(l * 3 + 1) * 9 * DM, rep ? 0.0f : 1.0f, true, false))
        PHASE(1, { ffn_up(F, l * 2 + 1, (PROBE_SKIPEPI && rep && lo == 0) ? 1 : 0); if (BG_CONV && l < DEPTH - 1) bg_site(F, args, l + 1, BGB_UP2, 216, BG_UP); })
        PHASE(2, { gemm_to_y<DFF, 11>(F, (const bf16*)(F.ws + WS_ACT), (const bf16*)(F.ws + WS_WO) + (size_t)(l * 2 + 1) * DM * DFF); if (BG_CONV && l < DEPTH - 1) bg_site(F, args, l + 1, BGB_DN2, 176, BG_DN); })
        PHASE(11, {
            const bool last = (l == DEPTH - 1);
            if (BG_CONV && !last) bg_drain(F, args, l + 1);
            norm_phase(F, args, false, true, 11, COMB + (size_t)(l * 3 + 2) * 9 * DM, rep ? 0.0f : 1.0f, !last, last);
        })
    }
}

extern "C" void kernel_launch(void* const* d_in, const int* in_sizes, int n_in, void* d_out, int out_size, void* d_ws, size_t ws_size, hipStream_t stream) {
    static int grid = 0;
    if (grid == 0) {
        if (n_in != 26 || in_sizes[0] != R_LAT * DM || out_size != R_LAT * DM || ws_size < WS_END) {
            fprintf(stderr, "kernel_launch: unexpected shapes: n_in %d in0 %d out %d ws %zu (need %zu)\n", n_in, n_in > 0 ? in_sizes[0] : -1, out_size, ws_size, (size_t)WS_END); grid = -1; return; }
        int dev = 0, cus = 0, per_cu = 0;
        if (hipGetDevice(&dev) != hipSuccess || hipDeviceGetAttribute(&cus, hipDeviceAttributeMultiprocessorCount, dev) != hipSuccess) { fprintf(stderr, "kernel_launch: device query failed\n"); grid = -1; return; }
        if (hipFuncSetAttribute((const void*)fwd_kernel, hipFuncAttributeMaxDynamicSharedMemorySize, LDS_BYTES) != hipSuccess) { fprintf(stderr, "kernel_launch: hipFuncSetAttribute failed\n"); grid = -1; return; }
        if (hipOccupancyMaxActiveBlocksPerMultiprocessor(&per_cu, (const void*)fwd_kernel, NTHR, LDS_BYTES) != hipSuccess || per_cu < 1)
            fprintf(stderr, "kernel_launch: note: occupancy query reports %d workgroups per CU\n", per_cu);
        (void)hipGetLastError();
        grid = cus;
    }
    if (grid < 0) return;
    if (hipMemsetAsync((char*)d_ws + WS_CTL, 0, CTL_ZERO_BYTES, stream) != hipSuccess) { fprintf(stderr, "kernel_launch: memset failed\n"); return; }
    Args a{};
    for (int i = 0; i < 26; ++i) a.in[i] = (const float*)d_in[i];
    a.out = (float*)d_out; a.ws = (unsigned char*)d_ws;
#if MK_PER_PHASE
    for (int p = 0; p < N_PHASES; ++p) { a.ph_lo = p; a.ph_hi = p + 1; hipLaunchKernelGGL(fwd_kernel, dim3(grid), dim3(NTHR), LDS_BYTES, stream, a); }
#else
    a.ph_lo = 0; a.ph_hi = N_PHASES;
    hipLaunchKernelGGL(fwd_kernel, dim3(grid), dim3(NTHR), LDS_BYTES, stream, a);
#endif
    const hipError_t le = hipPeekAtLastError();
    if (le != hipSuccess) fprintf(stderr, "kernel_launch: launch failed: %s\n", hipGetErrorName(le));
}
```

```cpp
#include <hip/hip_runtime.h>
#include <cstdio>
#include <cstdint>
namespace pg8 {
#define PG8_LAS __attribute__((address_space(3)))
typedef unsigned short bf16_t;
typedef short bf16x8 __attribute__((ext_vector_type(8)));
typedef float f32x4 __attribute__((ext_vector_type(4)));
typedef unsigned u32x4 __attribute__((ext_vector_type(4)));
constexpr int BM = 256, BK = 64, HALF = 128, HTB = HALF * BK * 2  , STAGE_BYTES = 8 * HTB, NXCD = 8, WGM = 8;

__host__ __device__ __forceinline__ int lds_byte(int r, int c) { const int st = (r >> 4) * 2 + (c >> 5), rr = r & 15, cc = c & 31, ob = rr * 64 + cc * 2; return st * 1024 + (ob ^ (((ob >> 9) & 1) << 5)); }
__host__ __device__ __forceinline__ void stage_rc(int b, int& R, int& C) { const int st = b / 1024, sb = b % 1024, swz = sb ^ (((sb >> 9) & 1) << 5); R = (st >> 1) * 16 + swz / 64; C = (st & 1) * 32 + (swz % 64) / 2; }
__host__ __device__ __forceinline__ int perm32(int rho) { const int n = rho >> 4, i = rho & 15; return 8 * (i >> 2) + 4 * n + (i & 3); }

struct Unit { int pm, pn, k0, nt, ks; };
struct Gemm { const bf16_t* A; const bf16_t* Bt; int M, N, K; };

struct StaticOrder {
    int nM, nN, nwg, G, c, ntf;
    __host__ __device__ void init(int M, int N, int K, int G_, int c_) { nM = M / BM; nN = N / BM; nwg = nM * nN; G = G_; c = c_; ntf = K / BK; }
    __host__ __device__ __forceinline__ bool next(int i, Unit& u) const {
        const long L = (long)i * G + c; if (L >= nwg) return false;
        int wgid = (int)L; { const int q = nwg / NXCD, r = nwg % NXCD, xcd = wgid % NXCD, off = wgid / NXCD; wgid = (xcd < r ? xcd * (q + 1) : r * (q + 1) + (xcd - r) * q) + off; }
        const int nig = WGM * nN, gid = wgid / nig, fm = gid * WGM, gsz = (nM - fm) < WGM ? (nM - fm) : WGM;
        u.pm = fm + ((wgid % nig) % gsz); u.pn = (wgid % nig) / gsz; u.k0 = 0; u.nt = ntf; u.ks = 0; return true;
    }
    __device__ __forceinline__ void a_ready(const Unit&) const {}
    __device__ __forceinline__ void done(const Unit&) const {}
};

template <int M_, int N_, int K_> struct StaticOrderT {
    int G, c;
    __host__ __device__ void init(int G_, int c_) { G = G_; c = c_; }
    __host__ __device__ __forceinline__ bool next(int i, Unit& u) const {
        constexpr int nM = M_ / BM, nN = N_ / BM, nwg = nM * nN;
        const long L = (long)i * G + c; if (L >= nwg) return false;
        int wgid = (int)L; { constexpr int q = nwg / NXCD, r = nwg % NXCD; const int xcd = wgid % NXCD, off = wgid / NXCD; wgid = (xcd < r ? xcd * (q + 1) : r * (q + 1) + (xcd - r) * q) + off; }
        constexpr int nig = WGM * nN; const int gid = wgid / nig, fm = gid * WGM, gsz = (nM - fm) < WGM ? (nM - fm) : WGM;
        u.pm = fm + ((wgid % nig) % gsz); u.pn = (wgid % nig) / gsz; u.k0 = 0; u.nt = K_ / BK; u.ks = 0; return true;
    }
    __device__ __forceinline__ void a_ready(const Unit&) const {}
    __device__ __forceinline__ void done(const Unit&) const {}
};
template <int K_, int NS> struct SplitTailOrder {
    int G, c;
    __host__ __device__ void init(int G_, int c_) { G = G_; c = c_; }
    __host__ __device__ __forceinline__ bool next(int i, Unit& u) const {
        constexpr int ntsub = K_ / BK / NS, nN = 8, nwg = 256, nig = WGM * nN;
        const int L = i * G + c;
        if (L >= 256 + 16 * NS) return false;
        const bool tail = L >= 256;
        const int Lc = tail ? 0 : L; const int wgid = (Lc % NXCD) * (nwg / NXCD) + Lc / NXCD;
        const int gid = wgid / nig, fm = gid * WGM; const int pm0 = fm + ((wgid % nig) % WGM), pn0 = (wgid % nig) / WGM;
        const int j = tail ? L - 256 : 0, tile = j / NS, ks = j % NS;
        u.pm = tail ? 32 + tile / 8 : pm0; u.pn = tail ? tile % 8 : pn0; u.ks = tail ? ks : 0; u.nt = tail ? ntsub : K_ / BK; u.k0 = tail ? ks * ntsub * BK : 0;
        return true;
    }
    __device__ __forceinline__ void a_ready(const Unit&) const {}
    __device__ __forceinline__ void done(const Unit&) const {}
};

__device__ __forceinline__ unsigned cvt_pk_bf16(float lo, float hi) { unsigned r; asm volatile("v_cvt_pk_bf16_f32 %0, %1, %2" : "=v"(r) : "v"(lo), "v"(hi)); return r; }
typedef float f32x2 __attribute__((ext_vector_type(2)));
__device__ __forceinline__ f32x2 gelu_pk(f32x2 v) {
    const f32x2 av = __builtin_elementwise_abs(v), d = av * 0.2316418882f + 1.0f;
    f32x2 t; t.x = __builtin_amdgcn_rcpf(d.x); t.y = __builtin_amdgcn_rcpf(d.y);
    f32x2 q = t * 0.5307027145f + (-0.7265760135f); q = q * t + 0.7107068705f; q = q * t + (-0.142248368f); q = q * t + 0.127414796f; q = q * t;
    const f32x2 s = (v * v) * (-0.72134752044f);
    f32x2 e; e.x = __builtin_amdgcn_exp2f(s.x); e.y = __builtin_amdgcn_exp2f(s.y);
    const f32x2 m = v * (q * e), r = v - m;
    f32x2 o; o.x = v.x < 0.f ? m.x : r.x; o.y = v.y < 0.f ? m.y : r.y; return o;
}

template <int ACT  > struct EpiBf16 {
    static constexpr bool PERM = true, AFTER_DRAIN = false; static_assert(ACT == 0 || ACT == 1, "EpiBf16: ACT is 0 (none) or 1 (gelu_pk)");
    bf16_t* O; int ldc; const float* bias; int split_cols; size_t split_stride; float scale0;
    __device__ __forceinline__ void operator()(const f32x4 (&acc)[2][2][4][2], const Unit& u, int wr, int wc, int fr, int fq) const {
        const int row0 = u.pm * BM + wr * 64 + fr; int colt = u.pn * BM; bf16_t* base = O;
        float sc = 1.f; if (split_cols) { const int t = colt / split_cols; base += (size_t)t * split_stride; colt -= t * split_cols; if (t == 0) sc = scale0; }
        const int col0 = colt + wc * 32 + 8 * fq, bcol0 = u.pn * BM + wc * 32 + 8 * fq;
        f32x4 bv[2][2];
#pragma unroll
        for (int bj = 0; bj < 2; ++bj)
#pragma unroll
            for (int n = 0; n < 2; ++n) bv[bj][n] = bias ? *(const f32x4*)(bias + bcol0 + bj * HALF + 4 * n) : (f32x4){0.f, 0.f, 0.f, 0.f};
#pragma unroll
        for (int ai = 0; ai < 2; ++ai)
#pragma unroll
            for (int m = 0; m < 4; ++m) { bf16_t* rowp = base + (size_t)(row0 + ai * HALF + m * 16) * ldc + col0;
#pragma unroll
                for (int bj = 0; bj < 2; ++bj) { f32x4 v0 = acc[ai][bj][m][0] + bv[bj][0], v1 = acc[ai][bj][m][1] + bv[bj][1];
                    if (ACT == 1) { f32x2 a = gelu_pk((f32x2){v0[0], v0[1]}), b = gelu_pk((f32x2){v0[2], v0[3]}), c = gelu_pk((f32x2){v1[0], v1[1]}), d = gelu_pk((f32x2){v1[2], v1[3]});
                        v0 = (f32x4){a.x, a.y, b.x, b.y}; v1 = (f32x4){c.x, c.y, d.x, d.y}; }
                    v0 = v0 * sc; v1 = v1 * sc; u32x4 w; w.x = cvt_pk_bf16(v0[0], v0[1]); w.y = cvt_pk_bf16(v0[2], v0[3]); w.z = cvt_pk_bf16(v1[0], v1[1]); w.w = cvt_pk_bf16(v1[2], v1[3]);
                    *(u32x4*)(rowp + bj * HALF) = w; } }
    }
};
struct EpiF32 {
    static constexpr bool PERM = false, AFTER_DRAIN = false;
    float* C; int ldc; const float* bias;
    __device__ __forceinline__ void operator()(const f32x4 (&acc)[2][2][4][2], const Unit& u, int wr, int wc, int fr, int fq) const {
        const int row0 = u.pm * BM + wr * 64 + fr, col0 = u.pn * BM + wc * 32 + 4 * fq;
        f32x4 bv[2][2];
#pragma unroll
        for (int bj = 0; bj < 2; ++bj)
#pragma unroll
            for (int n = 0; n < 2; ++n) bv[bj][n] = bias ? *(const f32x4*)(bias + col0 + bj * HALF + n * 16) : (f32x4){0.f, 0.f, 0.f, 0.f};
#pragma unroll
        for (int ai = 0; ai < 2; ++ai)
#pragma unroll
            for (int m = 0; m < 4; ++m) { float* rowp = C + (size_t)(row0 + ai * HALF + m * 16) * ldc + col0;
#pragma unroll
                for (int bj = 0; bj < 2; ++bj)
#pragma unroll
                    for (int n = 0; n < 2; ++n) *(f32x4*)(rowp + bj * HALF + n * 16) = acc[ai][bj][m][n] + bv[bj][n]; }
    }
};
__device__ __forceinline__ void store16_wt(void* p, u32x4 v) { asm volatile("global_store_dwordx4 %0, %1, off sc1\n\ts_nop 1" :: "v"(p), "v"(v) : "memory");     }
#ifndef NT_ACT
#define NT_ACT 0
#endif
struct EpiSwiglu {
    static constexpr bool PERM = true, AFTER_DRAIN = false;
    bf16_t* O; int ldc; int skip;
    __device__ __forceinline__ void operator()(const f32x4 (&acc)[2][2][4][2], const Unit& u, int wr, int wc, int fr, int fq) const {
        if (skip) return;
        const int row0 = u.pm * BM + wr * 64 + fr, col0 = u.pn * HALF + wc * 32 + 8 * fq;
#pragma unroll
        for (int ai = 0; ai < 2; ++ai)
#pragma unroll
            for (int m = 0; m < 4; ++m) { bf16_t* rowp = O + (size_t)(row0 + ai * HALF + m * 16) * ldc + col0;
                float v[8];
#pragma unroll
                for (int n = 0; n < 2; ++n)
#pragma unroll
                    for (int j = 0; j < 4; ++j) { const float g = acc[ai][0][m][n][j], up = acc[ai][1][m][n][j];
                        v[n * 4 + j] = g * __builtin_amdgcn_rcpf(1.0f + __expf(-g)) * up; }
                u32x4 w; w.x = cvt_pk_bf16(v[0], v[1]); w.y = cvt_pk_bf16(v[2], v[3]); w.z = cvt_pk_bf16(v[4], v[5]); w.w = cvt_pk_bf16(v[6], v[7]);
                if (NT_ACT) __builtin_nontemporal_store(w, (u32x4*)rowp); else *(u32x4*)rowp = w; }
    }
};
struct EpiGlu {
    static constexpr bool PERM = true, AFTER_DRAIN = false;
    const bf16_t* YG; int ldy; bf16_t* O; int ldc; const float* bias;
    __device__ __forceinline__ void operator()(const f32x4 (&acc)[2][2][4][2], const Unit& u, int wr, int wc, int fr, int fq) const {
        const int row0 = u.pm * BM + wr * 64 + fr, col0 = u.pn * BM + wc * 32 + 8 * fq;
#pragma unroll
        for (int ai = 0; ai < 2; ++ai)
#pragma unroll
            for (int m = 0; m < 4; ++m) { const int row = row0 + ai * HALF + m * 16;
#pragma unroll
                for (int bj = 0; bj < 2; ++bj) { const int c = col0 + bj * HALF;
                    const u32x4 y = *(const u32x4*)(YG + (size_t)row * ldy + c);
                    const f32x4 b0 = *(const f32x4*)(bias + c), b1 = *(const f32x4*)(bias + c + 4);
                    const f32x4 z0 = acc[ai][bj][m][0] + b0, z1 = acc[ai][bj][m][1] + b1;
                    float v[8];
                    v[0] = __builtin_bit_cast(float, y.x << 16); v[1] = __builtin_bit_cast(float, y.x & 0xffff0000u); v[2] = __builtin_bit_cast(float, y.y << 16); v[3] = __builtin_bit_cast(float, y.y & 0xffff0000u);
                    v[4] = __builtin_bit_cast(float, y.z << 16); v[5] = __builtin_bit_cast(float, y.z & 0xffff0000u); v[6] = __builtin_bit_cast(float, y.w << 16); v[7] = __builtin_bit_cast(float, y.w & 0xffff0000u);
#pragma unroll
                    for (int j = 0; j < 4; ++j) { v[j] *= __builtin_amdgcn_rcpf(1.0f + __expf(-z0[j])); v[4 + j] *= __builtin_amdgcn_rcpf(1.0f + __expf(-z1[j])); }
                    u32x4 w; w.x = cvt_pk_bf16(v[0], v[1]); w.y = cvt_pk_bf16(v[2], v[3]); w.z = cvt_pk_bf16(v[4], v[5]); w.w = cvt_pk_bf16(v[6], v[7]);
                    *(u32x4*)(O + (size_t)row * ldc + c) = w; } }
    }
};
#ifndef NT_Y
#define NT_Y 0
#endif
struct EpiYSplit {
    static constexpr bool PERM = true, AFTER_DRAIN = false;
    bf16_t* C; float* CP; int ldc;
    __device__ __forceinline__ void operator()(const f32x4 (&acc)[2][2][4][2], const Unit& u, int wr, int wc, int fr, int fq) const {
        const int row0 = u.pm * BM + wr * 64 + fr, col0 = u.pn * BM + wc * 32 + 8 * fq;
        if (u.pm < 32) {
#pragma unroll
            for (int ai = 0; ai < 2; ++ai)
#pragma unroll
                for (int m = 0; m < 4; ++m) { bf16_t* rowp = C + (size_t)(row0 + ai * HALF + m * 16) * ldc + col0;
#pragma unroll
                    for (int bj = 0; bj < 2; ++bj) { const f32x4 v0 = acc[ai][bj][m][0], v1 = acc[ai][bj][m][1];
                        u32x4 w; w.x = cvt_pk_bf16(v0[0], v0[1]); w.y = cvt_pk_bf16(v0[2], v0[3]); w.z = cvt_pk_bf16(v1[0], v1[1]); w.w = cvt_pk_bf16(v1[2], v1[3]);
                        if (NT_Y) __builtin_nontemporal_store(w, (u32x4*)(rowp + bj * HALF)); else *(u32x4*)(rowp + bj * HALF) = w; } }
        } else {
            float* base = CP + ((size_t)u.ks * 512 + (row0 - 8192)) * ldc + col0;
#pragma unroll
            for (int ai = 0; ai < 2; ++ai)
#pragma unroll
                for (int m = 0; m < 4; ++m) { float* rowp = base + (size_t)(ai * HALF + m * 16) * ldc;
#pragma unroll
                    for (int bj = 0; bj < 2; ++bj) { *(f32x4*)(rowp + bj * HALF) = acc[ai][bj][m][0]; *(f32x4*)(rowp + bj * HALF + 4) = acc[ai][bj][m][1]; } }
        }
    }
};

template <class Epi, class Sched, bool ALIGN_EPI = false, bool SP2 = false, int KP = 0>
__device__ __forceinline__ void gemm_phase(PG8_LAS unsigned char* lds, const Gemm g, const Sched& S, const Epi& E) {
    int tid_ = threadIdx.x; asm volatile("" : "+v"(tid_)); const int tid = tid_, wid = __builtin_amdgcn_readfirstlane(tid >> 6), lane = tid & 63, wr = wid >> 2, wc = wid & 3, fr = lane & 15, fq = lane >> 4;
    const int K = KP ? KP : g.K;
    unsigned voffA[2], voffB[2];
#pragma unroll
    for (int i = 0; i < 2; ++i) { int R, C; stage_rc(tid * 16 + i * 8192, R, C); const int Rb = Epi::PERM ? ((R & ~31) + perm32(R & 31)) : R;
        voffA[i] = (unsigned)(R * K + C) * 2u; voffB[i] = (unsigned)(Rb * K + C) * 2u; }
    const size_t kstep = (size_t)(BK * 2);
    const size_t hstep = (size_t)HALF * K * 2;
    const size_t tstep = 2 * hstep;
    const unsigned ldsw = (unsigned)wid * 1024u;
    const int aoff = lds_byte(wr * 64 + fr, fq * 8), boff = lds_byte(wc * 32 + fr, fq * 8);
#define PG8_SA(b, h) (((b) * 2 + (h)) * HTB)
#define PG8_SB(b, h) ((4 + (b) * 2 + (h)) * HTB)
#ifndef PG8_AUX_voffB
#define PG8_AUX_voffB 0
#endif
#define PG8_AUX_voffA 0
#define PG8_STAGE(bufoff, gbase, voff) do { _Pragma("unroll") for (int _i = 0; _i < 2; ++_i) \
        __builtin_amdgcn_global_load_lds((const unsigned*)((const char*)(gbase) + (voff)[_i]), (PG8_LAS unsigned*)(lds + (bufoff) + ldsw + _i * 8192), 16, 0, PG8_AUX_##voff); } while (0)
#define PG8_LDA(dst, b, h) do { _Pragma("unroll") for (int m = 0; m < 4; ++m) _Pragma("unroll") for (int k = 0; k < 2; ++k) dst[m][k] = *(const PG8_LAS bf16x8*)(lds + PG8_SA(b, h) + aoff + m * 2048 + k * 1024); } while (0)
#define PG8_LDB(dst, b, h) do { _Pragma("unroll") for (int n = 0; n < 2; ++n) _Pragma("unroll") for (int k = 0; k < 2; ++k) dst[n][k] = *(const PG8_LAS bf16x8*)(lds + PG8_SB(b, h) + boff + n * 2048 + k * 1024); } while (0)
#define PG8_MMA(ai, bj, At, Bt) do { __builtin_amdgcn_s_setprio(1); _Pragma("unroll") for (int m = 0; m < 4; ++m) _Pragma("unroll") for (int n = 0; n < 2; ++n) _Pragma("unroll") for (int k = 0; k < 2; ++k) \
        acc[ai][bj][m][n] = __builtin_amdgcn_mfma_f32_16x16x32_bf16(Bt[n][k], At[m][k], acc[ai][bj][m][n], 0, 0, 0); __builtin_amdgcn_s_setprio(0); } while (0)
#define PG8_WAIT_V(n) asm volatile("s_waitcnt vmcnt(" #n ")" ::: "memory")
#define PG8_WAIT_L(n) asm volatile("s_waitcnt lgkmcnt(" #n ")" ::: "memory")
#define PG8_BAR __builtin_amdgcn_s_barrier()
#define PG8_SCHED __builtin_amdgcn_sched_barrier(0)
    Unit cur, nxt; int ui = 0;
    if (!S.next(0, cur)) return;
    f32x4 acc[2][2][4][2];
#pragma unroll
    for (int a = 0; a < 2; ++a)
#pragma unroll
        for (int b = 0; b < 2; ++b)
#pragma unroll
            for (int m = 0; m < 4; ++m)
#pragma unroll
                for (int n = 0; n < 2; ++n) acc[a][b][m][n] = (f32x4){0.f, 0.f, 0.f, 0.f};
    bf16x8 At[4][2], B0[2][2], B1[2][2];
    const char* cA = (const char*)g.A + (size_t)cur.pm * tstep + (size_t)cur.k0 * 2; const char* cB = (const char*)g.Bt + (size_t)cur.pn * tstep + (size_t)cur.k0 * 2;
    S.a_ready(cur);
    if constexpr (SP2) {
        PG8_STAGE(PG8_SB(0, 0), cB, voffB); PG8_STAGE(PG8_SB(0, 1), cB + hstep, voffB); PG8_STAGE(PG8_SA(0, 0), cA, voffA); PG8_STAGE(PG8_SA(0, 1), cA + hstep, voffA);
        if (wr == 1) PG8_BAR;
        PG8_WAIT_V(2); PG8_BAR;
        PG8_STAGE(PG8_SB(1, 0), cB + kstep, voffB); PG8_STAGE(PG8_SA(1, 0), cA + kstep, voffA); PG8_STAGE(PG8_SB(1, 1), cB + hstep + kstep, voffB);
        PG8_WAIT_V(6); PG8_BAR;
    } else {
        PG8_STAGE(PG8_SB(0, 0), cB, voffB); PG8_STAGE(PG8_SA(0, 0), cA, voffA); PG8_STAGE(PG8_SB(0, 1), cB + hstep, voffB); PG8_STAGE(PG8_SA(0, 1), cA + hstep, voffA);
        if (wr == 1) PG8_BAR;
        PG8_WAIT_V(4); PG8_BAR;
        PG8_STAGE(PG8_SB(1, 0), cB + kstep, voffB); PG8_STAGE(PG8_SA(1, 0), cA + kstep, voffA); PG8_STAGE(PG8_SB(1, 1), cB + hstep + kstep, voffB);
        PG8_WAIT_V(6); PG8_BAR;
    }
    for (;;) {
        const bool has_next = S.next(ui + 1, nxt);
        const char* nA = has_next ? (const char*)g.A + (size_t)nxt.pm * tstep + (size_t)nxt.k0 * 2 : cA; const char* nB = has_next ? (const char*)g.Bt + (size_t)nxt.pn * tstep + (size_t)nxt.k0 * 2 : cB;
        const int nt = cur.nt;
        for (int t = 0; t < nt; t += 2) {
            const bool last = (t == nt - 2);
            const char* a1 = cA + (size_t)(t + 1) * kstep;
            const char* a2 = last ? nA : cA + (size_t)(t + 2) * kstep; const char* b2 = last ? nB : cB + (size_t)(t + 2) * kstep;
            const char* a3 = a2 + kstep; const char* b3 = b2 + kstep;
            if (last && has_next) S.a_ready(nxt);
            if constexpr (SP2) {
            PG8_LDB(B0, 0, 0); PG8_LDB(B1, 0, 1); PG8_SCHED; PG8_LDA(At, 0, 0); PG8_STAGE(PG8_SA(1, 1), a1 + hstep, voffA);
            PG8_WAIT_V(8); PG8_WAIT_L(0); PG8_BAR; PG8_MMA(0, 0, At, B0); PG8_MMA(0, 1, At, B1); PG8_BAR; PG8_SCHED;
            PG8_LDA(At, 0, 1); PG8_STAGE(PG8_SB(0, 0), b2, voffB); PG8_STAGE(PG8_SB(0, 1), b2 + hstep, voffB); PG8_STAGE(PG8_SA(0, 0), a2, voffA);
            PG8_WAIT_V(8); PG8_WAIT_L(0); PG8_BAR; PG8_MMA(1, 0, At, B0); PG8_MMA(1, 1, At, B1); PG8_BAR; PG8_SCHED;
            PG8_LDB(B0, 1, 0); PG8_LDB(B1, 1, 1); PG8_SCHED; PG8_LDA(At, 1, 0); PG8_STAGE(PG8_SA(0, 1), a2 + hstep, voffA);
            PG8_WAIT_V(8); PG8_WAIT_L(0); PG8_BAR; PG8_MMA(0, 0, At, B0); PG8_MMA(0, 1, At, B1); PG8_BAR; PG8_SCHED;
            PG8_LDA(At, 1, 1); PG8_STAGE(PG8_SB(1, 0), b3, voffB); PG8_STAGE(PG8_SB(1, 1), b3 + hstep, voffB); PG8_STAGE(PG8_SA(1, 0), a3, voffA);
            PG8_WAIT_V(8); PG8_WAIT_L(0); PG8_BAR; PG8_MMA(1, 0, At, B0); PG8_MMA(1, 1, At, B1); PG8_BAR; PG8_SCHED;
            } else {
            PG8_LDB(B0, 0, 0); PG8_SCHED; PG8_LDA(At, 0, 0); PG8_STAGE(PG8_SA(1, 1), a1 + hstep, voffA);
            PG8_WAIT_L(8); PG8_BAR; PG8_WAIT_L(0); PG8_MMA(0, 0, At, B0); PG8_BAR; PG8_SCHED;
            PG8_LDB(B1, 0, 1); PG8_STAGE(PG8_SB(0, 0), b2, voffB);
            PG8_BAR; PG8_WAIT_L(0); PG8_MMA(0, 1, At, B1); PG8_BAR;
            PG8_LDA(At, 0, 1); PG8_STAGE(PG8_SA(0, 0), a2, voffA);
            PG8_BAR; PG8_WAIT_L(0); PG8_MMA(1, 0, At, B0); PG8_BAR; PG8_SCHED;
            PG8_STAGE(PG8_SB(0, 1), b2 + hstep, voffB);
            PG8_WAIT_V(6); PG8_BAR; PG8_MMA(1, 1, At, B1); PG8_BAR;
            PG8_LDB(B0, 1, 0); PG8_SCHED; PG8_LDA(At, 1, 0); PG8_STAGE(PG8_SA(0, 1), a2 + hstep, voffA);
            PG8_WAIT_L(8); PG8_BAR; PG8_WAIT_L(0); PG8_MMA(0, 0, At, B0); PG8_BAR; PG8_SCHED;
            PG8_LDB(B1, 1, 1); PG8_STAGE(PG8_SB(1, 0), b3, voffB);
            PG8_BAR; PG8_WAIT_L(0); PG8_MMA(0, 1, At, B1); PG8_BAR;
            PG8_LDA(At, 1, 1); PG8_STAGE(PG8_SA(1, 0), a3, voffA);
            PG8_BAR; PG8_WAIT_L(0); PG8_MMA(1, 0, At, B0); PG8_BAR; PG8_SCHED;
            PG8_STAGE(PG8_SB(1, 1), b3 + hstep, voffB);
            PG8_WAIT_V(6); PG8_BAR; PG8_MMA(1, 1, At, B1); PG8_BAR;
            }
        }
        if constexpr (ALIGN_EPI) { if (wr == 0) PG8_BAR; }
        if constexpr (!Epi::AFTER_DRAIN) { E(acc, cur, wr, wc, fr, fq); S.done(cur); }
        if (!has_next) break;
#pragma unroll
        for (int a = 0; a < 2; ++a)
#pragma unroll
            for (int b = 0; b < 2; ++b)
#pragma unroll
                for (int m = 0; m < 4; ++m)
#pragma unroll
                    for (int n = 0; n < 2; ++n) acc[a][b][m][n] = (f32x4){0.f, 0.f, 0.f, 0.f};
        cur = nxt; cA = nA; cB = nB; ++ui;
        if constexpr (ALIGN_EPI) { if (wr == 1) PG8_BAR; }
    }
    PG8_WAIT_V(0);
    if constexpr (!ALIGN_EPI) { if (wr == 0) PG8_BAR; }
    PG8_BAR;
    if constexpr (Epi::AFTER_DRAIN) { E.fused(acc, cur, wr, wc, fr, fq, lds, wid, lane); S.done(cur); }
#undef PG8_SA
#undef PG8_SB
#undef PG8_STAGE
#undef PG8_LDA
#undef PG8_LDB
#undef PG8_MMA
#undef PG8_WAIT_V
#undef PG8_WAIT_L
#undef PG8_BAR
#undef PG8_SCHED
}
}
#ifndef MK_PER_PHASE
#define MK_PER_PHASE 0
#endif
constexpr int DM = 2048, NBATCH = 2, SEQ = 4096, DEPTH = 4, CTXL = 256, DFF = 5632, DIN = 2816;
constexpr int R_LAT = NBATCH * SEQ, R_CTX = NBATCH * CTXL, R = R_LAT + R_CTX;
constexpr int K_OFF = 0, V_OFF = 128, SSM_OFF = 256, Q_OFF = 768, CONV_OFF = 1280, FFT_OFF = 2304;
constexpr int MODW = 9 * DM;
constexpr int NWAVES = 8, NTHR = 512;
constexpr int MOD_CHUNKS = 32;

constexpr size_t MiB = 1u << 20;
constexpr size_t WS_CTL = 0, CTL_ZERO_BYTES = 1 * MiB;
constexpr size_t WS_MOD = 1 * MiB;
constexpr size_t WS_ROPE = 2 * MiB;
constexpr size_t WS_TW = WS_ROPE + 65536;
constexpr size_t WS_SSMA = WS_ROPE + 131072;
constexpr size_t WS_SSMBB = 3 * MiB;
constexpr size_t WS_SSMCT = 5 * MiB;
constexpr size_t WS_WFOLD = 7 * MiB;
constexpr size_t WS_MODP = 23 * MiB;
constexpr size_t WS_WI = 50 * MiB;
constexpr size_t WS_WO = WS_WI + 352 * MiB;
constexpr size_t WS_WIN = WS_WO + 176 * MiB;
constexpr size_t WS_WOUT = WS_WIN + 44 * MiB;
constexpr size_t WS_X = WS_WOUT + 32 * MiB;
constexpr size_t WS_H = WS_X + 68 * MiB;
constexpr size_t WS_ACT = WS_H + 34 * MiB;
constexpr size_t WS_Y = WS_ACT + 94 * MiB;
constexpr size_t WS_P = WS_Y + 68 * MiB;
constexpr size_t WS_CAT = WS_P + 47 * MiB;
constexpr size_t WS_SSMWS = WS_CAT + 34 * MiB;
constexpr size_t WS_SSMWY = WS_SSMWS + 16 * MiB;
constexpr size_t WS_SSMS = WS_SSMWY + 32 * MiB;
constexpr size_t WS_POW = WS_SSMS + 17 * MiB;
constexpr size_t WS_YG = WS_POW + 9 * MiB;
constexpr size_t WS_GLUW = WS_YG + 9 * MiB;
constexpr size_t WS_A16 = WS_GLUW + 2 * MiB;
constexpr size_t WS_ET = WS_A16 + 256 * 1024;
constexpr size_t WS_YP = WS_A16 + 1 * MiB;
constexpr size_t WS_COMB = WS_YP + 44 * MiB;
constexpr size_t WS_END = WS_COMB + 1 * MiB;
constexpr int NCR = R / 16;
constexpr int CW_CONVQ = 10240, CW_DONE = 12288;
constexpr int CW_QUEUE = 8192;
constexpr int CW_BAR = 4096;

constexpr int RING_BYTES = 131072;
constexpr int MISC_OFF = 147456 - 256;
constexpr int LDS_BYTES = 147456;

#define GAS __attribute__((address_space(1)))
#define LAS __attribute__((address_space(3)))
typedef unsigned short bf16;
typedef unsigned v4u __attribute__((ext_vector_type(4)));
typedef unsigned v2u __attribute__((ext_vector_type(2)));
typedef float f32x4 __attribute__((ext_vector_type(4)));
typedef float f32x2 __attribute__((ext_vector_type(2)));
#define LDS_WAIT() asm volatile("s_waitcnt lgkmcnt(0)" ::: "memory")
#define VM_WAIT() asm volatile("s_waitcnt vmcnt(0)" ::: "memory")
typedef float f32x2cv __attribute__((ext_vector_type(2))); typedef __bf16 bf16x2cv __attribute__((ext_vector_type(2)));
__device__ __forceinline__ unsigned pk2(float lo, float hi) { const f32x2cv v = {lo, hi}; return __builtin_bit_cast(unsigned, __builtin_convertvector(v, bf16x2cv)); }
__device__ __forceinline__ unsigned f2bf(float f) { return pk2(f, 0.0f) & 0xffffu; }
__device__ __forceinline__ float bflo(unsigned w) { return __builtin_bit_cast(float, w << 16); }
__device__ __forceinline__ float bfhi(unsigned w) { return __builtin_bit_cast(float, w & 0xffff0000u); }
__device__ __forceinline__ float bf1(bf16 v) { return __builtin_bit_cast(float, (unsigned)v << 16); }
__device__ __forceinline__ float sigmoidf_(float x) { return __builtin_amdgcn_rcpf(1.0f + __expf(-x)); }
__device__ __forceinline__ float wave_sum(float v) {
#pragma unroll
    for (int o = 1; o < 64; o <<= 1) v += __shfl_xor(v, o);
    return v;
}

#define XB_TMO      128
#define XB_XCNT(j)  (256  + 64 * (j))
#define XB_XSUB(j)  (1280 + 64 * (j))
#define XB_XGEN(j)  (2304 + 64 * (j))
#define XB_TOP      3328
#define XB_TOPGEN   3392
#define XCD_BAR_WORDS 3456
#define XB_SPIN_CAP (1u << 18)

__device__ __forceinline__ unsigned xb_ld(unsigned* p)              { return __hip_atomic_load(p, __ATOMIC_RELAXED, __HIP_MEMORY_SCOPE_AGENT); }
__device__ __forceinline__ unsigned xb_add(unsigned* p, unsigned v) { return __hip_atomic_fetch_add(p, v, __ATOMIC_RELAXED, __HIP_MEMORY_SCOPE_AGENT); }
__device__ __forceinline__ unsigned xb_xcc_id() { return (unsigned)__builtin_amdgcn_s_getreg((3 << 11) | 20) & 0xFu; }
#define XB_SPIN(cond, bar) do { unsigned _sp = 0; while (cond) { __builtin_amdgcn_s_sleep(1); \
    if ((++_sp & 255u) == 0u) { if (xb_ld(&(bar)[XB_TMO])) break; if (_sp > XB_SPIN_CAP) { atomicAdd(&(bar)[XB_TMO], 1u); break; } } } } while (0)

struct XcdBarrier {
    unsigned* bar; unsigned x;
    volatile LAS unsigned* st;
};

__device__ __forceinline__ XcdBarrier xcd_barrier_post(unsigned* bar, volatile LAS unsigned* st) {
    XcdBarrier b; b.bar = bar; b.x = xb_xcc_id(); b.st = st;
    if (threadIdx.x == 0) (void)xb_add(&bar[XB_XCNT(b.x)], 1u);
    return b;
}
__device__ __forceinline__ void xcd_barrier_complete(unsigned* bar, unsigned x, unsigned& nloc, unsigned& nx) {
    const unsigned G = gridDim.x * gridDim.y * gridDim.z;
    unsigned sum, cnt, mine, sp = 0u;
    for (;;) {
        sum = 0u; cnt = 0u; mine = 0u;
#pragma unroll
        for (unsigned j = 0; j < 16; ++j) { const unsigned c = xb_ld(&bar[XB_XCNT(j)]); sum += c; cnt += (c > 0u) ? 1u : 0u; mine = (j == x) ? c : mine; }
        if (sum == G) break;
        __builtin_amdgcn_s_sleep(1);
        if ((++sp & 255u) == 0u) { if (xb_ld(&bar[XB_TMO])) break; if (sp > XB_SPIN_CAP) { atomicAdd(&bar[XB_TMO], 1u); break; } }
    }
    nloc = mine > 0u ? mine : 1u; nx = cnt > 0u ? cnt : 1u;
}

__device__ __forceinline__ void xcd_barrier(const XcdBarrier& b) {
    asm volatile("s_waitcnt vmcnt(0)" ::: "memory");
    __syncthreads();
    if (threadIdx.x == 0) {
        unsigned* bar = b.bar;
        __builtin_amdgcn_s_waitcnt(0);
        unsigned nloc = b.st[0], nx = b.st[1];
        if (nloc == 0u) { xcd_barrier_complete(bar, b.x, nloc, nx); b.st[0] = nloc; b.st[1] = nx; }
        const unsigned old = xb_add(&bar[XB_XSUB(b.x)], 1u);
        const unsigned gen = old / nloc;
        if (old + 1u == (gen + 1u) * nloc) {
            __builtin_amdgcn_fence(__ATOMIC_RELEASE, "agent");
            asm volatile("s_waitcnt vmcnt(0)" ::: "memory");
            const unsigned og = xb_add(&bar[XB_TOP], 1u);
            const unsigned tg = og / nx;
            if (og + 1u == (tg + 1u) * nx) xb_add(&bar[XB_TOPGEN], 1u);
            else XB_SPIN(xb_ld(&bar[XB_TOPGEN]) == tg, bar);
            __builtin_amdgcn_fence(__ATOMIC_ACQUIRE, "agent");
            xb_add(&bar[XB_XGEN(b.x)], 1u);
            asm volatile("s_waitcnt vmcnt(0)" ::: "memory");
        } else {
            XB_SPIN(xb_ld(&bar[XB_XGEN(b.x)]) == gen, bar);
            __builtin_amdgcn_fence(__ATOMIC_ACQUIRE, "agent");
            asm volatile("s_waitcnt vmcnt(0)" ::: "memory");
        }
    }
    __syncthreads();
}

struct Frame {
    LAS unsigned char* lds;
    int tid, lane, wave, G, bid;
    float* out; unsigned char* ws;
};
struct Args { const float* in[26]; float* out; unsigned char* ws; int ph_lo, ph_hi; };
enum { I_X = 0, I_C, I_CTX, I_CCTX, I_WMOD, I_BMOD, I_NORMG, I_WI, I_WO, I_WIN, I_WOUT, I_SINK, I_LAMRE, I_LAMIM, I_LOGDT, I_BRE, I_BIM, I_CRE, I_CIM, I_SSMD, I_GLUW, I_GLUB,
       I_CONVW, I_CONVB, I_LNG, I_LNB };

constexpr int TR_STRIDE = 65, TR_WAVE_BYTES = 64 * TR_STRIDE * 4;
#ifndef TR_NT
#define TR_NT 1
#endif
struct TrItem { const float* src; bf16* dst; int ldw, K; };
__device__ __forceinline__ void tr_load(const TrItem& t, f32x4 (&v)[16], int lane) {
    const int rr = lane >> 4, c4 = (lane & 15) * 4;
#pragma unroll
    for (int i = 0; i < 16; ++i) v[i] = TR_NT ? __builtin_nontemporal_load((const f32x4*)(t.src + (size_t)(4 * i + rr) * t.ldw + c4)) : *(const f32x4*)(t.src + (size_t)(4 * i + rr) * t.ldw + c4);
}
__device__ __forceinline__ void tr_store(const TrItem& t, const f32x4 (&v)[16], LAS float* scr, int lane) {
    const int rr = lane >> 4, c4 = (lane & 15) * 4;
#pragma unroll
    for (int i = 0; i < 16; ++i) { LAS float* d = scr + (4 * i + rr) * TR_STRIDE + c4; d[0] = v[i].x; d[1] = v[i].y; d[2] = v[i].z; d[3] = v[i].w; }
    LDS_WAIT(); asm volatile("" ::: "memory");
    const int c = lane & 7;
#pragma unroll
    for (int j = 0; j < 8; ++j) { const int n = (lane >> 3) + 8 * j; const LAS float* s = scr + (8 * c) * TR_STRIDE + n;
        v4u o; o.x = pk2(s[0 * TR_STRIDE], s[1 * TR_STRIDE]); o.y = pk2(s[2 * TR_STRIDE], s[3 * TR_STRIDE]); o.z = pk2(s[4 * TR_STRIDE], s[5 * TR_STRIDE]); o.w = pk2(s[6 * TR_STRIDE], s[7 * TR_STRIDE]);
        if (TR_NT) __builtin_nontemporal_store(o, (v4u*)(t.dst + (size_t)n * t.K + 8 * c)); else *(GAS v4u*)(t.dst + (size_t)n * t.K + 8 * c) = o; }
    LDS_WAIT(); asm volatile("" ::: "memory");
}
__device__ __forceinline__ void transpose_item(const float* W, int ldw, int k0, int n0, bf16* WT, int K, int drow0, LAS float* scr, int lane) {
    TrItem t{W + (size_t)k0 * ldw + n0, WT + (size_t)drow0 * K + k0, ldw, K}; f32x4 v[16]; tr_load(t, v, lane); tr_store(t, v, scr, lane);
}

constexpr int CV_WI = 32 * 176, CV_WO = 88 * 32, CV_WOUT = 32 * 32, CV_WIN = 32 * 36, CV_GLU = 8 * 8, CV_FOLD = 32 * 8;
constexpr int CV_NOFOLD = 2 * CV_WI + 2 * CV_WO + CV_WOUT + CV_WIN + CV_GLU, CV_TILES = CV_NOFOLD + CV_FOLD, CV_ITEMS = CV_TILES / 8;
static_assert(CV_TILES % 8 == 0, "workgroup items of 8 wave tiles");
__device__ __forceinline__ void conv_decode(const Args& AR, unsigned char* ws, int L, int it, TrItem& t) {
    int r = it;
    if (r < 2 * CV_WI) { const int mat = L * 2 + r / CV_WI, q = r % CV_WI, kb = q / 176, nb = q % 176, n0 = nb * 64, half = n0 / DFF, j = n0 % DFF, drow = (j / 128) * 256 + half * 128 + (j % 128);
        t.src = AR.in[I_WI] + (size_t)mat * DM * 2 * DFF + (size_t)(kb * 64) * (2 * DFF) + n0; t.dst = (bf16*)(ws + WS_WI) + (size_t)mat * 2 * DFF * DM + (size_t)drow * DM + kb * 64; t.ldw = 2 * DFF; t.K = DM; return; }
    r -= 2 * CV_WI;
    if (r < 2 * CV_WO) { const int mat = L * 2 + r / CV_WO, q = r % CV_WO, kb = q / 32, nb = q % 32;
        t.src = AR.in[I_WO] + (size_t)mat * DFF * DM + (size_t)(kb * 64) * DM + nb * 64; t.dst = (bf16*)(ws + WS_WO) + (size_t)mat * DM * DFF + (size_t)(nb * 64) * DFF + kb * 64; t.ldw = DM; t.K = DFF; return; }
    r -= 2 * CV_WO;
    if (r < CV_WOUT) { const int kb = r / 32, nb = r % 32;
        t.src = AR.in[I_WOUT] + (size_t)L * DM * DM + (size_t)(kb * 64) * DM + nb * 64; t.dst = (bf16*)(ws + WS_WOUT) + (size_t)L * DM * DM + (size_t)(nb * 64) * DM + kb * 64; t.ldw = DM; t.K = DM; return; }
    r -= CV_WOUT;
    if (r < CV_WIN) { const int kb = r / 36, nb = r % 36;
        t.src = AR.in[I_WIN] + (size_t)L * DM * DIN + (size_t)(kb * 64) * DIN + nb * 64; t.dst = (bf16*)(ws + WS_WIN) + (size_t)L * DIN * DM + (size_t)(nb * 64) * DM + kb * 64; t.ldw = DIN; t.K = DM; return; }
    r -= CV_WIN;
    if (r < CV_GLU) { const int kb = r / 8, nb = r % 8;
        t.src = AR.in[I_GLUW] + (size_t)L * 512 * 512 + (size_t)(kb * 64) * 512 + nb * 64; t.dst = (bf16*)(ws + WS_GLUW) + (size_t)L * 512 * 512 + (size_t)(nb * 64) * 512 + kb * 64; t.ldw = 512; t.K = 512; return; }
    r -= CV_GLU;
    { const int kb = r / 8, nb = r % 8;
        t.src = (const float*)(ws + WS_WFOLD) + (size_t)L * DM * 512 + (size_t)(kb * 64) * 512 + nb * 64; t.dst = (bf16*)(ws + WS_WIN) + (size_t)L * DIN * DM + (size_t)(FFT_OFF + nb * 64) * DM + kb * 64; t.ldw = 512; t.K = DM; }
}
__device__ __forceinline__ void bg_static(Frame& F, const Args& AR, int L, int first, int n, int stride) {
    __syncthreads();
    LAS float* scr = (LAS float*)(F.lds + F.wave * TR_WAVE_BYTES);
    int it = first, left = n;
    if (left <= 0 || it >= CV_ITEMS) return;
    TrItem cur; conv_decode(AR, F.ws, L, it * 8 + F.wave, cur); f32x4 va[16]; tr_load(cur, va, F.lane);
#pragma unroll 1
    for (;;) {
        const int nx = it + stride; const bool more = left > 1 && nx < CV_ITEMS;
        TrItem nxt = cur; f32x4 vb[16];
        if (more) { conv_decode(AR, F.ws, L, nx * 8 + F.wave, nxt); tr_load(nxt, vb, F.lane); }
        tr_store(cur, va, scr, F.lane);
        if (!more) break;
#pragma unroll
        for (int i = 0; i < 16; ++i) va[i] = vb[i];
        cur = nxt; it = nx; --left;
    }
}
constexpr int BG_UP = 8, BG_IN = 7, BG_DN = 1, BG_OUT = 1, BG_CA = 0;
constexpr int BGB_UP1 = 0, BGB_UP2 = BGB_UP1 + 40 * BG_UP, BGB_IN = BGB_UP2 + 40 * BG_UP, BGB_DN1 = BGB_IN + 138 * BG_IN, BGB_DN2 = BGB_DN1 + 80 * BG_DN, BGB_OUT = BGB_DN2 + 80 * BG_DN,
              BGB_CA = BGB_OUT + 192 * BG_OUT, BGB_REST = BGB_CA + 128 * BG_CA;
static_assert(BGB_REST <= CV_ITEMS, "background item map");
__device__ __forceinline__ void bg_site(Frame& F, const Args& AR, int L, int base, int c0, int n) {
    if (F.G == 256 && F.bid >= c0) bg_static(F, AR, L, base + (F.bid - c0) * n, n, 1);
}
__device__ __forceinline__ void bg_drain(Frame& F, const Args& AR, int L) {
    const int base = F.G == 256 ? BGB_REST : 0;
    bg_static(F, AR, L, base + F.bid, (CV_ITEMS - base - F.bid + F.G - 1) / F.G, F.G);
}

__device__ __forceinline__ void p0a(Frame& F, const Args& AR) {
    unsigned char* ws = F.ws;
    const int gw = F.bid * NWAVES + F.wave, NGW = F.G * NWAVES;
    const int gt = F.bid * NTHR + F.tid, NGT = F.G * NTHR;
    {
        float* rope = (float*)(ws + WS_ROPE);
        for (int i = gt; i < 64 * 16; i += NGT) { const int pos = i >> 4, j = i & 15;
            const double inv = exp(-(double)j * (9.210340371976184 / 16.0)); const double t = (double)pos * inv * 0.15915494309189535; const double fr = t - rint(t);
            rope[2 * i] = (float)cospi(2.0 * fr); rope[2 * i + 1] = (float)sinpi(2.0 * fr); }
        float* tw = (float*)(ws + WS_TW);
        for (int i = gt; i < 4096; i += NGT) { const double fr = (double)i / 4096.0; tw[2 * i] = (float)cospi(2.0 * fr); tw[2 * i + 1] = (float)(-sinpi(2.0 * fr)); }
        float* sa = (float*)(ws + WS_SSMA); float* sbb = (float*)(ws + WS_SSMBB);
        for (int i = gt; i < DEPTH * 2 * 32 * 64; i += NGT) {
            const int ldg = i >> 6;
            const double lr = fmin((double)AR.in[I_LAMRE][i], -1e-4), li = (double)AR.in[I_LAMIM][i], dt = exp((double)AR.in[I_LOGDT][ldg]);
            const double mag = exp(lr * dt); const double t = li * dt * 0.15915494309189535; const double fr = t - rint(t);
            const double are = mag * cospi(2.0 * fr), aim = mag * sinpi(2.0 * fr);
            const double den = lr * lr + li * li, nr = are - 1.0;
            const double cre = (nr * lr + aim * li) / den, cim = (aim * lr - nr * li) / den;
            sa[2 * i] = (float)are; sa[2 * i + 1] = (float)aim;
            { const double mag16 = exp(lr * dt * 16.0); const double t16 = li * dt * 16.0 * 0.15915494309189535; const double f16 = t16 - rint(t16);
              const double ar16 = mag16 * cospi(2.0 * f16), ai16 = mag16 * sinpi(2.0 * f16);
              float* a16 = (float*)(ws + WS_A16); a16[2 * i] = (float)ar16; a16[2 * i + 1] = (float)ai16;
              float* pw = (float*)(ws + WS_POW) + ((size_t)ldg * 65 * 64 + (i & 63)) * 2;
              double pr = 1.0, pi = 0.0;
              for (int k = 0; k <= 64; ++k) { pw[(size_t)k * 128] = (float)pr; pw[(size_t)k * 128 + 1] = (float)pi; const double nr = pr * ar16 - pi * ai16, ni = pr * ai16 + pi * ar16; pr = nr; pi = ni; } }
            for (int h = 0; h < 16; ++h) { const double br = (double)AR.in[I_BRE][(size_t)i * 16 + h], bi = (double)AR.in[I_BIM][(size_t)i * 16 + h];
                sbb[((size_t)i * 16 + h) * 2] = (float)(cre * br - cim * bi); sbb[((size_t)i * 16 + h) * 2 + 1] = (float)(cre * bi + cim * br); }
        }
        float* sct = (float*)(ws + WS_SSMCT);
        for (int i = gt; i < DEPTH * 2 * 64 * 512; i += NGT) { const int ch = i & 511, p = (i >> 9) & 63, ld = i >> 15;
            const size_t src = ((size_t)ld * 512 + ch) * 64 + p; sct[2 * (size_t)i] = AR.in[I_CRE][src]; sct[2 * (size_t)i + 1] = AR.in[I_CIM][src]; }
    }
    {
        LAS float* sv = (LAS float*)F.lds;
        for (int i = F.tid; i < 3 * DM; i += NTHR) { const int v = i / DM, d = i % DM; const float c = v < 2 ? AR.in[I_C][v * DM + d] : AR.in[I_CCTX][d]; sv[i] = c * sigmoidf_(c); }
        __syncthreads();
        float* modp = (float*)(ws + WS_MODP);
        constexpr int DCH = DM / MOD_CHUNKS;
        for (int it = F.bid; it < DEPTH * 9 * MOD_CHUNKS; it += F.G) {
            const int ch = it % MOD_CHUNKS, lj = it / MOD_CHUNKS, jg = lj % 9, l = lj / 9;
            const float* wp = AR.in[I_WMOD] + ((size_t)l * DM + (size_t)ch * DCH) * MODW + jg * 2048 + F.tid * 4;
            f32x4 a0 = {0.f, 0.f, 0.f, 0.f}, a1 = a0, a2 = a0;
#pragma unroll 8
            for (int d = 0; d < DCH; ++d) { const f32x4 w = __builtin_nontemporal_load((const f32x4*)(wp + (size_t)d * MODW)); const int dd = ch * DCH + d;
                a0 += w * sv[dd]; a1 += w * sv[DM + dd]; a2 += w * sv[2 * DM + dd]; }
            float* o = modp + ((size_t)(ch * DEPTH + l) * 3) * MODW + jg * 2048 + F.tid * 4;
            *(f32x4*)(o) = a0; *(f32x4*)(o + MODW) = a1; *(f32x4*)(o + 2 * MODW) = a2;
        }
        __syncthreads();
    }
    {
        LAS float* scr = (LAS float*)(F.lds + F.wave * 16384);
        scr[F.lane] = cospif((float)F.lane * (1.0f / 64.0f)); scr[F.lane + 64] = cospif((float)(F.lane + 64) * (1.0f / 64.0f));
        float* wf = (float*)(ws + WS_WFOLD);
        for (int it = gw; it < DEPTH * DM * 4; it += NGW) {
            const int h = it & 3, ld = it >> 2;
            const float* src = AR.in[I_WIN] + (size_t)ld * DIN + FFT_OFF + 128 * h;
            LDS_WAIT(); asm volatile("" ::: "memory");
            scr[128 + F.lane] = src[F.lane]; scr[192 + F.lane] = src[F.lane + 64];
            LDS_WAIT(); asm volatile("" ::: "memory");
#pragma unroll
            for (int q = 0; q < 2; ++q) { const int jj = F.lane + 64 * q, mp = jj >> 1, odd = jj & 1;
                const int mult = mp == 0 ? (odd ? 64 : 0) : mp, shift = (mp != 0 && odd) ? 96 : 0; const float sgn = (mp != 0 && odd) ? -1.f : 1.f;
                float s = 0.f;
                for (int c = 0; c < 128; ++c) s += scr[128 + c] * scr[(mult * c + shift) & 127];
                wf[(size_t)ld * 512 + 128 * h + jj] = s * sgn; }
        }
        LDS_WAIT(); asm volatile("" ::: "memory");
    }
    {
        __syncthreads();
        LAS float* scr = (LAS float*)(F.lds + F.wave * TR_WAVE_BYTES);
        constexpr int NIT = CV_NOFOLD;
        auto decode = [&](int it, TrItem& t) { conv_decode(AR, ws, 0, it, t); };
        int it = gw;
        if (it < NIT) {
            TrItem cur; decode(it, cur); f32x4 va[16]; tr_load(cur, va, F.lane);
#pragma unroll 1
            for (;;) {
                const int nx = it + NGW; const bool more = nx < NIT;
                TrItem nxt = cur; f32x4 vb[16];
                if (more) { decode(nx, nxt); tr_load(nxt, vb, F.lane); }
                tr_store(cur, va, scr, F.lane);
                if (!more) break;
#pragma unroll
                for (int i = 0; i < 16; ++i) va[i] = vb[i];
                cur = nxt; it = nx;
            }
        }
    }
}
__device__ __forceinline__ void ssm_build_mats(Frame& F, const Args& AR, int item2) {
    const int item = item2 >> 1, half = item2 & 1;
    const int l = item >> 5, g = item & 31;
    LAS float* apow = (LAS float*)F.lds;
    LAS float* cc = apow + 2 * 17 * 64 * 2;
    LAS float* bb = cc + 4096;
    LAS float* kt = bb + 4096;
    const float* ssmbb = (const float*)(F.ws + WS_SSMBB);
    __syncthreads();
    for (int i = F.tid; i < 2 * 17 * 64; i += NTHR) { const int p = i & 63, j = (i >> 6) % 17, dir = i / (17 * 64);
        const int idx = ((l * 2 + dir) * 32 + g) * 64 + p;
        const double lr = fmin((double)AR.in[I_LAMRE][idx], -1e-4), li = (double)AR.in[I_LAMIM][idx], dt = exp((double)AR.in[I_LOGDT][(l * 2 + dir) * 32 + g]);
        const double mag = exp(lr * dt * (double)j); const double t = li * dt * (double)j * 0.15915494309189535; const double fr = t - rint(t);
        apow[2 * i] = (float)(mag * cospi(2.0 * fr)); apow[2 * i + 1] = (float)(mag * sinpi(2.0 * fr)); }
    for (int i = F.tid; i < 2 * 16 * 64; i += NTHR) { const int p = i & 63, h = (i >> 6) & 15, dir = i >> 10;
        const size_t src = ((size_t)((l * 2 + dir) * 32 + g) * 16 + h) * 64 + p;
        cc[2 * i] = AR.in[I_CRE][src]; cc[2 * i + 1] = AR.in[I_CIM][src]; }
    for (int i = F.tid; i < 2 * 64 * 16; i += NTHR) { const int h = i & 15, p = (i >> 4) & 63, dir = i >> 10;
        const size_t src = ((size_t)((l * 2 + dir) * 32 + g) * 64 + p) * 16 + h;
        bb[2 * i] = ssmbb[2 * src]; bb[2 * i + 1] = ssmbb[2 * src + 1]; }
    __syncthreads();
    for (int i = F.tid; i < 8192; i += NTHR) { const int h = i & 15, hp = (i >> 4) & 15, j = (i >> 8) & 15, dir = i >> 12;
        float s = 0.f;
        for (int p = 0; p < 64; ++p) { const LAS float* c = cc + ((dir * 16 + hp) * 64 + p) * 2; const LAS float* a = apow + ((dir * 17 + j) * 64 + p) * 2; const LAS float* b = bb + ((dir * 64 + p) * 16 + h) * 2;
            const float car = c[0] * a[0] - c[1] * a[1], cai = c[0] * a[1] + c[1] * a[0]; s += car * b[0] - cai * b[1]; }
        kt[i] = s; }
    __syncthreads();
    bf16* wy = (bf16*)(F.ws + WS_SSMWY) + (size_t)item * 256 * 512;
    for (int e = half * 128 * 64 + F.tid; e < (half + 1) * 128 * 64; e += NTHR) { const int n = e >> 6, k0 = (e & 63) * 8, i = n >> 4, hp = n & 15;
        float v[8];
#pragma unroll
        for (int t = 0; t < 8; ++t) { const int k = k0 + t; float val;
            if (k < 256) { const int ip = k >> 4, h = k & 15; val = 0.f;
                if (ip <= i) val += kt[((0 * 16 + (i - ip)) * 16 + hp) * 16 + h];
                if (ip >= i) val += kt[((1 * 16 + (ip - i)) * 16 + hp) * 16 + h];
                if (ip == i && h == hp) val += AR.in[I_SSMD][l * 512 + g * 16 + h]; }
            else { const int kk = k - 256, dir = kk >> 7, part = (kk >> 6) & 1, p = kk & 63, ee = dir == 0 ? i + 1 : 16 - i;
                const LAS float* c = cc + ((dir * 16 + hp) * 64 + p) * 2; const LAS float* a = apow + ((dir * 17 + ee) * 64 + p) * 2;
                val = part == 0 ? c[0] * a[0] - c[1] * a[1] : -(c[0] * a[1] + c[1] * a[0]); }
            v[t] = val; }
        v4u o; o.x = pk2(v[0], v[1]); o.y = pk2(v[2], v[3]); o.z = pk2(v[4], v[5]); o.w = pk2(v[6], v[7]);
        *(v4u*)(wy + (size_t)n * 512 + k0) = o; }
    bf16* wsm = (bf16*)(F.ws + WS_SSMWS) + (size_t)item * 256 * 256;
    for (int e = half * 128 * 32 + F.tid; e < (half + 1) * 128 * 32; e += NTHR) { const int n = e >> 5, k0 = (e & 31) * 8, dir = n >> 7, part = (n >> 6) & 1, p = n & 63;
        float v[8];
#pragma unroll
        for (int t = 0; t < 8; ++t) { const int k = k0 + t, ip = k >> 4, h = k & 15, ee = dir == 0 ? 15 - ip : ip;
            const LAS float* a = apow + ((dir * 17 + ee) * 64 + p) * 2; const LAS float* b = bb + ((dir * 64 + p) * 16 + h) * 2;
            v[t] = part == 0 ? a[0] * b[0] - a[1] * b[1] : a[0] * b[1] + a[1] * b[0]; }
        v4u o; o.x = pk2(v[0], v[1]); o.y = pk2(v[2], v[3]); o.z = pk2(v[4], v[5]); o.w = pk2(v[6], v[7]);
        *(v4u*)(wsm + (size_t)n * 256 + k0) = o; }
}
__device__ __forceinline__ void p0b(Frame& F, const Args& AR) {
    unsigned char* ws = F.ws;
    const int gw = F.bid * NWAVES + F.wave, NGW = F.G * NWAVES;
    const int gt = F.bid * NTHR + F.tid, NGT = F.G * NTHR;
    {
        const float* modp = (const float*)(ws + WS_MODP); float* comb = (float*)(ws + WS_COMB); const float* ng = AR.in[I_NORMG];
        auto modval = [&](int l, int v, int j) { float s = AR.in[I_BMOD][l * MODW + j]; const float* q = modp + (size_t)(l * 3 + v) * MODW + j;
            for (int ch = 0; ch < MOD_CHUNKS; ++ch) s += q[(size_t)ch * DEPTH * 3 * MODW]; return s; };
        for (int e = gt; e < 13 * 3 * DM; e += NGT) { const int c = e % DM, v = (e / DM) % 3, idx = e / (3 * DM);
            float vg = 0.f, vs = 0.f, vh = 0.f;
            if (idx == 12) { vs = ng[c] * (1.0f + modval(0, v, 1 * DM + c)); vh = modval(0, v, c); }
            else { const int l = idx / 3, k = idx % 3;
                vg = (k == 1 ? 1.0f : 0.5f) * modval(l, v, (2 + 3 * k) * DM + c) * ng[(l * 6 + 1 + 2 * k) * DM + c];
                if (k < 2) { vs = ng[(l * 6 + 2 + 2 * k) * DM + c] * (1.0f + modval(l, v, (4 + 3 * k) * DM + c)); vh = modval(l, v, (3 + 3 * k) * DM + c); }
                else if (l < DEPTH - 1) { vs = ng[((l + 1) * 6) * DM + c] * (1.0f + modval(l + 1, v, 1 * DM + c)); vh = modval(l + 1, v, c); } }
            float* o = comb + ((size_t)(idx * 3 + v) * 3) * DM + c; o[0] = vg; o[DM] = vs; o[2 * DM] = vh; }
    }
    for (int it = F.bid; it < DEPTH * 32 * 2; it += F.G) ssm_build_mats(F, AR, it);
    __syncthreads();
    {
        LAS float* scr = (LAS float*)(F.lds + F.wave * TR_WAVE_BYTES);
        bf16* win_t = (bf16*)(ws + WS_WIN); const float* wf = (const float*)(ws + WS_WFOLD);
        for (int it = gw; it < CV_FOLD; it += NGW) { TrItem t; conv_decode(AR, ws, 0, CV_NOFOLD + it, t); f32x4 v[16]; tr_load(t, v, F.lane); tr_store(t, v, scr, F.lane); }
        (void)win_t; (void)wf;
    }
}
#ifndef NT_H
#define NT_H 1
#endif
#ifndef NT_X
#define NT_X 1
#endif
#ifndef NORM_CUS
#define NORM_CUS 0
#endif
__device__ __forceinline__ void norm_phase(Frame& F, const Args& AR, bool first, bool has_y, int nsplit, const float* comb, float res_mul, bool write_h, bool write_out) {
    if (NORM_CUS && F.bid >= NORM_CUS) return;
    const int gw = F.bid * NWAVES + F.wave, NGW = (NORM_CUS ? NORM_CUS : F.G) * NWAVES;
    float* X = (float*)(F.ws + WS_X); const bf16* Y = (const bf16*)(F.ws + WS_Y); bf16* H = (bf16*)(F.ws + WS_H);
#pragma unroll 1
    for (int r = gw; r < R; r += NGW) {
        const int v = r < SEQ ? 0 : (r < R_LAT ? 1 : 2);
        const float* cb = comb + (size_t)v * 3 * DM + 4 * F.lane;
        const float* xr = (first ? (r < R_LAT ? AR.in[I_X] + (size_t)r * DM : AR.in[I_CTX] + (size_t)(r - R_LAT) * DM) : X + (size_t)r * DM) + 4 * F.lane;
        f32x4 x[8], y[8], vg[8], vs[8], vh[8];
#pragma unroll
        for (int j = 0; j < 8; ++j) x[j] = NT_X ? __builtin_nontemporal_load((const f32x4*)(xr + 256 * j)) : *(const f32x4*)(xr + 256 * j);
        if (has_y) {
            if (r < R_LAT) {
#pragma unroll
                for (int j = 0; j < 8; ++j) { const v2u w = __builtin_nontemporal_load((const v2u*)(Y + (size_t)r * DM + 4 * F.lane + 256 * j)); y[j] = (f32x4){bflo(w.x), bfhi(w.x), bflo(w.y), bfhi(w.y)}; }
            } else {
                const float* yp = (const float*)(F.ws + WS_YP) + (size_t)(r - R_LAT) * DM + 4 * F.lane;
#pragma unroll
                for (int j = 0; j < 8; ++j) y[j] = __builtin_nontemporal_load((const f32x4*)(yp + 256 * j));
#pragma unroll 1
                for (int s = 1; s < nsplit; ++s) {
#pragma unroll
                    for (int j = 0; j < 8; ++j) y[j] += __builtin_nontemporal_load((const f32x4*)(yp + (size_t)s * R_CTX * DM + 256 * j)); }
            }
#pragma unroll
            for (int j = 0; j < 8; ++j) vg[j] = *(const f32x4*)(cb + 256 * j);
        }
        if (write_h) {
#pragma unroll
            for (int j = 0; j < 8; ++j) { vs[j] = *(const f32x4*)(cb + DM + 256 * j); vh[j] = *(const f32x4*)(cb + 2 * DM + 256 * j); }
        }
        if (has_y) {
            float ss = 0.f;
#pragma unroll
            for (int j = 0; j < 8; ++j) ss += (y[j].x * y[j].x + y[j].y * y[j].y) + (y[j].z * y[j].z + y[j].w * y[j].w);
            const float rs = rsqrtf(wave_sum(ss) * (1.0f / DM) + 1e-6f) * res_mul;
#pragma unroll
            for (int j = 0; j < 8; ++j) x[j] += vg[j] * (y[j] * rs);
        }
        if (has_y) {
#pragma unroll
            for (int j = 0; j < 8; ++j) { if (NT_X) __builtin_nontemporal_store(x[j], (f32x4*)(X + (size_t)r * DM + 4 * F.lane + 256 * j)); else *(f32x4*)(X + (size_t)r * DM + 4 * F.lane + 256 * j) = x[j]; }
        }
        if (write_out && r < R_LAT) {
#pragma unroll
            for (int j = 0; j < 8; ++j) *(f32x4*)(F.out + (size_t)r * DM + 4 * F.lane + 256 * j) = x[j];
        }
        if (write_h) {
            float ss = 0.f;
#pragma unroll
            for (int j = 0; j < 8; ++j) ss += (x[j].x * x[j].x + x[j].y * x[j].y) + (x[j].z * x[j].z + x[j].w * x[j].w);
            const float rs = rsqrtf(wave_sum(ss) * (1.0f / DM) + 1e-6f);
#pragma unroll
            for (int j = 0; j < 8; ++j) { const f32x4 hv = x[j] * rs * vs[j] + vh[j];
                v2u o; o.x = pk2(hv.x, hv.y); o.y = pk2(hv.z, hv.w); if (NT_H) __builtin_nontemporal_store(o, (v2u*)(H + (size_t)r * DM + 4 * F.lane + 256 * j)); else *(v2u*)(H + (size_t)r * DM + 4 * F.lane + 256 * j) = o; }
        }
    }
}

typedef short bf16x8v __attribute__((ext_vector_type(8)));
template <int K> __device__ __forceinline__ void wave_bfrags(const bf16* Bt, int kb, bf16x8v (&bfr)[8][2], int lane) {
    const int fr = lane & 15, fq = lane >> 4;
#pragma unroll
    for (int ks = 0; ks < 8; ++ks)
#pragma unroll
        for (int n = 0; n < 2; ++n) bfr[ks][n] = *(const bf16x8v*)(Bt + (size_t)(n * 16 + fr) * K + kb * 256 + ks * 32 + 8 * fq);
}
template <int K, int MT> __device__ __forceinline__ void wave_mma_batch(const LAS unsigned char* a_lds, int lda, int kb, const bf16x8v (&bfr)[8][2], f32x4 (&acc)[MT][2], int lane) {
    const int fr = lane & 15, fq = lane >> 4;
#pragma unroll
    for (int ks = 0; ks < 8; ++ks)
#pragma unroll
        for (int m = 0; m < MT; ++m) { const bf16x8v af = *(const LAS bf16x8v*)(a_lds + (m * 16 + fr) * lda + (kb * 256 + ks * 32 + 8 * fq) * 2);
#pragma unroll
            for (int n = 0; n < 2; ++n) acc[m][n] = __builtin_amdgcn_mfma_f32_16x16x32_bf16(bfr[ks][n], af, acc[m][n], 0, 0, 0); }
}
__device__ __forceinline__ void ssm_sgemm_item(Frame& F, const Args& AR, int l, int item) {
    constexpr int K = 256, LDA = K * 2 + 16, MT = 4, NROW = 64, SL_OFF = 36864, SLD = 260, EX_OFF = 104448;
    const int g = item & 31, rt = item >> 5, row0 = rt * 64;
    const bf16* P = (const bf16*)(F.ws + WS_P);
    LAS unsigned char* at = F.lds;
    LAS float* sl = (LAS float*)(F.lds + SL_OFF); LAS float* ex = (LAS float*)(F.lds + EX_OFF);
    const bf16* Bt = (const bf16*)(F.ws + WS_SSMWS) + (size_t)(l * 32 + g) * 256 * 256 + (size_t)(F.wave * 32) * K;
    bf16x8v b0[8][2];
    wave_bfrags<K>(Bt, 0, b0, F.lane);
    __syncthreads();
    for (int idx = F.tid; idx < NROW * 32; idx += NTHR) { const int piece = idx & 1, tok = (idx >> 1) & 15, row = idx >> 5, cr = row0 + row;
        v4u v = {0u, 0u, 0u, 0u}; if (cr < NCR) v = *(const v4u*)(P + (size_t)(cr * 16 + tok) * DIN + SSM_OFF + g * 16 + piece * 8);
        *(LAS v4u*)(at + row * LDA + (tok * 16 + piece * 8) * 2) = v; }
    __syncthreads();
    f32x4 acc[MT][2];
#pragma unroll
    for (int m = 0; m < MT; ++m)
#pragma unroll
        for (int n = 0; n < 2; ++n) acc[m][n] = (f32x4){0.f, 0.f, 0.f, 0.f};
    wave_mma_batch<K, MT>(at, LDA, 0, b0, acc, F.lane);
    { const int fr = F.lane & 15, fq = F.lane >> 4;
#pragma unroll
      for (int m = 0; m < MT; ++m)
#pragma unroll
        for (int n = 0; n < 2; ++n) *(LAS f32x4*)(sl + (m * 16 + fr) * SLD + F.wave * 32 + n * 16 + 4 * fq) = acc[m][n]; }
    __syncthreads();
    const int dir = F.wave & 1, cpos = F.wave >> 1, sub = dir ? 3 - cpos : cpos, p = F.lane;
    const f32x2 a = *(const f32x2*)((const float*)(F.ws + WS_A16) + ((size_t)((l * 2 + dir) * 32 + g) * 64 + p) * 2);
    float sr[16], si[16];
#pragma unroll
    for (int i = 0; i < 16; ++i) { const int row = sub * 16 + (dir ? 15 - i : i); sr[i] = sl[row * SLD + dir * 128 + p]; si[i] = sl[row * SLD + dir * 128 + 64 + p]; }
    float hr = 0.f, hi = 0.f;
#pragma unroll
    for (int i = 0; i < 16; ++i) { const float nr = a.x * hr - a.y * hi + sr[i], ni = a.x * hi + a.y * hr + si[i]; hr = nr; hi = ni; }
    ex[(F.wave * 64 + p) * 2] = hr; ex[(F.wave * 64 + p) * 2 + 1] = hi;
    float pr = a.x, pi = a.y;
#pragma unroll
    for (int i = 0; i < 4; ++i) { const float nr = pr * pr - pi * pi, ni = 2.0f * pr * pi; pr = nr; pi = ni; }
    __syncthreads();
    hr = 0.f; hi = 0.f;
    if (rt < 8) for (int c = 0; c < cpos; ++c) { const int ww = (c << 1) | dir; const float er = ex[(ww * 64 + p) * 2], ei = ex[(ww * 64 + p) * 2 + 1];
        const float nr = pr * hr - pi * hi + er, ni = pr * hi + pi * hr + ei; hr = nr; hi = ni; }
    const bool valid = rt < 8 || sub < 2;
    float* HL = (float*)(F.ws + WS_SSMS) + (size_t)g * 256 + dir * 128 + p;
#pragma unroll
    for (int i = 0; i < 16; ++i) { const int cr = row0 + sub * 16 + (dir ? 15 - i : i);
        if (valid) { HL[(size_t)cr * 8192] = hr; HL[(size_t)cr * 8192 + 64] = hi; }
        const float nr = a.x * hr - a.y * hi + sr[i], ni = a.x * hi + a.y * hr + si[i]; hr = nr; hi = ni; }
    float* ET = (float*)(F.ws + WS_ET) + (size_t)g * 256 + dir * 128 + p;
    if (rt < 8) { if (cpos == 3) { ET[(size_t)rt * 8192] = hr; ET[(size_t)rt * 8192 + 64] = hi; } }
    else if (sub < 2) { ET[(size_t)(8 + sub) * 8192] = hr; ET[(size_t)(8 + sub) * 8192 + 64] = hi; }
}
template <int PH, int MT> __device__ __forceinline__ void ssm_gemm_rows(Frame& F, const Args& AR, int l, int g, int row0) {
    static_assert(PH == 1, "Y phase only");
    constexpr int K = 512, LDA = K * 2 + 16, NROW = 16 * MT, HS_OFF = 100352;
    const bf16* P = (const bf16*)(F.ws + WS_P);
    LAS unsigned char* at = F.lds; LAS float* hs = (LAS float*)(F.lds + HS_OFF);
    const bf16* Bt = (const bf16*)(F.ws + WS_SSMWY) + (size_t)(l * 32 + g) * 256 * 512 + (size_t)(F.wave * 32) * K;
    const float* POW = (const float*)(F.ws + WS_POW);
    bf16x8v b0[8][2];
    wave_bfrags<K>(Bt, 0, b0, F.lane);
    __syncthreads();
    if (F.tid < 128) { const int dir = F.tid >> 6, p = F.tid & 63, t = row0 >> 6, b = t >> 2, i = t & 3;
        const float* ET = (const float*)(F.ws + WS_ET) + (size_t)g * 256 + dir * 128 + p;
        const f32x2 a64 = *(const f32x2*)(POW + ((((size_t)(l * 2 + dir) * 32 + g) * 65 + 64) * 64 + p) * 2);
        float hr = ET[(size_t)(8 + b) * 8192], hi = ET[(size_t)(8 + b) * 8192 + 64];
        if (dir == 0) { for (int j = 0; j < i; ++j) { const float er = ET[(size_t)(4 * b + j) * 8192], ei = ET[(size_t)(4 * b + j) * 8192 + 64];
                const float nr = a64.x * hr - a64.y * hi + er, ni = a64.x * hi + a64.y * hr + ei; hr = nr; hi = ni; } }
        else { for (int j = 3; j > i; --j) { const float er = ET[(size_t)(4 * b + j) * 8192], ei = ET[(size_t)(4 * b + j) * 8192 + 64];
                const float nr = a64.x * hr - a64.y * hi + er, ni = a64.x * hi + a64.y * hr + ei; hr = nr; hi = ni; } }
        hs[F.tid * 2] = hr; hs[F.tid * 2 + 1] = hi; }
    for (int idx = F.tid; idx < NROW * 32; idx += NTHR) { const int piece = idx & 1, tok = (idx >> 1) & 15, row = idx >> 5, cr = row0 + row;
        v4u v = {0u, 0u, 0u, 0u}; if (cr < NCR) v = *(const v4u*)(P + (size_t)(cr * 16 + tok) * DIN + SSM_OFF + g * 16 + piece * 8);
        *(LAS v4u*)(at + row * LDA + (tok * 16 + piece * 8) * 2) = v; }
    __syncthreads();
    { const float* HL = (const float*)(F.ws + WS_SSMS);
        for (int idx = F.tid; idx < NROW * 16; idx += NTHR) { const int oct = idx & 7, dir = (idx >> 3) & 1, row = idx >> 4, cr = row0 + row;
            const float* hl = HL + ((size_t)cr * 32 + g) * 256 + dir * 128 + oct * 8;
            f32x4 r0 = *(const f32x4*)hl, r1 = *(const f32x4*)(hl + 4), i0 = *(const f32x4*)(hl + 64), i1 = *(const f32x4*)(hl + 68);
            if (row < 64) { const int e = dir ? 63 - row : row;
                const float* pw = POW + ((((size_t)(l * 2 + dir) * 32 + g) * 65 + e) * 64 + oct * 8) * 2;
                const f32x4 w0 = *(const f32x4*)pw, w1 = *(const f32x4*)(pw + 4), w2 = *(const f32x4*)(pw + 8), w3 = *(const f32x4*)(pw + 12);
                const LAS float* hp = hs + (dir * 64 + oct * 8) * 2;
                const f32x4 h0 = *(const LAS f32x4*)hp, h1 = *(const LAS f32x4*)(hp + 4), h2 = *(const LAS f32x4*)(hp + 8), h3 = *(const LAS f32x4*)(hp + 12);
                r0.x += w0.x * h0.x - w0.y * h0.y; i0.x += w0.x * h0.y + w0.y * h0.x;  r0.y += w0.z * h0.z - w0.w * h0.w; i0.y += w0.z * h0.w + w0.w * h0.z;
                r0.z += w1.x * h1.x - w1.y * h1.y; i0.z += w1.x * h1.y + w1.y * h1.x;  r0.w += w1.z * h1.z - w1.w * h1.w; i0.w += w1.z * h1.w + w1.w * h1.z;
                r1.x += w2.x * h2.x - w2.y * h2.y; i1.x += w2.x * h2.y + w2.y * h2.x;  r1.y += w2.z * h2.z - w2.w * h2.w; i1.y += w2.z * h2.w + w2.w * h2.z;
                r1.z += w3.x * h3.x - w3.y * h3.y; i1.z += w3.x * h3.y + w3.y * h3.x;  r1.w += w3.z * h3.z - w3.w * h3.w; i1.w += w3.z * h3.w + w3.w * h3.z; }
            v4u vr, vi; vr.x = pk2(r0.x, r0.y); vr.y = pk2(r0.z, r0.w); vr.z = pk2(r1.x, r1.y); vr.w = pk2(r1.z, r1.w);
            vi.x = pk2(i0.x, i0.y); vi.y = pk2(i0.z, i0.w); vi.z = pk2(i1.x, i1.y); vi.w = pk2(i1.z, i1.w);
            *(LAS v4u*)(at + row * LDA + 512 + (dir * 128 + oct * 8) * 2) = vr; *(LAS v4u*)(at + row * LDA + 512 + (dir * 128 + 64 + oct * 8) * 2) = vi; } }
    __syncthreads();
    f32x4 acc[MT][2];
#pragma unroll
    for (int m = 0; m < MT; ++m)
#pragma unroll
        for (int n = 0; n < 2; ++n) acc[m][n] = (f32x4){0.f, 0.f, 0.f, 0.f};
    { bf16x8v b1[8][2]; wave_bfrags<K>(Bt, 1, b1, F.lane); wave_mma_batch<K, MT>(at, LDA, 0, b0, acc, F.lane); wave_mma_batch<K, MT>(at, LDA, 1, b1, acc, F.lane); }
    const int fr = F.lane & 15, fq = F.lane >> 4;
#pragma unroll
    for (int m = 0; m < MT; ++m) { const int cr = row0 + m * 16 + fr;
        if (cr < NCR) {
#pragma unroll
            for (int n = 0; n < 2; ++n) { const int col = F.wave * 32 + n * 16 + 4 * fq;
                const int i = col >> 4, hp = col & 15; float yv[4];
#pragma unroll
                for (int j = 0; j < 4; ++j) { const float y = acc[m][n][j]; const float z = 0.7978845608028654f * (y + 0.044715f * y * y * y);
                    const float th = 1.0f - 2.0f * __builtin_amdgcn_rcpf(1.0f + __expf(2.0f * z)); yv[j] = 0.5f * y * (1.0f + th); }
                v2u o; o.x = pk2(yv[0], yv[1]); o.y = pk2(yv[2], yv[3]);
                *(v2u*)((bf16*)(F.ws + WS_YG) + (size_t)(cr * 16 + i) * 512 + g * 16 + hp) = o; } } }
}
__device__ __forceinline__ void glu_item(Frame& F, const Args& AR, int l, int item) {
    constexpr int K = 512, LDA = K * 2 + 16, NROW = 68, MT = 5;
    const int half = item & 1, row0 = (item >> 1) * NROW;
    const bf16* YG = (const bf16*)(F.ws + WS_YG); bf16* CAT = (bf16*)(F.ws + WS_CAT);
    LAS unsigned char* at = F.lds;
    const int colw = half * 256 + F.wave * 32;
    const bf16* Bt = (const bf16*)(F.ws + WS_GLUW) + (size_t)l * 512 * 512 + (size_t)colw * K;
    bf16x8v b0[8][2];
    wave_bfrags<K>(Bt, 0, b0, F.lane);
    __syncthreads();
    for (int idx = F.tid; idx < 80 * 64; idx += NTHR) { const int pc = idx & 63, row = idx >> 6;
        v4u v = {0u, 0u, 0u, 0u}; if (row < NROW) v = *(const v4u*)(YG + (size_t)(row0 + row) * 512 + pc * 8);
        *(LAS v4u*)(at + row * LDA + pc * 16) = v; }
    __syncthreads();
    f32x4 acc[MT][2];
#pragma unroll
    for (int m = 0; m < MT; ++m)
#pragma unroll
        for (int n = 0; n < 2; ++n) acc[m][n] = (f32x4){0.f, 0.f, 0.f, 0.f};
    { bf16x8v b1[8][2]; wave_bfrags<K>(Bt, 1, b1, F.lane); wave_mma_batch<K, MT>(at, LDA, 0, b0, acc, F.lane); wave_mma_batch<K, MT>(at, LDA, 1, b1, acc, F.lane); }
    const int fr = F.lane & 15, fq = F.lane >> 4;
#pragma unroll
    for (int n = 0; n < 2; ++n) { const int col = colw + n * 16 + 4 * fq; const f32x4 bias = *(const f32x4*)(AR.in[I_GLUB] + l * 512 + col);
#pragma unroll
        for (int m = 0; m < MT; ++m) { const int row = m * 16 + fr;
            if (row < NROW) { const v2u yw = *(const LAS v2u*)(at + row * LDA + col * 2); const f32x4 z = acc[m][n] + bias;
                const float o0 = bflo(yw.x) * sigmoidf_(z.x), o1 = bfhi(yw.x) * sigmoidf_(z.y), o2 = bflo(yw.y) * sigmoidf_(z.z), o3 = bfhi(yw.y) * sigmoidf_(z.w);
                v2u o; o.x = pk2(o0, o1); o.y = pk2(o2, o3); *(v2u*)(CAT + (size_t)(row0 + row) * DM + 512 + col) = o; } } }
}
typedef float f32x16 __attribute__((ext_vector_type(16)));
constexpr int AT_ROW = 144, AT_KB = 64 * AT_ROW, AT_BUF = 2 * AT_KB;
__device__ __forceinline__ int crow16(int r, int hi) { return (r & 3) + 8 * (r >> 2) + 4 * hi; }
__device__ __forceinline__ void unpack8(const v4u w, float (&x)[8]) { x[0] = bflo(w.x); x[1] = bfhi(w.x); x[2] = bflo(w.y); x[3] = bfhi(w.y); x[4] = bflo(w.z); x[5] = bfhi(w.z); x[6] = bflo(w.w); x[7] = bfhi(w.w); }
__device__ __forceinline__ void attn_item_mfma(Frame& F, const Args& AR, int l, int item) {
    const bf16* P = (const bf16*)(F.ws + WS_P); bf16* CAT = (bf16*)(F.ws + WS_CAT); const float* rope = (const float*)(F.ws + WS_ROPE);
    const bool latent = item < 256;
    int b, kv, n, hq;
    if (latent) { hq = item & 1; n = (item >> 1) & 31; kv = (item >> 6) & 1; b = item >> 7; } else { const int c = item - 256; hq = c & 1; n = (c >> 1) & 1; kv = (c >> 2) & 1; b = c >> 3; }
    const int g = F.wave >> 1, wq = F.wave & 1, h = kv * 4 + g, r32 = F.lane & 31, hi = F.lane >> 5;
    constexpr float C2 = 0.125f * 1.4426950408889634f;
    const int qq = 32 * wq + r32;
    const int qpos = n * 128 + 64 * hq + qq;
    const int qrow = latent ? b * SEQ + qpos : R_LAT + b * CTXL + qpos;
    bf16x8v qf[4];
    {
        const bf16* qp = P + (size_t)qrow * DIN + Q_OFF + h * 64 + 8 * hi;
        float x[4][8];
#pragma unroll
        for (int ks = 0; ks < 4; ++ks) unpack8(*(const v4u*)(qp + 16 * ks), x[ks]);
        if (latent) {
#pragma unroll
            for (int part = 0; part < 2; ++part) { const int pos = part ? (qpos & 63) : (qpos >> 6);
#pragma unroll
                for (int t = 0; t < 8; ++t) { const f32x2 cs = *(const f32x2*)(rope + (pos * 16 + 8 * hi + t) * 2);
                    const float x1 = x[2 * part][t], x2 = x[2 * part + 1][t]; x[2 * part][t] = x1 * cs.x - x2 * cs.y; x[2 * part + 1][t] = x2 * cs.x + x1 * cs.y; } }
        }
#pragma unroll
        for (int ks = 0; ks < 4; ++ks) { v4u w; w.x = pk2(x[ks][0] * C2, x[ks][1] * C2); w.y = pk2(x[ks][2] * C2, x[ks][3] * C2); w.z = pk2(x[ks][4] * C2, x[ks][5] * C2); w.w = pk2(x[ks][6] * C2, x[ks][7] * C2);
            qf[ks] = __builtin_bit_cast(bf16x8v, w); }
    }
    float mrun = AR.in[I_SINK][l * 8 + h] * 1.4426950408889634f, lsum = hi == 0 ? 1.0f : 0.0f;
    f32x16 o[2];
#pragma unroll
    for (int db = 0; db < 2; ++db)
#pragma unroll
        for (int r = 0; r < 16; ++r) o[db][r] = 0.f;
    int tlo = hq, thi = hq + 4;
    if (latent) { if (n == 0 && tlo < 2) tlo = 2; if (n == 31 && thi > 3) thi = 3; } else { tlo = 0; thi = -1; }
    const int nloc = thi - tlo + 1, ntile = nloc + 4;
    const int sj = F.tid >> 3, sd0 = (F.tid & 7) * 8;
    v4u kw, kp, vw;
    { const bool lc = 0 < nloc; const int kp0 = lc ? 128 * (n - 1) + 64 * tlo : 0; const int krow = lc ? b * SEQ + kp0 + sj : R_LAT + b * CTXL + kp0 + sj;
      const bf16* kp_ = P + (size_t)krow * DIN + K_OFF + kv * 64; kw = *(const v4u*)(kp_ + sd0); kp = *(const v4u*)(kp_ + (sd0 ^ 16)); vw = *(const v4u*)(P + (size_t)krow * DIN + V_OFF + kv * 64 + sd0); }
    __syncthreads();
#pragma unroll 1
    for (int s = 0; s < ntile; ++s) {
        const bool local = s < nloc; const int kpos0 = local ? 128 * (n - 1) + 64 * (tlo + s) : 64 * (s - nloc);
        LAS unsigned char* kb_ = F.lds + (s & 1) * AT_BUF; LAS unsigned char* vb_ = kb_ + AT_KB;
        {
            float kk[8], kq[8], vv[8]; unpack8(kw, kk); unpack8(kp, kq); unpack8(vw, vv);
            if (local) { const int kpos = kpos0 + sj, part = sd0 >> 5, e0 = sd0 & 31; const bool firsth = e0 < 16; const int pp = part ? (kpos & 63) : (kpos >> 6);
#pragma unroll
                for (int t = 0; t < 8; ++t) { const f32x2 cs = *(const f32x2*)(rope + (pp * 16 + (e0 & 15) + t) * 2); kk[t] = firsth ? kk[t] * cs.x - kq[t] * cs.y : kk[t] * cs.x + kq[t] * cs.y; } }
            v4u w; w.x = pk2(kk[0], kk[1]); w.y = pk2(kk[2], kk[3]); w.z = pk2(kk[4], kk[5]); w.w = pk2(kk[6], kk[7]);
            *(LAS v4u*)(kb_ + sj * AT_ROW + sd0 * 2) = w;
#pragma unroll
            for (int t = 0; t < 8; ++t) *(LAS bf16*)(vb_ + (sd0 + t) * AT_ROW + sj * 2) = (bf16)f2bf(vv[t]);
        }
        __syncthreads();
        if (s + 1 < ntile) { const bool lc = s + 1 < nloc; const int kp0 = lc ? 128 * (n - 1) + 64 * (tlo + s + 1) : 64 * (s + 1 - nloc); const int krow = lc ? b * SEQ + kp0 + sj : R_LAT + b * CTXL + kp0 + sj;
            const bf16* kp_ = P + (size_t)krow * DIN + K_OFF + kv * 64; kw = *(const v4u*)(kp_ + sd0); kp = *(const v4u*)(kp_ + (sd0 ^ 16)); vw = *(const v4u*)(P + (size_t)krow * DIN + V_OFF + kv * 64 + sd0); }
        const int rel = local ? (tlo + s) - hq : 2;
        f32x16 st[2];
#pragma unroll
        for (int kb = 0; kb < 2; ++kb) {
#pragma unroll
            for (int r = 0; r < 16; ++r) st[kb][r] = 0.f;
#pragma unroll
            for (int ks = 0; ks < 4; ++ks) { const bf16x8v kf = *(const LAS bf16x8v*)(kb_ + (32 * kb + r32) * AT_ROW + (16 * ks + 8 * hi) * 2);
                st[kb] = __builtin_amdgcn_mfma_f32_32x32x16_bf16(kf, qf[ks], st[kb], 0, 0, 0); }
        }
        if (rel == 0 || rel == 4) {
#pragma unroll
            for (int kb = 0; kb < 2; ++kb)
#pragma unroll
                for (int r = 0; r < 16; ++r) { const int kk = 32 * kb + crow16(r, hi); const bool bad = rel == 0 ? kk < qq : kk > qq; st[kb][r] = bad ? -1e30f : st[kb][r]; } }
        float mx = st[0][0];
#pragma unroll
        for (int kb = 0; kb < 2; ++kb)
#pragma unroll
            for (int r = 0; r < 16; ++r) mx = fmaxf(mx, st[kb][r]);
        mx = fmaxf(mx, __shfl_xor(mx, 32));
        const float mnew = mx > mrun + 8.0f ? mx : mrun, corr = __builtin_amdgcn_exp2f(mrun - mnew);
        mrun = mnew;
        float ps = 0.f;
#pragma unroll
        for (int kb = 0; kb < 2; ++kb)
#pragma unroll
            for (int r = 0; r < 16; ++r) { st[kb][r] = __builtin_amdgcn_exp2f(st[kb][r] - mnew); ps += st[kb][r]; }
        lsum = lsum * corr + ps;
        if (__builtin_amdgcn_ballot_w64(corr != 1.0f) != 0ull) {
#pragma unroll
            for (int db = 0; db < 2; ++db)
#pragma unroll
                for (int r = 0; r < 16; ++r) o[db][r] *= corr; }
#pragma unroll
        for (int m = 0; m < 4; ++m) { const int kb = m >> 1, r0 = 8 * (m & 1); v4u pw;
            pw.x = pk2(st[kb][r0 + 0], st[kb][r0 + 1]); pw.y = pk2(st[kb][r0 + 2], st[kb][r0 + 3]); pw.z = pk2(st[kb][r0 + 4], st[kb][r0 + 5]); pw.w = pk2(st[kb][r0 + 6], st[kb][r0 + 7]);
            const bf16x8v pf = __builtin_bit_cast(bf16x8v, pw);
#pragma unroll
            for (int db = 0; db < 2; ++db) { const LAS unsigned char* vp = vb_ + (32 * db + r32) * AT_ROW + (16 * m + 4 * hi) * 2;
                const v2u lo = *(const LAS v2u*)vp, hh = *(const LAS v2u*)(vp + 16); const v4u w = {lo.x, lo.y, hh.x, hh.y};
                o[db] = __builtin_amdgcn_mfma_f32_32x32x16_bf16(__builtin_bit_cast(bf16x8v, w), pf, o[db], 0, 0, 0); } }
    }
    {
        const float lt = lsum + __shfl_xor(lsum, 32), inv = 1.0f / lt;
        bf16* op = CAT + (size_t)qrow * DM + h * 64;
#pragma unroll
        for (int db = 0; db < 2; ++db)
#pragma unroll
            for (int rq = 0; rq < 4; ++rq) { v2u w; w.x = pk2(o[db][4 * rq] * inv, o[db][4 * rq + 1] * inv); w.y = pk2(o[db][4 * rq + 2] * inv, o[db][4 * rq + 3] * inv);
                *(v2u*)(op + 32 * db + 8 * rq + 4 * hi) = w; }
    }
}
__device__ __forceinline__ void conv_tile_v1(Frame& F, const Args& AR, int l, int tile) {
    const bf16* P = (const bf16*)(F.ws + WS_P); bf16* CAT = (bf16*)(F.ws + WS_CAT);
    LAS float* hh = (LAS float*)F.lds;
    LAS float* red = hh + 47 * 512;
    const int c = F.tid;
    int base, t0, Ls;
    if (tile < R_LAT / 16) { const int b = tile / (SEQ / 16); t0 = (tile % (SEQ / 16)) * 16; base = b * SEQ; Ls = SEQ; }
    else { const int q = tile - R_LAT / 16; const int b = q / (CTXL / 16); t0 = (q % (CTXL / 16)) * 16; base = R_LAT + b * CTXL; Ls = CTXL; }
    __syncthreads();
#pragma unroll 1
    for (int kb = 0; kb < 6; kb += 3) {
        v4u vv[3], gg[3];
#pragma unroll
        for (int k = 0; k < 3; ++k) { const int q = F.tid + NTHR * (kb + k), i = q >> 6, c8 = (q & 63) * 8, t = t0 - 15 + i;
            vv[k] = (v4u){0u, 0u, 0u, 0u}; gg[k] = vv[k];
            if (i < 46 && t >= 0 && t < Ls) { const bf16* pr = P + (size_t)(base + t) * DIN + CONV_OFF + c8; vv[k] = *(const v4u*)pr; gg[k] = *(const v4u*)(pr + 512); } }
#pragma unroll
        for (int k = 0; k < 3; ++k) { const int q = F.tid + NTHR * (kb + k), i = q >> 6, c8 = (q & 63) * 8;
            if (i < 46) { float a[8], g[8]; unpack8(vv[k], a); unpack8(gg[k], g);
#pragma unroll
                for (int e = 0; e < 8; ++e) a[e] *= sigmoidf_(g[e]);
                *(LAS f32x4*)(hh + i * 512 + c8) = (f32x4){a[0], a[1], a[2], a[3]}; *(LAS f32x4*)(hh + i * 512 + c8 + 4) = (f32x4){a[4], a[5], a[6], a[7]}; } }
    }
    hh[46 * 512 + c] = 0.f;
    const float cb = AR.in[I_CONVB][l * 512 + c];
    __syncthreads();
    float ov[16];
#pragma unroll
    for (int i = 0; i < 16; ++i) ov[i] = cb;
    {
        const float* wp = AR.in[I_CONVW] + (size_t)l * 31 * 512 + c;
        float wc[8];
#pragma unroll
        for (int t = 0; t < 8; ++t) wc[t] = wp[t * 512];
#pragma unroll 1
        for (int kb = 0; kb < 4; ++kb) {
            float wn[8];
#pragma unroll
            for (int t = 0; t < 8; ++t) { const int k = 8 * (kb + 1) + t; wn[t] = wp[(k < 31 ? k : 30) * 512]; if (k >= 31) wn[t] = 0.f; }
            const LAS float* hb = hh + (8 * kb) * 512 + c;
            float hv[23];
#pragma unroll
            for (int j = 0; j < 23; ++j) hv[j] = hb[j * 512];
#pragma unroll
            for (int t = 0; t < 8; ++t)
#pragma unroll
                for (int i = 0; i < 16; ++i) ov[i] += hv[i + t] * wc[t];
#pragma unroll
            for (int t = 0; t < 8; ++t) wc[t] = wn[t];
        }
    }
    __syncthreads();
#pragma unroll
    for (int i = 0; i < 16; ++i) hh[i * 512 + c] = ov[i];
    __syncthreads();
    {
        float a0[8], a1[8]; float s0 = 0.f, s1 = 0.f;
#pragma unroll
        for (int j = 0; j < 8; ++j) { a0[j] = hh[(2 * F.wave) * 512 + F.lane + 64 * j]; a1[j] = hh[(2 * F.wave + 1) * 512 + F.lane + 64 * j]; s0 += a0[j]; s1 += a1[j]; }
        const float m0 = wave_sum(s0) * (1.0f / 512.0f), m1 = wave_sum(s1) * (1.0f / 512.0f);
        float q0 = 0.f, q1 = 0.f;
#pragma unroll
        for (int j = 0; j < 8; ++j) { const float d0 = a0[j] - m0, d1 = a1[j] - m1; q0 += d0 * d0; q1 += d1 * d1; }
        q0 = wave_sum(q0); q1 = wave_sum(q1);
        if (F.lane == 0) { red[4 * F.wave] = m0; red[4 * F.wave + 1] = rsqrtf(q0 * (1.0f / 512.0f) + 1e-5f); red[4 * F.wave + 2] = m1; red[4 * F.wave + 3] = rsqrtf(q1 * (1.0f / 512.0f) + 1e-5f); }
    }
    __syncthreads();
    const float lg = AR.in[I_LNG][l * 512 + c], lb = AR.in[I_LNB][l * 512 + c];
#pragma unroll
    for (int i = 0; i < 16; ++i) { const float mean = red[2 * i], rstd = red[2 * i + 1];
        const float y = (ov[i] - mean) * rstd * lg + lb;
        CAT[(size_t)(base + t0 + i) * DM + 1024 + c] = (bf16)f2bf(y * sigmoidf_(y)); }
}
__device__ __forceinline__ f32x2 cmul(f32x2 a, f32x2 b) { return (f32x2){a.x * b.x - a.y * b.y, a.x * b.y + a.y * b.x}; }
__device__ __forceinline__ void dft4(f32x2& a, f32x2& b, f32x2& c, f32x2& d) {
    const f32x2 s0 = a + c, s1 = a - c, s2 = b + d, s3 = b - d;
    a = s0 + s2; c = s0 - s2; b = (f32x2){s1.x + s3.y, s1.y - s3.x}; d = (f32x2){s1.x - s3.y, s1.y + s3.x};
}
__device__ __forceinline__ void dft16(f32x2 (&x)[16]) {
#pragma unroll
    for (int q0 = 0; q0 < 4; ++q0) dft4(x[q0], x[4 + q0], x[8 + q0], x[12 + q0]);
    const f32x2 w1 = {0.9238795325112867f, -0.3826834323650898f}, w2 = {0.7071067811865476f, -0.7071067811865476f}, w3 = {0.3826834323650898f, -0.9238795325112867f},
                w6 = {-0.7071067811865476f, -0.7071067811865476f}, w9 = {-0.9238795325112867f, 0.3826834323650898f};
    x[5] = cmul(x[5], w1); x[6] = cmul(x[6], w2); x[7] = cmul(x[7], w3);
    x[9] = cmul(x[9], w2); x[10] = (f32x2){x[10].y, -x[10].x}; x[11] = cmul(x[11], w6);
    x[13] = cmul(x[13], w3); x[14] = cmul(x[14], w6); x[15] = cmul(x[15], w9);
#pragma unroll
    for (int p1 = 0; p1 < 4; ++p1) dft4(x[4 * p1], x[4 * p1 + 1], x[4 * p1 + 2], x[4 * p1 + 3]);
}
template <int LOG2N> __device__ __forceinline__ void fft_item(Frame& F, const Args& AR, int item) {
    constexpr int N = 1 << LOG2N, TP = N / 16, PP = NTHR / TP, NST = LOG2N / 4, SLOTS = N + N / 16;
    const bf16* P = (const bf16*)(F.ws + WS_P); bf16* CAT = (bf16*)(F.ws + WS_CAT); const f32x2* twg = (const f32x2*)(F.ws + WS_TW);
    const int pr = F.tid / TP, j = F.tid % TP;
    int b, h, mA;
    if (LOG2N == 12) { const int grp = item & 15; h = (item >> 4) & 3; b = item >> 6; mA = 4 * grp + 2 * pr; } else { h = item & 3; b = item >> 2; mA = 2 * pr; }
    const int rbase = (LOG2N == 12) ? b * SEQ : R_LAT + b * CTXL;
    LAS f32x2* bufA = (LAS f32x2*)F.lds + (size_t)(2 * pr) * SLOTS; LAS f32x2* bufB = bufA + SLOTS;
    const float norm = (LOG2N == 12) ? 0.001381067932004975f : 0.005524271728019903f;
    f32x2 xa[16], xb[16];
    {
        const bf16* src = P + (size_t)(rbase + j) * DIN + FFT_OFF + 128 * h + 2 * mA;
#pragma unroll
        for (int q = 0; q < 16; ++q) { const v2u w = *(const v2u*)(src + (size_t)(TP * q) * DIN); xa[q] = (f32x2){bflo(w.x), bfhi(w.x)}; xb[q] = (f32x2){bflo(w.y), bfhi(w.y)}; }
        dft16(xa); dft16(xb);
    }
    __syncthreads();
#pragma unroll
    for (int st = 1; st < NST; ++st) {
        const int Ns0 = 1 << (4 * (st - 1));
        { const int k = j & (Ns0 - 1), o0 = (j - k) * 16 + k;
#pragma unroll
          for (int p1 = 0; p1 < 4; ++p1)
#pragma unroll
              for (int p0 = 0; p0 < 4; ++p0) { const int idx = o0 + (p1 + 4 * p0) * Ns0, s = idx + (idx >> 4); bufA[s] = xa[4 * p1 + p0]; bufB[s] = xb[4 * p1 + p0]; } }
        __syncthreads();
        const int Ns = Ns0 * 16, k = j & (Ns - 1);
#pragma unroll
        for (int q = 0; q < 16; ++q) { const int idx = j + TP * q, s = idx + (idx >> 4); xa[q] = bufA[s]; xb[q] = bufB[s]; }
        const f32x2 w1 = twg[k * (256 / Ns)]; f32x2 w = w1;
#pragma unroll
        for (int q = 1; q < 16; ++q) { xa[q] = cmul(xa[q], w); xb[q] = cmul(xb[q], w); w = cmul(w, w1); }
        dft16(xa); dft16(xb);
        __syncthreads();
    }
    const bool special = (mA == 0);
    if (LOG2N == 8 || (item & 15) == 0) {
        if (special) {
#pragma unroll
            for (int p1 = 0; p1 < 4; ++p1)
#pragma unroll
                for (int p0 = 0; p0 < 4; ++p0) { const int idx = j + TP * (p1 + 4 * p0); bufA[idx + (idx >> 4)] = xa[4 * p1 + p0]; } }
        __syncthreads();
        if (special) {
#pragma unroll
            for (int p1 = 0; p1 < 4; ++p1)
#pragma unroll
                for (int p0 = 0; p0 < 4; ++p0) { const int idx = j + TP * (p1 + 4 * p0), mi = (N - idx) & (N - 1); const f32x2 zr = bufA[mi + (mi >> 4)], z = xa[4 * p1 + p0];
                    xa[4 * p1 + p0] = (f32x2){(z.x + zr.x) * 0.5f, (z.y + zr.y) * 0.5f}; } }
        __syncthreads();
    }
#pragma unroll
    for (int p1 = 0; p1 < 4; ++p1)
#pragma unroll
        for (int p0 = 0; p0 < 4; ++p0) { const int idx = j + TP * (p1 + 4 * p0), mi = (N - idx) & (N - 1); const f32x2 za = xa[4 * p1 + p0], zb = xb[4 * p1 + p0];
            bf16* orow = CAT + (size_t)(rbase + idx) * DM + 1536 + 128 * h; bf16* mrow = CAT + (size_t)(rbase + mi) * DM + 1536 + 128 * h;
            if (special) { orow[0] = (bf16)f2bf(za.x * norm); orow[64] = (bf16)f2bf(za.y * norm); orow[1] = (bf16)f2bf(zb.x * norm); mrow[127] = (bf16)f2bf(zb.x * norm); }
            else { *(unsigned*)(orow + mA) = pk2(za.x * norm, zb.x * norm); mrow[128 - mA] = (bf16)f2bf(za.x * norm); mrow[127 - mA] = (bf16)f2bf(zb.x * norm); } }
}
#ifndef UP_ALIGN
#define UP_ALIGN true
#endif
#ifndef UP_SP2
#define UP_SP2 true
#endif

#ifndef NLAYER_RUN
#define NLAYER_RUN DEPTH
#endif
constexpr int N_PRO = 3, PH_PER_LAYER = 12, N_PHASES = N_PRO + DEPTH * PH_PER_LAYER;

__device__ __forceinline__ void ffn_up(Frame& F, int lf, int skip_epi) {
    pg8::Gemm g{(const bf16*)(F.ws + WS_H), (const bf16*)(F.ws + WS_WI) + (size_t)lf * 2 * DFF * DM, R, 2 * DFF, DM}; pg8::StaticOrderT<R, 2 * DFF, DM> S; S.init(F.G, F.bid);
    pg8::EpiSwiglu E{(bf16*)(F.ws + WS_ACT), DFF, skip_epi};
    pg8::gemm_phase<pg8::EpiSwiglu, pg8::StaticOrderT<R, 2 * DFF, DM>, UP_ALIGN, UP_SP2, DM>(F.lds, g, S, E);
}
template <int K, int NS> __device__ __forceinline__ void gemm_to_y(Frame& F, const bf16* A, const bf16* Bt) {
    pg8::Gemm g{A, Bt, R, DM, K}; pg8::SplitTailOrder<K, NS> S; S.init(F.G, F.bid);
    pg8::EpiYSplit E{(bf16*)(F.ws + WS_Y), (float*)(F.ws + WS_YP), DM};
    pg8::gemm_phase<pg8::EpiYSplit, pg8::SplitTailOrder<K, NS>, true, true, K>(F.lds, g, S, E);
}

__global__ void __launch_bounds__(NTHR, 2) fwd_kernel(Args args) {
    extern __shared__ __attribute__((aligned(16))) unsigned char lds_raw[];
    Frame F;
    F.lds = (LAS unsigned char*)lds_raw;
    F.tid = threadIdx.x; F.lane = F.tid & 63; F.wave = __builtin_amdgcn_readfirstlane(F.tid >> 6);
    F.G = gridDim.x; F.bid = blockIdx.x;
    F.out = args.out; F.ws = args.ws;
    volatile LAS unsigned* MISC = (volatile LAS unsigned*)(F.lds + MISC_OFF);
    if (F.tid < 32) MISC[F.tid] = 0u;
    __syncthreads();
    unsigned* ctl = (unsigned*)(F.ws + WS_CTL);
#if MK_PER_PHASE
    XcdBarrier bar; bar.bar = ctl + CW_BAR; bar.x = 0; bar.st = nullptr;
#define GRID_BAR() do { } while (0)
#else
    XcdBarrier bar = xcd_barrier_post(ctl + CW_BAR, MISC + 8);
#define GRID_BAR() xcd_barrier(bar)
#endif
    const int lo = args.ph_lo, hi = args.ph_hi;
    int ph = 0;
#ifndef BG_CONV
#define BG_CONV 1
#endif
#ifndef PROBE_SKIPEPI
#define PROBE_SKIPEPI 0
#endif
#ifndef PROBE_DUP
#define PROBE_DUP 0
#endif
#define PHASE(id, ...) if (ph >= lo && ph < hi) { { int t_ = threadIdx.x; asm volatile("" : "+v"(t_)); F.tid = t_; F.lane = t_ & 63; F.wave = __builtin_amdgcn_readfirstlane(t_ >> 6); } \
        { const int rep = 0; (void)rep; __VA_ARGS__; } if (PROBE_DUP != 0 && PROBE_DUP == (id)) { GRID_BAR(); { const int rep = 1; (void)rep; __VA_ARGS__; } } if (ph + 1 < hi) GRID_BAR(); } ++ph;

    PHASE(5, p0a(F, args))
    PHASE(10, p0b(F, args))
    const float* COMB = (const float*)(F.ws + WS_COMB);
    PHASE(0, norm_phase(F, args, true, false, 0, COMB + (size_t)12 * 9 * DM, 1.0f, true, false))

#pragma unroll 1
    for (int l = 0; l < NLAYER_RUN; ++l) {
        PHASE(1, { ffn_up(F, l * 2 + 0, (PROBE_SKIPEPI && rep && lo == 0) ? 1 : 0); if (BG_CONV && l < DEPTH - 1) bg_site(F, args, l + 1, BGB_UP1, 216, BG_UP); })
        PHASE(2, { gemm_to_y<DFF, 11>(F, (const bf16*)(F.ws + WS_ACT), (const bf16*)(F.ws + WS_WO) + (size_t)(l * 2 + 0) * DM * DFF); if (BG_CONV && l < DEPTH - 1) bg_site(F, args, l + 1, BGB_DN1, 176, BG_DN); })
        PHASE(11, norm_phase(F, args, l == 0, true, 11, COMB + (size_t)(l * 3 + 0) * 9 * DM, rep ? 0.0f : 1.0f, true, false))
        PHASE(3, {
            pg8::Gemm g{(const bf16*)(F.ws + WS_H), (const bf16*)(F.ws + WS_WIN) + (size_t)l * DIN * DM, R, DIN, DM}; pg8::StaticOrderT<R, DIN, DM> S; S.init(F.G, F.bid);
            pg8::EpiBf16<0> E{(bf16*)(F.ws + WS_P), DIN, nullptr, 0, 0, 1.f};
            pg8::gemm_phase<pg8::EpiBf16<0>, pg8::StaticOrderT<R, DIN, DM>, true, true, DM>(F.lds, g, S, E);
            if (BG_CONV && l < DEPTH - 1) bg_site(F, args, l + 1, BGB_IN, 118, BG_IN);
        })
        PHASE(6, {
            constexpr int W_ATT = 272, W_CFFT = W_ATT + 8, W_FFT = W_CFFT + 128, W_CONV = W_FFT + R / 16, W_SG = W_CONV + 32 * 9, W_END = W_SG;
            unsigned* qhead = ctl + CW_QUEUE + 64 * (l + 4 * rep);
            int it = F.bid;
            unsigned nxt = 0u;
            if (F.tid == 0) nxt = __hip_atomic_fetch_add(qhead, 1u, __ATOMIC_RELAXED, __HIP_MEMORY_SCOPE_AGENT) + (unsigned)F.G;
            while (it < W_END) {
                { int t_ = threadIdx.x; asm volatile("" : "+v"(t_)); F.tid = t_; F.lane = t_ & 63; F.wave = __builtin_amdgcn_readfirstlane(t_ >> 6); }
                if (it < W_ATT) { _Pragma("unroll 1") for (int rr = 0; rr < (PROBE_DUP == 61 ? 2 : 1); ++rr) attn_item_mfma(F, args, l, it); }
                else if (it < W_CFFT) fft_item<8>(F, args, it - W_ATT);
                else if (it < W_FFT) { _Pragma("unroll 1") for (int rr = 0; rr < (PROBE_DUP == 62 ? 2 : 1); ++rr) fft_item<12>(F, args, it - W_CFFT); }
                else if (it < W_CONV) { _Pragma("unroll 1") for (int rr = 0; rr < (PROBE_DUP == 63 ? 2 : 1); ++rr) conv_tile_v1(F, args, l, it - W_FFT); }
                else { ssm_sgemm_item(F, args, l, it - W_CONV); if (PROBE_DUP == 64) ssm_sgemm_item(F, args, l, it - W_CONV); }
                if (threadIdx.x == 0) MISC[0] = nxt;
                __syncthreads();
                it = __builtin_amdgcn_readfirstlane((int)MISC[0]);
                if (threadIdx.x == 0 && it < W_END) nxt = __hip_atomic_fetch_add(qhead, 1u, __ATOMIC_RELAXED, __HIP_MEMORY_SCOPE_AGENT) + (unsigned)F.G;
            }
            __syncthreads();
        })
        PHASE(8, {
            for (int it = F.bid; it < 32 * 8; it += F.G) {
                const int g = it & 31, rt = it >> 5;
                if (rt < 7) ssm_gemm_rows<1, 4>(F, args, l, g, rt * 64); else ssm_gemm_rows<1, 6>(F, args, l, g, 448);
            }
            __syncthreads();
        })
        PHASE(9, {
            for (int it = F.bid; it < 256; it += F.G) glu_item(F, args, l, it);
            __syncthreads();
        })
        PHASE(4, { gemm_to_y<DM, 4>(F, (const bf16*)(F.ws + WS_CAT), (const bf16*)(F.ws + WS_WOUT) + (size_t)l * DM * DM); if (BG_CONV && l < DEPTH - 1) bg_site(F, args, l + 1, BGB_OUT, 64, BG_OUT); })
        PHASE(11, norm_phase(F, args, false, true, 4, COMB + (size_t)(l * 3 + 1) * 9 * DM, rep ? 0.0f : 1.0f, true, false))
        PHASE(1, { ffn_up(F, l * 2 + 1, (PROBE_SKIPEPI && rep && lo == 0) ? 1 : 0); if (BG_CONV && l < DEPTH - 1) bg_site(F, args, l + 1, BGB_UP2, 216, BG_UP); })
        PHASE(2, { gemm_to_y<DFF, 11>(F, (const bf16*)(F.ws + WS_ACT), (const bf16*)(F.ws + WS_WO) + (size_t)(l * 2 + 1) * DM * DFF); if (BG_CONV && l < DEPTH - 1) bg_site(F, args, l + 1, BGB_DN2, 176, BG_DN); })
        PHASE(11, {
            const bool last = (l == DEPTH - 1);
            if (BG_CONV && !last) bg_drain(F, args, l + 1);
            norm_phase(F, args, false, true, 11, COMB + (size_t)(l * 3 + 2) * 9 * DM, rep ? 0.0f : 1.0f, !last, last);
        })
    }
}

extern "C" void kernel_launch(void* const* d_in, const int* in_sizes, int n_in, void* d_out, int out_size, void* d_ws, size_t ws_size, hipStream_t stream) {
    static int grid = 0;
    if (grid == 0) {
        if (n_in != 26 || in_sizes[0] != R_LAT * DM || out_size != R_LAT * DM || ws_size < WS_END) {
            fprintf(stderr, "kernel_launch: unexpected shapes: n_in %d in0 %d out %d ws %zu (need %zu)\n", n_in, n_in > 0 ? in_sizes[0] : -1, out_size, ws_size, (size_t)WS_END); grid = -1; return; }
        int dev = 0, cus = 0, per_cu = 0;
        if (hipGetDevice(&dev) != hipSuccess || hipDeviceGetAttribute(&cus, hipDeviceAttributeMultiprocessorCount, dev) != hipSuccess) { fprintf(stderr, "kernel_launch: device query failed\n"); grid = -1; return; }
        if (hipFuncSetAttribute((const void*)fwd_kernel, hipFuncAttributeMaxDynamicSharedMemorySize, LDS_BYTES) != hipSuccess) { fprintf(stderr, "kernel_launch: hipFuncSetAttribute failed\n"); grid = -1; return; }
        if (hipOccupancyMaxActiveBlocksPerMultiprocessor(&per_cu, (const void*)fwd_kernel, NTHR, LDS_BYTES) != hipSuccess || per_cu < 1)
            fprintf(stderr, "kernel_launch: note: occupancy query reports %d workgroups per CU\n", per_cu);
        (void)hipGetLastError();
        grid = cus;
    }
    if (grid < 0) return;
    if (hipMemsetAsync((char*)d_ws + WS_CTL, 0, CTL_ZERO_BYTES, stream) != hipSuccess) { fprintf(stderr, "kernel_launch: memset failed\n"); return; }
    Args a{};
    for (int i = 0; i < 26; ++i) a.in[i] = (const float*)d_in[i];
    a.out = (float*)d_out; a.ws = (unsigned char*)d_ws;
#if MK_PER_PHASE
    for (int p = 0; p < N_PHASES; ++p) { a.ph_lo = p; a.ph_hi = p + 1; hipLaunchKernelGGL(fwd_kernel, dim3(grid), dim3(NTHR), LDS_BYTES, stream, a); }
#else
    a.ph_lo = 0; a.ph_hi = N_PHASES;
    hipLaunchKernelGGL(fwd_kernel, dim3(grid), dim3(NTHR), LDS_BYTES, stream, a);
#endif
    const hipError_t le = hipPeekAtLastError();
    if (le != hipSuccess) fprintf(stderr, "kernel_launch: launch failed: %s\n", hipGetErrorName(le));
}
```

```cpp
#include <hip/hip_runtime.h>
#include <cstdio>
#include <cstdint>
namespace pg8 {
#define PG8_LAS __attribute__((address_space(3)))
typedef unsigned short bf16_t;
typedef short bf16x8 __attribute__((ext_vector_type(8)));
typedef float f32x4 __attribute__((ext_vector_type(4)));
typedef unsigned u32x4 __attribute__((ext_vector_type(4)));
constexpr int BM = 256, BK = 64, HALF = 128, HTB = HALF * BK * 2  , STAGE_BYTES = 8 * HTB, NXCD = 8, WGM = 8;

__host__ __device__ __forceinline__ int lds_byte(int r, int c) { const int st = (r >> 4) * 2 + (c >> 5), rr = r & 15, cc = c & 31, ob = rr * 64 + cc * 2; return st * 1024 + (ob ^ (((ob >> 9) & 1) << 5)); }
__host__ __device__ __forceinline__ void stage_rc(int b, int& R, int& C) { const int st = b / 1024, sb = b % 1024, swz = sb ^ (((sb >> 9) & 1) << 5); R = (st >> 1) * 16 + swz / 64; C = (st & 1) * 32 + (swz % 64) / 2; }
__host__ __device__ __forceinline__ int perm32(int rho) { const int n = rho >> 4, i = rho & 15; return 8 * (i >> 2) + 4 * n + (i & 3); }

struct Unit { int pm, pn, k0, nt, ks; };
struct Gemm { const bf16_t* A; const bf16_t* Bt; int M, N, K; };

struct StaticOrder {
    int nM, nN, nwg, G, c, ntf;
    __host__ __device__ void init(int M, int N, int K, int G_, int c_) { nM = M / BM; nN = N / BM; nwg = nM * nN; G = G_; c = c_; ntf = K / BK; }
    __host__ __device__ __forceinline__ bool next(int i, Unit& u) const {
        const long L = (long)i * G + c; if (L >= nwg) return false;
        int wgid = (int)L; { const int q = nwg / NXCD, r = nwg % NXCD, xcd = wgid % NXCD, off = wgid / NXCD; wgid = (xcd < r ? xcd * (q + 1) : r * (q + 1) + (xcd - r) * q) + off; }
        const int nig = WGM * nN, gid = wgid / nig, fm = gid * WGM, gsz = (nM - fm) < WGM ? (nM - fm) : WGM;
        u.pm = fm + ((wgid % nig) % gsz); u.pn = (wgid % nig) / gsz; u.k0 = 0; u.nt = ntf; u.ks = 0; return true;
    }
    __device__ __forceinline__ void a_ready(const Unit&) const {}
    __device__ __forceinline__ void done(const Unit&) const {}
};

template <int M_, int N_, int K_> struct StaticOrderT {
    int G, c;
    __host__ __device__ void init(int G_, int c_) { G = G_; c = c_; }
    __host__ __device__ __forceinline__ bool next(int i, Unit& u) const {
        constexpr int nM = M_ / BM, nN = N_ / BM, nwg = nM * nN;
        const long L = (long)i * G + c; if (L >= nwg) return false;
        int wgid = (int)L; { constexpr int q = nwg / NXCD, r = nwg % NXCD; const int xcd = wgid % NXCD, off = wgid / NXCD; wgid = (xcd < r ? xcd * (q + 1) : r * (q + 1) + (xcd - r) * q) + off; }
        constexpr int nig = WGM * nN; const int gid = wgid / nig, fm = gid * WGM, gsz = (nM - fm) < WGM ? (nM - fm) : WGM;
        u.pm = fm + ((wgid % nig) % gsz); u.pn = (wgid % nig) / gsz; u.k0 = 0; u.nt = K_ / BK; u.ks = 0; return true;
    }
    __device__ __forceinline__ void a_ready(const Unit&) const {}
    __device__ __forceinline__ void done(const Unit&) const {}
};
template <int K_, int NS> struct SplitTailOrder {
    int G, c, ntail;
    __host__ __device__ void init(int G_, int c_, bool with_tail = true) { G = G_; c = c_; ntail = with_tail ? 16 * NS : 0; }
    __host__ __device__ __forceinline__ bool next(int i, Unit& u) const {
        constexpr int ntsub = K_ / BK / NS, nN = 8, nwg = 256, nig = WGM * nN;
        const int L = i * G + c;
        if (L >= 256 + ntail) return false;
        const bool tail = L >= 256;
        const int Lc = tail ? 0 : L; const int wgid = (Lc % NXCD) * (nwg / NXCD) + Lc / NXCD;
        const int gid = wgid / nig, fm = gid * WGM; const int pm0 = fm + ((wgid % nig) % WGM), pn0 = (wgid % nig) / WGM;
        const int j = tail ? L - 256 : 0, tile = j / NS, ks = j % NS;
        u.pm = tail ? 32 + tile / 8 : pm0; u.pn = tail ? tile % 8 : pn0; u.ks = tail ? ks : 0; u.nt = tail ? ntsub : K_ / BK; u.k0 = tail ? ks * ntsub * BK : 0;
        return true;
    }
    __device__ __forceinline__ void a_ready(const Unit&) const {}
    __device__ __forceinline__ void done(const Unit&) const {}
};

__device__ __forceinline__ unsigned cvt_pk_bf16(float lo, float hi) { unsigned r; asm volatile("v_cvt_pk_bf16_f32 %0, %1, %2" : "=v"(r) : "v"(lo), "v"(hi)); return r; }
typedef float f32x2 __attribute__((ext_vector_type(2)));
__device__ __forceinline__ f32x2 gelu_pk(f32x2 v) {
    const f32x2 av = __builtin_elementwise_abs(v), d = av * 0.2316418882f + 1.0f;
    f32x2 t; t.x = __builtin_amdgcn_rcpf(d.x); t.y = __builtin_amdgcn_rcpf(d.y);
    f32x2 q = t * 0.5307027145f + (-0.7265760135f); q = q * t + 0.7107068705f; q = q * t + (-0.142248368f); q = q * t + 0.127414796f; q = q * t;
    const f32x2 s = (v * v) * (-0.72134752044f);
    f32x2 e; e.x = __builtin_amdgcn_exp2f(s.x); e.y = __builtin_amdgcn_exp2f(s.y);
    const f32x2 m = v * (q * e), r = v - m;
    f32x2 o; o.x = v.x < 0.f ? m.x : r.x; o.y = v.y < 0.f ? m.y : r.y; return o;
}

template <int ACT  > struct EpiBf16 {
    static constexpr bool PERM = true, AFTER_DRAIN = false; static_assert(ACT == 0 || ACT == 1, "EpiBf16: ACT is 0 (none) or 1 (gelu_pk)");
    bf16_t* O; int ldc; const float* bias; int split_cols; size_t split_stride; float scale0;
    __device__ __forceinline__ void operator()(const f32x4 (&acc)[2][2][4][2], const Unit& u, int wr, int wc, int fr, int fq) const {
        const int row0 = u.pm * BM + wr * 64 + fr; int colt = u.pn * BM; bf16_t* base = O;
        float sc = 1.f; if (split_cols) { const int t = colt / split_cols; base += (size_t)t * split_stride; colt -= t * split_cols; if (t == 0) sc = scale0; }
        const int col0 = colt + wc * 32 + 8 * fq, bcol0 = u.pn * BM + wc * 32 + 8 * fq;
        f32x4 bv[2][2];
#pragma unroll
        for (int bj = 0; bj < 2; ++bj)
#pragma unroll
            for (int n = 0; n < 2; ++n) bv[bj][n] = bias ? *(const f32x4*)(bias + bcol0 + bj * HALF + 4 * n) : (f32x4){0.f, 0.f, 0.f, 0.f};
#pragma unroll
        for (int ai = 0; ai < 2; ++ai)
#pragma unroll
            for (int m = 0; m < 4; ++m) { bf16_t* rowp = base + (size_t)(row0 + ai * HALF + m * 16) * ldc + col0;
#pragma unroll
                for (int bj = 0; bj < 2; ++bj) { f32x4 v0 = acc[ai][bj][m][0] + bv[bj][0], v1 = acc[ai][bj][m][1] + bv[bj][1];
                    if (ACT == 1) { f32x2 a = gelu_pk((f32x2){v0[0], v0[1]}), b = gelu_pk((f32x2){v0[2], v0[3]}), c = gelu_pk((f32x2){v1[0], v1[1]}), d = gelu_pk((f32x2){v1[2], v1[3]});
                        v0 = (f32x4){a.x, a.y, b.x, b.y}; v1 = (f32x4){c.x, c.y, d.x, d.y}; }
                    v0 = v0 * sc; v1 = v1 * sc; u32x4 w; w.x = cvt_pk_bf16(v0[0], v0[1]); w.y = cvt_pk_bf16(v0[2], v0[3]); w.z = cvt_pk_bf16(v1[0], v1[1]); w.w = cvt_pk_bf16(v1[2], v1[3]);
                    *(u32x4*)(rowp + bj * HALF) = w; } }
    }
};
struct EpiF32 {
    static constexpr bool PERM = false, AFTER_DRAIN = false;
    float* C; int ldc; const float* bias;
    __device__ __forceinline__ void operator()(const f32x4 (&acc)[2][2][4][2], const Unit& u, int wr, int wc, int fr, int fq) const {
        const int row0 = u.pm * BM + wr * 64 + fr, col0 = u.pn * BM + wc * 32 + 4 * fq;
        f32x4 bv[2][2];
#pragma unroll
        for (int bj = 0; bj < 2; ++bj)
#pragma unroll
            for (int n = 0; n < 2; ++n) bv[bj][n] = bias ? *(const f32x4*)(bias + col0 + bj * HALF + n * 16) : (f32x4){0.f, 0.f, 0.f, 0.f};
#pragma unroll
        for (int ai = 0; ai < 2; ++ai)
#pragma unroll
            for (int m = 0; m < 4; ++m) { float* rowp = C + (size_t)(row0 + ai * HALF + m * 16) * ldc + col0;
#pragma unroll
                for (int bj = 0; bj < 2; ++bj)
#pragma unroll
                    for (int n = 0; n < 2; ++n) *(f32x4*)(rowp + bj * HALF + n * 16) = acc[ai][bj][m][n] + bv[bj][n]; }
    }
};
__device__ __forceinline__ void store16_wt(void* p, u32x4 v) { asm volatile("global_store_dwordx4 %0, %1, off sc1\n\ts_nop 1" :: "v"(p), "v"(v) : "memory");     }
#ifndef NT_ACT
#define NT_ACT 0
#endif
struct EpiSwiglu {
    static constexpr bool PERM = true, AFTER_DRAIN = false;
    bf16_t* O; int ldc; int skip;
    __device__ __forceinline__ void operator()(const f32x4 (&acc)[2][2][4][2], const Unit& u, int wr, int wc, int fr, int fq) const {
        if (skip) return;
        const int row0 = u.pm * BM + wr * 64 + fr, col0 = u.pn * HALF + wc * 32 + 8 * fq;
#pragma unroll
        for (int ai = 0; ai < 2; ++ai)
#pragma unroll
            for (int m = 0; m < 4; ++m) { bf16_t* rowp = O + (size_t)(row0 + ai * HALF + m * 16) * ldc + col0;
                float v[8];
#pragma unroll
                for (int n = 0; n < 2; ++n)
#pragma unroll
                    for (int j = 0; j < 4; ++j) { const float g = acc[ai][0][m][n][j], up = acc[ai][1][m][n][j];
                        v[n * 4 + j] = g * __builtin_amdgcn_rcpf(1.0f + __expf(-g)) * up; }
                u32x4 w; w.x = cvt_pk_bf16(v[0], v[1]); w.y = cvt_pk_bf16(v[2], v[3]); w.z = cvt_pk_bf16(v[4], v[5]); w.w = cvt_pk_bf16(v[6], v[7]);
                if (NT_ACT) __builtin_nontemporal_store(w, (u32x4*)rowp); else *(u32x4*)rowp = w; }
    }
};
struct EpiGlu {
    static constexpr bool PERM = true, AFTER_DRAIN = false;
    const bf16_t* YG; int ldy; bf16_t* O; int ldc; const float* bias;
    __device__ __forceinline__ void operator()(const f32x4 (&acc)[2][2][4][2], const Unit& u, int wr, int wc, int fr, int fq) const {
        const int row0 = u.pm * BM + wr * 64 + fr, col0 = u.pn * BM + wc * 32 + 8 * fq;
#pragma unroll
        for (int ai = 0; ai < 2; ++ai)
#pragma unroll
            for (int m = 0; m < 4; ++m) { const int row = row0 + ai * HALF + m * 16;
#pragma unroll
                for (int bj = 0; bj < 2; ++bj) { const int c = col0 + bj * HALF;
                    const u32x4 y = *(const u32x4*)(YG + (size_t)row * ldy + c);
                    const f32x4 b0 = *(const f32x4*)(bias + c), b1 = *(const f32x4*)(bias + c + 4);
                    const f32x4 z0 = acc[ai][bj][m][0] + b0, z1 = acc[ai][bj][m][1] + b1;
                    float v[8];
                    v[0] = __builtin_bit_cast(float, y.x << 16); v[1] = __builtin_bit_cast(float, y.x & 0xffff0000u); v[2] = __builtin_bit_cast(float, y.y << 16); v[3] = __builtin_bit_cast(float, y.y & 0xffff0000u);
                    v[4] = __builtin_bit_cast(float, y.z << 16); v[5] = __builtin_bit_cast(float, y.z & 0xffff0000u); v[6] = __builtin_bit_cast(float, y.w << 16); v[7] = __builtin_bit_cast(float, y.w & 0xffff0000u);
#pragma unroll
                    for (int j = 0; j < 4; ++j) { v[j] *= __builtin_amdgcn_rcpf(1.0f + __expf(-z0[j])); v[4 + j] *= __builtin_amdgcn_rcpf(1.0f + __expf(-z1[j])); }
                    u32x4 w; w.x = cvt_pk_bf16(v[0], v[1]); w.y = cvt_pk_bf16(v[2], v[3]); w.z = cvt_pk_bf16(v[4], v[5]); w.w = cvt_pk_bf16(v[6], v[7]);
                    *(u32x4*)(O + (size_t)row * ldc + c) = w; } }
    }
};
#ifndef NT_Y
#define NT_Y 0
#endif
struct EpiYSplit {
    static constexpr bool PERM = true, AFTER_DRAIN = false;
    bf16_t* C; float* CP; int ldc;
    __device__ __forceinline__ void operator()(const f32x4 (&acc)[2][2][4][2], const Unit& u, int wr, int wc, int fr, int fq) const {
        const int row0 = u.pm * BM + wr * 64 + fr, col0 = u.pn * BM + wc * 32 + 8 * fq;
        if (u.pm < 32) {
#pragma unroll
            for (int ai = 0; ai < 2; ++ai)
#pragma unroll
                for (int m = 0; m < 4; ++m) { bf16_t* rowp = C + (size_t)(row0 + ai * HALF + m * 16) * ldc + col0;
#pragma unroll
                    for (int bj = 0; bj < 2; ++bj) { const f32x4 v0 = acc[ai][bj][m][0], v1 = acc[ai][bj][m][1];
                        u32x4 w; w.x = cvt_pk_bf16(v0[0], v0[1]); w.y = cvt_pk_bf16(v0[2], v0[3]); w.z = cvt_pk_bf16(v1[0], v1[1]); w.w = cvt_pk_bf16(v1[2], v1[3]);
                        if (NT_Y) __builtin_nontemporal_store(w, (u32x4*)(rowp + bj * HALF)); else *(u32x4*)(rowp + bj * HALF) = w; } }
        } else {
            float* base = CP + ((size_t)u.ks * 512 + (row0 - 8192)) * ldc + col0;
#pragma unroll
            for (int ai = 0; ai < 2; ++ai)
#pragma unroll
                for (int m = 0; m < 4; ++m) { float* rowp = base + (size_t)(ai * HALF + m * 16) * ldc;
#pragma unroll
                    for (int bj = 0; bj < 2; ++bj) { *(f32x4*)(rowp + bj * HALF) = acc[ai][bj][m][0]; *(f32x4*)(rowp + bj * HALF + 4) = acc[ai][bj][m][1]; } }
        }
    }
};

template <class Epi, class Sched, bool ALIGN_EPI = false, bool SP2 = false, int KP = 0>
__device__ __forceinline__ void gemm_phase(PG8_LAS unsigned char* lds, const Gemm g, const Sched& S, const Epi& E) {
    int tid_ = threadIdx.x; asm volatile("" : "+v"(tid_)); const int tid = tid_, wid = __builtin_amdgcn_readfirstlane(tid >> 6), lane = tid & 63, wr = wid >> 2, wc = wid & 3, fr = lane & 15, fq = lane >> 4;
    const int K = KP ? KP : g.K;
    unsigned voffA[2], voffB[2];
#pragma unroll
    for (int i = 0; i < 2; ++i) { int R, C; stage_rc(tid * 16 + i * 8192, R, C); const int Rb = Epi::PERM ? ((R & ~31) + perm32(R & 31)) : R;
        voffA[i] = (unsigned)(R * K + C) * 2u; voffB[i] = (unsigned)(Rb * K + C) * 2u; }
    const size_t kstep = (size_t)(BK * 2);
    const size_t hstep = (size_t)HALF * K * 2;
    const size_t tstep = 2 * hstep;
    const unsigned ldsw = (unsigned)wid * 1024u;
    const int aoff = lds_byte(wr * 64 + fr, fq * 8), boff = lds_byte(wc * 32 + fr, fq * 8);
#define PG8_SA(b, h) (((b) * 2 + (h)) * HTB)
#define PG8_SB(b, h) ((4 + (b) * 2 + (h)) * HTB)
#ifndef PG8_AUX_voffB
#define PG8_AUX_voffB 0
#endif
#define PG8_AUX_voffA 0
#define PG8_STAGE(bufoff, gbase, voff) do { _Pragma("unroll") for (int _i = 0; _i < 2; ++_i) \
        __builtin_amdgcn_global_load_lds((const unsigned*)((const char*)(gbase) + (voff)[_i]), (PG8_LAS unsigned*)(lds + (bufoff) + ldsw + _i * 8192), 16, 0, PG8_AUX_##voff); } while (0)
#define PG8_LDA(dst, b, h) do { _Pragma("unroll") for (int m = 0; m < 4; ++m) _Pragma("unroll") for (int k = 0; k < 2; ++k) dst[m][k] = *(const PG8_LAS bf16x8*)(lds + PG8_SA(b, h) + aoff + m * 2048 + k * 1024); } while (0)
#define PG8_LDB(dst, b, h) do { _Pragma("unroll") for (int n = 0; n < 2; ++n) _Pragma("unroll") for (int k = 0; k < 2; ++k) dst[n][k] = *(const PG8_LAS bf16x8*)(lds + PG8_SB(b, h) + boff + n * 2048 + k * 1024); } while (0)
#define PG8_MMA(ai, bj, At, Bt) do { __builtin_amdgcn_s_setprio(1); _Pragma("unroll") for (int m = 0; m < 4; ++m) _Pragma("unroll") for (int n = 0; n < 2; ++n) _Pragma("unroll") for (int k = 0; k < 2; ++k) \
        acc[ai][bj][m][n] = __builtin_amdgcn_mfma_f32_16x16x32_bf16(Bt[n][k], At[m][k], acc[ai][bj][m][n], 0, 0, 0); __builtin_amdgcn_s_setprio(0); } while (0)
#define PG8_WAIT_V(n) asm volatile("s_waitcnt vmcnt(" #n ")" ::: "memory")
#define PG8_WAIT_L(n) asm volatile("s_waitcnt lgkmcnt(" #n ")" ::: "memory")
#define PG8_BAR __builtin_amdgcn_s_barrier()
#define PG8_SCHED __builtin_amdgcn_sched_barrier(0)
    Unit cur, nxt; int ui = 0;
    if (!S.next(0, cur)) return;
    f32x4 acc[2][2][4][2];
#pragma unroll
    for (int a = 0; a < 2; ++a)
#pragma unroll
        for (int b = 0; b < 2; ++b)
#pragma unroll
            for (int m = 0; m < 4; ++m)
#pragma unroll
                for (int n = 0; n < 2; ++n) acc[a][b][m][n] = (f32x4){0.f, 0.f, 0.f, 0.f};
    bf16x8 At[4][2], B0[2][2], B1[2][2];
    const char* cA = (const char*)g.A + (size_t)cur.pm * tstep + (size_t)cur.k0 * 2; const char* cB = (const char*)g.Bt + (size_t)cur.pn * tstep + (size_t)cur.k0 * 2;
    S.a_ready(cur);
    if constexpr (SP2) {
        PG8_STAGE(PG8_SB(0, 0), cB, voffB); PG8_STAGE(PG8_SB(0, 1), cB + hstep, voffB); PG8_STAGE(PG8_SA(0, 0), cA, voffA); PG8_STAGE(PG8_SA(0, 1), cA + hstep, voffA);
        if (wr == 1) PG8_BAR;
        PG8_WAIT_V(2); PG8_BAR;
        PG8_STAGE(PG8_SB(1, 0), cB + kstep, voffB); PG8_STAGE(PG8_SA(1, 0), cA + kstep, voffA); PG8_STAGE(PG8_SB(1, 1), cB + hstep + kstep, voffB);
        PG8_WAIT_V(6); PG8_BAR;
    } else {
        PG8_STAGE(PG8_SB(0, 0), cB, voffB); PG8_STAGE(PG8_SA(0, 0), cA, voffA); PG8_STAGE(PG8_SB(0, 1), cB + hstep, voffB); PG8_STAGE(PG8_SA(0, 1), cA + hstep, voffA);
        if (wr == 1) PG8_BAR;
        PG8_WAIT_V(4); PG8_BAR;
        PG8_STAGE(PG8_SB(1, 0), cB + kstep, voffB); PG8_STAGE(PG8_SA(1, 0), cA + kstep, voffA); PG8_STAGE(PG8_SB(1, 1), cB + hstep + kstep, voffB);
        PG8_WAIT_V(6); PG8_BAR;
    }
    for (;;) {
        const bool has_next = S.next(ui + 1, nxt);
        const char* nA = has_next ? (const char*)g.A + (size_t)nxt.pm * tstep + (size_t)nxt.k0 * 2 : cA; const char* nB = has_next ? (const char*)g.Bt + (size_t)nxt.pn * tstep + (size_t)nxt.k0 * 2 : cB;
        const int nt = cur.nt;
        for (int t = 0; t < nt; t += 2) {
            const bool last = (t == nt - 2);
            const char* a1 = cA + (size_t)(t + 1) * kstep;
            const char* a2 = last ? nA : cA + (size_t)(t + 2) * kstep; const char* b2 = last ? nB : cB + (size_t)(t + 2) * kstep;
            const char* a3 = a2 + kstep; const char* b3 = b2 + kstep;
            if (last && has_next) S.a_ready(nxt);
            if constexpr (SP2) {
            PG8_LDB(B0, 0, 0); PG8_LDB(B1, 0, 1); PG8_SCHED; PG8_LDA(At, 0, 0); PG8_STAGE(PG8_SA(1, 1), a1 + hstep, voffA);
            PG8_WAIT_V(8); PG8_WAIT_L(0); PG8_BAR; PG8_MMA(0, 0, At, B0); PG8_MMA(0, 1, At, B1); PG8_BAR; PG8_SCHED;
            PG8_LDA(At, 0, 1); PG8_STAGE(PG8_SB(0, 0), b2, voffB); PG8_STAGE(PG8_SB(0, 1), b2 + hstep, voffB); PG8_STAGE(PG8_SA(0, 0), a2, voffA);
            PG8_WAIT_V(8); PG8_WAIT_L(0); PG8_BAR; PG8_MMA(1, 0, At, B0); PG8_MMA(1, 1, At, B1); PG8_BAR; PG8_SCHED;
            PG8_LDB(B0, 1, 0); PG8_LDB(B1, 1, 1); PG8_SCHED; PG8_LDA(At, 1, 0); PG8_STAGE(PG8_SA(0, 1), a2 + hstep, voffA);
            PG8_WAIT_V(8); PG8_WAIT_L(0); PG8_BAR; PG8_MMA(0, 0, At, B0); PG8_MMA(0, 1, At, B1); PG8_BAR; PG8_SCHED;
            PG8_LDA(At, 1, 1); PG8_STAGE(PG8_SB(1, 0), b3, voffB); PG8_STAGE(PG8_SB(1, 1), b3 + hstep, voffB); PG8_STAGE(PG8_SA(1, 0), a3, voffA);
            PG8_WAIT_V(8); PG8_WAIT_L(0); PG8_BAR; PG8_MMA(1, 0, At, B0); PG8_MMA(1, 1, At, B1); PG8_BAR; PG8_SCHED;
            } else {
            PG8_LDB(B0, 0, 0); PG8_SCHED; PG8_LDA(At, 0, 0); PG8_STAGE(PG8_SA(1, 1), a1 + hstep, voffA);
            PG8_WAIT_L(8); PG8_BAR; PG8_WAIT_L(0); PG8_MMA(0, 0, At, B0); PG8_BAR; PG8_SCHED;
            PG8_LDB(B1, 0, 1); PG8_STAGE(PG8_SB(0, 0), b2, voffB);
            PG8_BAR; PG8_WAIT_L(0); PG8_MMA(0, 1, At, B1); PG8_BAR;
            PG8_LDA(At, 0, 1); PG8_STAGE(PG8_SA(0, 0), a2, voffA);
            PG8_BAR; PG8_WAIT_L(0); PG8_MMA(1, 0, At, B0); PG8_BAR; PG8_SCHED;
            PG8_STAGE(PG8_SB(0, 1), b2 + hstep, voffB);
            PG8_WAIT_V(6); PG8_BAR; PG8_MMA(1, 1, At, B1); PG8_BAR;
            PG8_LDB(B0, 1, 0); PG8_SCHED; PG8_LDA(At, 1, 0); PG8_STAGE(PG8_SA(0, 1), a2 + hstep, voffA);
            PG8_WAIT_L(8); PG8_BAR; PG8_WAIT_L(0); PG8_MMA(0, 0, At, B0); PG8_BAR; PG8_SCHED;
            PG8_LDB(B1, 1, 1); PG8_STAGE(PG8_SB(1, 0), b3, voffB);
            PG8_BAR; PG8_WAIT_L(0); PG8_MMA(0, 1, At, B1); PG8_BAR;
            PG8_LDA(At, 1, 1); PG8_STAGE(PG8_SA(1, 0), a3, voffA);
            PG8_BAR; PG8_WAIT_L(0); PG8_MMA(1, 0, At, B0); PG8_BAR; PG8_SCHED;
            PG8_STAGE(PG8_SB(1, 1), b3 + hstep, voffB);
            PG8_WAIT_V(6); PG8_BAR; PG8_MMA(1, 1, At, B1); PG8_BAR;
            }
        }
        if constexpr (ALIGN_EPI) { if (wr == 0) PG8_BAR; }
        if constexpr (!Epi::AFTER_DRAIN) { E(acc, cur, wr, wc, fr, fq); S.done(cur); }
        if (!has_next) break;
#pragma unroll
        for (int a = 0; a < 2; ++a)
#pragma unroll
            for (int b = 0; b < 2; ++b)
#pragma unroll
                for (int m = 0; m < 4; ++m)
#pragma unroll
                    for (int n = 0; n < 2; ++n) acc[a][b][m][n] = (f32x4){0.f, 0.f, 0.f, 0.f};
        cur = nxt; cA = nA; cB = nB; ++ui;
        if constexpr (ALIGN_EPI) { if (wr == 1) PG8_BAR; }
    }
    PG8_WAIT_V(0);
    if constexpr (!ALIGN_EPI) { if (wr == 0) PG8_BAR; }
    PG8_BAR;
    if constexpr (Epi::AFTER_DRAIN) { E.fused(acc, cur, wr, wc, fr, fq, lds, wid, lane); S.done(cur); }
#undef PG8_SA
#undef PG8_SB
#undef PG8_STAGE
#undef PG8_LDA
#undef PG8_LDB
#undef PG8_MMA
#undef PG8_WAIT_V
#undef PG8_WAIT_L
#undef PG8_BAR
#undef PG8_SCHED
}
}
#ifndef MK_PER_PHASE
#define MK_PER_PHASE 0
#endif
constexpr int DM = 2048, NBATCH = 2, SEQ = 4096, DEPTH = 4, CTXL = 256, DFF = 5632, DIN = 2816;
constexpr int R_LAT = NBATCH * SEQ, R_CTX = NBATCH * CTXL, R = R_LAT + R_CTX;
constexpr int K_OFF = 0, V_OFF = 128, SSM_OFF = 256, Q_OFF = 768, CONV_OFF = 1280, FFT_OFF = 2304;
constexpr int MODW = 9 * DM;
constexpr int NWAVES = 8, NTHR = 512;
constexpr int MOD_CHUNKS = 32;

constexpr size_t MiB = 1u << 20;
constexpr size_t WS_CTL = 0, CTL_ZERO_BYTES = 1 * MiB;
constexpr size_t WS_MOD = 1 * MiB;
constexpr size_t WS_ROPE = 2 * MiB;
constexpr size_t WS_TW = WS_ROPE + 65536;
constexpr size_t WS_SSMA = WS_ROPE + 131072;
constexpr size_t WS_SSMBB = 3 * MiB;
constexpr size_t WS_SSMCT = 5 * MiB;
constexpr size_t WS_WFOLD = 7 * MiB;
constexpr size_t WS_MODP = 23 * MiB;
constexpr size_t WS_WI = 50 * MiB;
constexpr size_t WS_WO = WS_WI + 352 * MiB;
constexpr size_t WS_WIN = WS_WO + 176 * MiB;
constexpr size_t WS_WOUT = WS_WIN + 44 * MiB;
constexpr size_t WS_X = WS_WOUT + 32 * MiB;
constexpr size_t WS_H = WS_X + 68 * MiB;
constexpr size_t WS_ACT = WS_H + 34 * MiB;
constexpr size_t WS_Y = WS_ACT + 94 * MiB;
constexpr size_t WS_P = WS_Y + 68 * MiB;
constexpr size_t WS_CAT = WS_P + 47 * MiB;
constexpr size_t WS_SSMWS = WS_CAT + 34 * MiB;
constexpr size_t WS_SSMWY = WS_SSMWS + 16 * MiB;
constexpr size_t WS_SSMS = WS_SSMWY + 32 * MiB;
constexpr size_t WS_POW = WS_SSMS + 17 * MiB;
constexpr size_t WS_YG = WS_POW + 9 * MiB;
constexpr size_t WS_GLUW = WS_YG + 9 * MiB;
constexpr size_t WS_A16 = WS_GLUW + 2 * MiB;
constexpr size_t WS_ET = WS_A16 + 256 * 1024;
constexpr size_t WS_YP = WS_A16 + 1 * MiB;
constexpr size_t WS_COMB = WS_YP + 44 * MiB;
constexpr size_t WS_END = WS_COMB + 1 * MiB;
constexpr int NCR = R / 16;
constexpr int CW_CONVQ = 10240, CW_DONE = 12288;
constexpr int CW_QUEUE = 8192;
constexpr int CW_BAR = 4096;

constexpr int RING_BYTES = 131072;
constexpr int MISC_OFF = 147456 - 256;
constexpr int LDS_BYTES = 147456;

#define GAS __attribute__((address_space(1)))
#define LAS __attribute__((address_space(3)))
typedef unsigned short bf16;
typedef unsigned v4u __attribute__((ext_vector_type(4)));
typedef unsigned v2u __attribute__((ext_vector_type(2)));
typedef float f32x4 __attribute__((ext_vector_type(4)));
typedef float f32x2 __attribute__((ext_vector_type(2)));
#define LDS_WAIT() asm volatile("s_waitcnt lgkmcnt(0)" ::: "memory")
#define VM_WAIT() asm volatile("s_waitcnt vmcnt(0)" ::: "memory")
typedef float f32x2cv __attribute__((ext_vector_type(2))); typedef __bf16 bf16x2cv __attribute__((ext_vector_type(2)));
__device__ __forceinline__ unsigned pk2(float lo, float hi) { const f32x2cv v = {lo, hi}; return __builtin_bit_cast(unsigned, __builtin_convertvector(v, bf16x2cv)); }
__device__ __forceinline__ unsigned f2bf(float f) { return pk2(f, 0.0f) & 0xffffu; }
__device__ __forceinline__ float bflo(unsigned w) { return __builtin_bit_cast(float, w << 16); }
__device__ __forceinline__ float bfhi(unsigned w) { return __builtin_bit_cast(float, w & 0xffff0000u); }
__device__ __forceinline__ float bf1(bf16 v) { return __builtin_bit_cast(float, (unsigned)v << 16); }
__device__ __forceinline__ float sigmoidf_(float x) { return __builtin_amdgcn_rcpf(1.0f + __expf(-x)); }
__device__ __forceinline__ float wave_sum(float v) {
#pragma unroll
    for (int o = 1; o < 64; o <<= 1) v += __shfl_xor(v, o);
    return v;
}

#define XB_TMO      128
#define XB_XCNT(j)  (256  + 64 * (j))
#define XB_XSUB(j)  (1280 + 64 * (j))
#define XB_XGEN(j)  (2304 + 64 * (j))
#define XB_TOP      3328
#define XB_TOPGEN   3392
#define XCD_BAR_WORDS 3456
#define XB_SPIN_CAP (1u << 18)

__device__ __forceinline__ unsigned xb_ld(unsigned* p)              { return __hip_atomic_load(p, __ATOMIC_RELAXED, __HIP_MEMORY_SCOPE_AGENT); }
__device__ __forceinline__ unsigned xb_add(unsigned* p, unsigned v) { return __hip_atomic_fetch_add(p, v, __ATOMIC_RELAXED, __HIP_MEMORY_SCOPE_AGENT); }
__device__ __forceinline__ unsigned xb_xcc_id() { return (unsigned)__builtin_amdgcn_s_getreg((3 << 11) | 20) & 0xFu; }
#define XB_SPIN(cond, bar) do { unsigned _sp = 0; while (cond) { __builtin_amdgcn_s_sleep(1); \
    if ((++_sp & 255u) == 0u) { if (xb_ld(&(bar)[XB_TMO])) break; if (_sp > XB_SPIN_CAP) { atomicAdd(&(bar)[XB_TMO], 1u); break; } } } } while (0)

struct XcdBarrier {
    unsigned* bar; unsigned x;
    volatile LAS unsigned* st;
};

__device__ __forceinline__ XcdBarrier xcd_barrier_post(unsigned* bar, volatile LAS unsigned* st) {
    XcdBarrier b; b.bar = bar; b.x = xb_xcc_id(); b.st = st;
    if (threadIdx.x == 0) (void)xb_add(&bar[XB_XCNT(b.x)], 1u);
    return b;
}
__device__ __forceinline__ void xcd_barrier_complete(unsigned* bar, unsigned x, unsigned& nloc, unsigned& nx) {
    const unsigned G = gridDim.x * gridDim.y * gridDim.z;
    unsigned sum, cnt, mine, sp = 0u;
    for (;;) {
        sum = 0u; cnt = 0u; mine = 0u;
#pragma unroll
        for (unsigned j = 0; j < 16; ++j) { const unsigned c = xb_ld(&bar[XB_XCNT(j)]); sum += c; cnt += (c > 0u) ? 1u : 0u; mine = (j == x) ? c : mine; }
        if (sum == G) break;
        __builtin_amdgcn_s_sleep(1);
        if ((++sp & 255u) == 0u) { if (xb_ld(&bar[XB_TMO])) break; if (sp > XB_SPIN_CAP) { atomicAdd(&bar[XB_TMO], 1u); break; } }
    }
    nloc = mine > 0u ? mine : 1u; nx = cnt > 0u ? cnt : 1u;
}

__device__ __forceinline__ void xcd_barrier(const XcdBarrier& b) {
    asm volatile("s_waitcnt vmcnt(0)" ::: "memory");
    __syncthreads();
    if (threadIdx.x == 0) {
        unsigned* bar = b.bar;
        __builtin_amdgcn_s_waitcnt(0);
        unsigned nloc = b.st[0], nx = b.st[1];
        if (nloc == 0u) { xcd_barrier_complete(bar, b.x, nloc, nx); b.st[0] = nloc; b.st[1] = nx; }
        const unsigned old = xb_add(&bar[XB_XSUB(b.x)], 1u);
        const unsigned gen = old / nloc;
        if (old + 1u == (gen + 1u) * nloc) {
            __builtin_amdgcn_fence(__ATOMIC_RELEASE, "agent");
            asm volatile("s_waitcnt vmcnt(0)" ::: "memory");
            const unsigned og = xb_add(&bar[XB_TOP], 1u);
            const unsigned tg = og / nx;
            if (og + 1u == (tg + 1u) * nx) xb_add(&bar[XB_TOPGEN], 1u);
            else XB_SPIN(xb_ld(&bar[XB_TOPGEN]) == tg, bar);
            __builtin_amdgcn_fence(__ATOMIC_ACQUIRE, "agent");
            xb_add(&bar[XB_XGEN(b.x)], 1u);
            asm volatile("s_waitcnt vmcnt(0)" ::: "memory");
        } else {
            XB_SPIN(xb_ld(&bar[XB_XGEN(b.x)]) == gen, bar);
            __builtin_amdgcn_fence(__ATOMIC_ACQUIRE, "agent");
            asm volatile("s_waitcnt vmcnt(0)" ::: "memory");
        }
    }
    __syncthreads();
}

struct Frame {
    LAS unsigned char* lds;
    int tid, lane, wave, G, bid;
    float* out; unsigned char* ws;
};
struct Args { const float* in[26]; float* out; unsigned char* ws; int ph_lo, ph_hi; };
enum { I_X = 0, I_C, I_CTX, I_CCTX, I_WMOD, I_BMOD, I_NORMG, I_WI, I_WO, I_WIN, I_WOUT, I_SINK, I_LAMRE, I_LAMIM, I_LOGDT, I_BRE, I_BIM, I_CRE, I_CIM, I_SSMD, I_GLUW, I_GLUB,
       I_CONVW, I_CONVB, I_LNG, I_LNB };

constexpr int TR_STRIDE = 65, TR_WAVE_BYTES = 64 * TR_STRIDE * 4;
#ifndef TR_NT
#define TR_NT 1
#endif
struct TrItem { const float* src; bf16* dst; int ldw, K; };
__device__ __forceinline__ void tr_load(const TrItem& t, f32x4 (&v)[16], int lane) {
    const int rr = lane >> 4, c4 = (lane & 15) * 4;
#pragma unroll
    for (int i = 0; i < 16; ++i) v[i] = TR_NT ? __builtin_nontemporal_load((const f32x4*)(t.src + (size_t)(4 * i + rr) * t.ldw + c4)) : *(const f32x4*)(t.src + (size_t)(4 * i + rr) * t.ldw + c4);
}
__device__ __forceinline__ void tr_store(const TrItem& t, const f32x4 (&v)[16], LAS float* scr, int lane) {
    const int rr = lane >> 4, c4 = (lane & 15) * 4;
#pragma unroll
    for (int i = 0; i < 16; ++i) { LAS float* d = scr + (4 * i + rr) * TR_STRIDE + c4; d[0] = v[i].x; d[1] = v[i].y; d[2] = v[i].z; d[3] = v[i].w; }
    LDS_WAIT(); asm volatile("" ::: "memory");
    const int c = lane & 7;
#pragma unroll
    for (int j = 0; j < 8; ++j) { const int n = (lane >> 3) + 8 * j; const LAS float* s = scr + (8 * c) * TR_STRIDE + n;
        v4u o; o.x = pk2(s[0 * TR_STRIDE], s[1 * TR_STRIDE]); o.y = pk2(s[2 * TR_STRIDE], s[3 * TR_STRIDE]); o.z = pk2(s[4 * TR_STRIDE], s[5 * TR_STRIDE]); o.w = pk2(s[6 * TR_STRIDE], s[7 * TR_STRIDE]);
        if (TR_NT) __builtin_nontemporal_store(o, (v4u*)(t.dst + (size_t)n * t.K + 8 * c)); else *(GAS v4u*)(t.dst + (size_t)n * t.K + 8 * c) = o; }
    LDS_WAIT(); asm volatile("" ::: "memory");
}
__device__ __forceinline__ void transpose_item(const float* W, int ldw, int k0, int n0, bf16* WT, int K, int drow0, LAS float* scr, int lane) {
    TrItem t{W + (size_t)k0 * ldw + n0, WT + (size_t)drow0 * K + k0, ldw, K}; f32x4 v[16]; tr_load(t, v, lane); tr_store(t, v, scr, lane);
}

constexpr int CV_WI = 32 * 176, CV_WO = 88 * 32, CV_WOUT = 32 * 32, CV_WIN = 32 * 36, CV_GLU = 8 * 8, CV_FOLD = 32 * 8;
constexpr int CV_NOFOLD = 2 * CV_WI + 2 * CV_WO + CV_WOUT + CV_WIN + CV_GLU, CV_TILES = CV_NOFOLD + CV_FOLD, CV_ITEMS = CV_TILES / 8;
static_assert(CV_TILES % 8 == 0, "workgroup items of 8 wave tiles");
__device__ __forceinline__ void conv_decode(const Args& AR, unsigned char* ws, int L, int it, TrItem& t) {
    int r = it;
    if (r < 2 * CV_WI) { const int mat = L * 2 + r / CV_WI, q = r % CV_WI, kb = q / 176, nb = q % 176, n0 = nb * 64, half = n0 / DFF, j = n0 % DFF, drow = (j / 128) * 256 + half * 128 + (j % 128);
        t.src = AR.in[I_WI] + (size_t)mat * DM * 2 * DFF + (size_t)(kb * 64) * (2 * DFF) + n0; t.dst = (bf16*)(ws + WS_WI) + (size_t)mat * 2 * DFF * DM + (size_t)drow * DM + kb * 64; t.ldw = 2 * DFF; t.K = DM; return; }
    r -= 2 * CV_WI;
    if (r < 2 * CV_WO) { const int mat = L * 2 + r / CV_WO, q = r % CV_WO, kb = q / 32, nb = q % 32;
        t.src = AR.in[I_WO] + (size_t)mat * DFF * DM + (size_t)(kb * 64) * DM + nb * 64; t.dst = (bf16*)(ws + WS_WO) + (size_t)mat * DM * DFF + (size_t)(nb * 64) * DFF + kb * 64; t.ldw = DM; t.K = DFF; return; }
    r -= 2 * CV_WO;
    if (r < CV_WOUT) { const int kb = r / 32, nb = r % 32;
        t.src = AR.in[I_WOUT] + (size_t)L * DM * DM + (size_t)(kb * 64) * DM + nb * 64; t.dst = (bf16*)(ws + WS_WOUT) + (size_t)L * DM * DM + (size_t)(nb * 64) * DM + kb * 64; t.ldw = DM; t.K = DM; return; }
    r -= CV_WOUT;
    if (r < CV_WIN) { const int kb = r / 36, nb = r % 36;
        t.src = AR.in[I_WIN] + (size_t)L * DM * DIN + (size_t)(kb * 64) * DIN + nb * 64; t.dst = (bf16*)(ws + WS_WIN) + (size_t)L * DIN * DM + (size_t)(nb * 64) * DM + kb * 64; t.ldw = DIN; t.K = DM; return; }
    r -= CV_WIN;
    if (r < CV_GLU) { const int kb = r / 8, nb = r % 8;
        t.src = AR.in[I_GLUW] + (size_t)L * 512 * 512 + (size_t)(kb * 64) * 512 + nb * 64; t.dst = (bf16*)(ws + WS_GLUW) + (size_t)L * 512 * 512 + (size_t)(nb * 64) * 512 + kb * 64; t.ldw = 512; t.K = 512; return; }
    r -= CV_GLU;
    { const int kb = r / 8, nb = r % 8;
        t.src = (const float*)(ws + WS_WFOLD) + (size_t)L * DM * 512 + (size_t)(kb * 64) * 512 + nb * 64; t.dst = (bf16*)(ws + WS_WIN) + (size_t)L * DIN * DM + (size_t)(FFT_OFF + nb * 64) * DM + kb * 64; t.ldw = 512; t.K = DM; }
}
__device__ __forceinline__ void bg_static(Frame& F, const Args& AR, int L, int first, int n, int stride) {
    __syncthreads();
    LAS float* scr = (LAS float*)(F.lds + F.wave * TR_WAVE_BYTES);
    int it = first, left = n;
    if (left <= 0 || it >= CV_ITEMS) return;
    TrItem cur; conv_decode(AR, F.ws, L, it * 8 + F.wave, cur); f32x4 va[16]; tr_load(cur, va, F.lane);
#pragma unroll 1
    for (;;) {
        const int nx = it + stride; const bool more = left > 1 && nx < CV_ITEMS;
        TrItem nxt = cur; f32x4 vb[16];
        if (more) { conv_decode(AR, F.ws, L, nx * 8 + F.wave, nxt); tr_load(nxt, vb, F.lane); }
        tr_store(cur, va, scr, F.lane);
        if (!more) break;
#pragma unroll
        for (int i = 0; i < 16; ++i) va[i] = vb[i];
        cur = nxt; it = nx; --left;
    }
}
constexpr int BG_UP = 8, BG_IN = 7, BG_DN = 1, BG_OUT = 1, BG_CA = 0;
constexpr int BGB_UP1 = 0, BGB_UP2 = BGB_UP1 + 40 * BG_UP, BGB_IN = BGB_UP2 + 40 * BG_UP, BGB_DN1 = BGB_IN + 138 * BG_IN, BGB_DN2 = BGB_DN1 + 80 * BG_DN, BGB_OUT = BGB_DN2 + 80 * BG_DN,
              BGB_CA = BGB_OUT + 192 * BG_OUT, BGB_REST = BGB_CA + 128 * BG_CA;
static_assert(BGB_REST <= CV_ITEMS, "background item map");
__device__ __forceinline__ void bg_site(Frame& F, const Args& AR, int L, int base, int c0, int n) {
    if (F.G == 256 && F.bid >= c0) bg_static(F, AR, L, base + (F.bid - c0) * n, n, 1);
}
__device__ __forceinline__ void bg_drain(Frame& F, const Args& AR, int L) {
    const int base = F.G == 256 ? BGB_REST : 0;
    bg_static(F, AR, L, base + F.bid, (CV_ITEMS - base - F.bid + F.G - 1) / F.G, F.G);
}

__device__ __forceinline__ void p0a(Frame& F, const Args& AR) {
    unsigned char* ws = F.ws;
    const int gw = F.bid * NWAVES + F.wave, NGW = F.G * NWAVES;
    const int gt = F.bid * NTHR + F.tid, NGT = F.G * NTHR;
    {
        float* rope = (float*)(ws + WS_ROPE);
        for (int i = gt; i < 64 * 16; i += NGT) { const int pos = i >> 4, j = i & 15;
            const double inv = exp(-(double)j * (9.210340371976184 / 16.0)); const double t = (double)pos * inv * 0.15915494309189535; const double fr = t - rint(t);
            rope[2 * i] = (float)cospi(2.0 * fr); rope[2 * i + 1] = (float)sinpi(2.0 * fr); }
        float* tw = (float*)(ws + WS_TW);
        for (int i = gt; i < 4096; i += NGT) { const double fr = (double)i / 4096.0; tw[2 * i] = (float)cospi(2.0 * fr); tw[2 * i + 1] = (float)(-sinpi(2.0 * fr)); }
        float* sa = (float*)(ws + WS_SSMA); float* sbb = (float*)(ws + WS_SSMBB);
        for (int i = gt; i < DEPTH * 2 * 32 * 64; i += NGT) {
            const int ldg = i >> 6;
            const double lr = fmin((double)AR.in[I_LAMRE][i], -1e-4), li = (double)AR.in[I_LAMIM][i], dt = exp((double)AR.in[I_LOGDT][ldg]);
            const double mag = exp(lr * dt); const double t = li * dt * 0.15915494309189535; const double fr = t - rint(t);
            const double are = mag * cospi(2.0 * fr), aim = mag * sinpi(2.0 * fr);
            const double den = lr * lr + li * li, nr = are - 1.0;
            const double cre = (nr * lr + aim * li) / den, cim = (aim * lr - nr * li) / den;
            sa[2 * i] = (float)are; sa[2 * i + 1] = (float)aim;
            { const double mag16 = exp(lr * dt * 16.0); const double t16 = li * dt * 16.0 * 0.15915494309189535; const double f16 = t16 - rint(t16);
              const double ar16 = mag16 * cospi(2.0 * f16), ai16 = mag16 * sinpi(2.0 * f16);
              float* a16 = (float*)(ws + WS_A16); a16[2 * i] = (float)ar16; a16[2 * i + 1] = (float)ai16;
              float* pw = (float*)(ws + WS_POW) + ((size_t)ldg * 65 * 64 + (i & 63)) * 2;
              double pr = 1.0, pi = 0.0;
              for (int k = 0; k <= 64; ++k) { pw[(size_t)k * 128] = (float)pr; pw[(size_t)k * 128 + 1] = (float)pi; const double nr = pr * ar16 - pi * ai16, ni = pr * ai16 + pi * ar16; pr = nr; pi = ni; } }
            for (int h = 0; h < 16; ++h) { const double br = (double)AR.in[I_BRE][(size_t)i * 16 + h], bi = (double)AR.in[I_BIM][(size_t)i * 16 + h];
                sbb[((size_t)i * 16 + h) * 2] = (float)(cre * br - cim * bi); sbb[((size_t)i * 16 + h) * 2 + 1] = (float)(cre * bi + cim * br); }
        }
        float* sct = (float*)(ws + WS_SSMCT);
        for (int i = gt; i < DEPTH * 2 * 64 * 512; i += NGT) { const int ch = i & 511, p = (i >> 9) & 63, ld = i >> 15;
            const size_t src = ((size_t)ld * 512 + ch) * 64 + p; sct[2 * (size_t)i] = AR.in[I_CRE][src]; sct[2 * (size_t)i + 1] = AR.in[I_CIM][src]; }
    }
    {
        LAS float* sv = (LAS float*)F.lds;
        for (int i = F.tid; i < 3 * DM; i += NTHR) { const int v = i / DM, d = i % DM; const float c = v < 2 ? AR.in[I_C][v * DM + d] : AR.in[I_CCTX][d]; sv[i] = c * sigmoidf_(c); }
        __syncthreads();
        float* modp = (float*)(ws + WS_MODP);
        constexpr int DCH = DM / MOD_CHUNKS;
        for (int it = F.bid; it < DEPTH * 9 * MOD_CHUNKS; it += F.G) {
            const int ch = it % MOD_CHUNKS, lj = it / MOD_CHUNKS, jg = lj % 9, l = lj / 9;
            const float* wp = AR.in[I_WMOD] + ((size_t)l * DM + (size_t)ch * DCH) * MODW + jg * 2048 + F.tid * 4;
            f32x4 a0 = {0.f, 0.f, 0.f, 0.f}, a1 = a0, a2 = a0;
#pragma unroll 8
            for (int d = 0; d < DCH; ++d) { const f32x4 w = __builtin_nontemporal_load((const f32x4*)(wp + (size_t)d * MODW)); const int dd = ch * DCH + d;
                a0 += w * sv[dd]; a1 += w * sv[DM + dd]; a2 += w * sv[2 * DM + dd]; }
            float* o = modp + ((size_t)(ch * DEPTH + l) * 3) * MODW + jg * 2048 + F.tid * 4;
            *(f32x4*)(o) = a0; *(f32x4*)(o + MODW) = a1; *(f32x4*)(o + 2 * MODW) = a2;
        }
        __syncthreads();
    }
    {
        LAS float* scr = (LAS float*)(F.lds + F.wave * 16384);
        scr[F.lane] = cospif((float)F.lane * (1.0f / 64.0f)); scr[F.lane + 64] = cospif((float)(F.lane + 64) * (1.0f / 64.0f));
        float* wf = (float*)(ws + WS_WFOLD);
        for (int it = gw; it < DEPTH * DM * 4; it += NGW) {
            const int h = it & 3, ld = it >> 2;
            const float* src = AR.in[I_WIN] + (size_t)ld * DIN + FFT_OFF + 128 * h;
            LDS_WAIT(); asm volatile("" ::: "memory");
            scr[128 + F.lane] = src[F.lane]; scr[192 + F.lane] = src[F.lane + 64];
            LDS_WAIT(); asm volatile("" ::: "memory");
#pragma unroll
            for (int q = 0; q < 2; ++q) { const int jj = F.lane + 64 * q, mp = jj >> 1, odd = jj & 1;
                const int mult = mp == 0 ? (odd ? 64 : 0) : mp, shift = (mp != 0 && odd) ? 96 : 0; const float sgn = (mp != 0 && odd) ? -1.f : 1.f;
                float s = 0.f;
                for (int c = 0; c < 128; ++c) s += scr[128 + c] * scr[(mult * c + shift) & 127];
                wf[(size_t)ld * 512 + 128 * h + jj] = s * sgn; }
        }
        LDS_WAIT(); asm volatile("" ::: "memory");
    }
    {
        __syncthreads();
        LAS float* scr = (LAS float*)(F.lds + F.wave * TR_WAVE_BYTES);
        constexpr int NIT = CV_NOFOLD;
        auto decode = [&](int it, TrItem& t) { conv_decode(AR, ws, 0, it, t); };
        int it = gw;
        if (it < NIT) {
            TrItem cur; decode(it, cur); f32x4 va[16]; tr_load(cur, va, F.lane);
#pragma unroll 1
            for (;;) {
                const int nx = it + NGW; const bool more = nx < NIT;
                TrItem nxt = cur; f32x4 vb[16];
                if (more) { decode(nx, nxt); tr_load(nxt, vb, F.lane); }
                tr_store(cur, va, scr, F.lane);
                if (!more) break;
#pragma unroll
                for (int i = 0; i < 16; ++i) va[i] = vb[i];
                cur = nxt; it = nx;
            }
        }
    }
}
__device__ __forceinline__ void ssm_build_mats(Frame& F, const Args& AR, int item2) {
    const int item = item2 >> 1, half = item2 & 1;
    const int l = item >> 5, g = item & 31;
    LAS float* apow = (LAS float*)F.lds;
    LAS float* cc = apow + 2 * 17 * 64 * 2;
    LAS float* bb = cc + 4096;
    LAS float* kt = bb + 4096;
    const float* ssmbb = (const float*)(F.ws + WS_SSMBB);
    __syncthreads();
    for (int i = F.tid; i < 2 * 17 * 64; i += NTHR) { const int p = i & 63, j = (i >> 6) % 17, dir = i / (17 * 64);
        const int idx = ((l * 2 + dir) * 32 + g) * 64 + p;
        const double lr = fmin((double)AR.in[I_LAMRE][idx], -1e-4), li = (double)AR.in[I_LAMIM][idx], dt = exp((double)AR.in[I_LOGDT][(l * 2 + dir) * 32 + g]);
        const double mag = exp(lr * dt * (double)j); const double t = li * dt * (double)j * 0.15915494309189535; const double fr = t - rint(t);
        apow[2 * i] = (float)(mag * cospi(2.0 * fr)); apow[2 * i + 1] = (float)(mag * sinpi(2.0 * fr)); }
    for (int i = F.tid; i < 2 * 16 * 64; i += NTHR) { const int p = i & 63, h = (i >> 6) & 15, dir = i >> 10;
        const size_t src = ((size_t)((l * 2 + dir) * 32 + g) * 16 + h) * 64 + p;
        cc[2 * i] = AR.in[I_CRE][src]; cc[2 * i + 1] = AR.in[I_CIM][src]; }
    for (int i = F.tid; i < 2 * 64 * 16; i += NTHR) { const int h = i & 15, p = (i >> 4) & 63, dir = i >> 10;
        const size_t src = ((size_t)((l * 2 + dir) * 32 + g) * 64 + p) * 16 + h;
        bb[2 * i] = ssmbb[2 * src]; bb[2 * i + 1] = ssmbb[2 * src + 1]; }
    __syncthreads();
    for (int i = F.tid; i < 8192; i += NTHR) { const int h = i & 15, hp = (i >> 4) & 15, j = (i >> 8) & 15, dir = i >> 12;
        float s = 0.f;
        for (int p = 0; p < 64; ++p) { const LAS float* c = cc + ((dir * 16 + hp) * 64 + p) * 2; const LAS float* a = apow + ((dir * 17 + j) * 64 + p) * 2; const LAS float* b = bb + ((dir * 64 + p) * 16 + h) * 2;
            const float car = c[0] * a[0] - c[1] * a[1], cai = c[0] * a[1] + c[1] * a[0]; s += car * b[0] - cai * b[1]; }
        kt[i] = s; }
    __syncthreads();
    bf16* wy = (bf16*)(F.ws + WS_SSMWY) + (size_t)item * 256 * 512;
    for (int e = half * 128 * 64 + F.tid; e < (half + 1) * 128 * 64; e += NTHR) { const int n = e >> 6, k0 = (e & 63) * 8, i = n >> 4, hp = n & 15;
        float v[8];
#pragma unroll
        for (int t = 0; t < 8; ++t) { const int k = k0 + t; float val;
            if (k < 256) { const int ip = k >> 4, h = k & 15; val = 0.f;
                if (ip <= i) val += kt[((0 * 16 + (i - ip)) * 16 + hp) * 16 + h];
                if (ip >= i) val += kt[((1 * 16 + (ip - i)) * 16 + hp) * 16 + h];
                if (ip == i && h == hp) val += AR.in[I_SSMD][l * 512 + g * 16 + h]; }
            else { const int kk = k - 256, dir = kk >> 7, part = (kk >> 6) & 1, p = kk & 63, ee = dir == 0 ? i + 1 : 16 - i;
                const LAS float* c = cc + ((dir * 16 + hp) * 64 + p) * 2; const LAS float* a = apow + ((dir * 17 + ee) * 64 + p) * 2;
                val = part == 0 ? c[0] * a[0] - c[1] * a[1] : -(c[0] * a[1] + c[1] * a[0]); }
            v[t] = val; }
        v4u o; o.x = pk2(v[0], v[1]); o.y = pk2(v[2], v[3]); o.z = pk2(v[4], v[5]); o.w = pk2(v[6], v[7]);
        *(v4u*)(wy + (size_t)n * 512 + k0) = o; }
    bf16* wsm = (bf16*)(F.ws + WS_SSMWS) + (size_t)item * 256 * 256;
    for (int e = half * 128 * 32 + F.tid; e < (half + 1) * 128 * 32; e += NTHR) { const int n = e >> 5, k0 = (e & 31) * 8, dir = n >> 7, part = (n >> 6) & 1, p = n & 63;
        float v[8];
#pragma unroll
        for (int t = 0; t < 8; ++t) { const int k = k0 + t, ip = k >> 4, h = k & 15, ee = dir == 0 ? 15 - ip : ip;
            const LAS float* a = apow + ((dir * 17 + ee) * 64 + p) * 2; const LAS float* b = bb + ((dir * 64 + p) * 16 + h) * 2;
            v[t] = part == 0 ? a[0] * b[0] - a[1] * b[1] : a[0] * b[1] + a[1] * b[0]; }
        v4u o; o.x = pk2(v[0], v[1]); o.y = pk2(v[2], v[3]); o.z = pk2(v[4], v[5]); o.w = pk2(v[6], v[7]);
        *(v4u*)(wsm + (size_t)n * 256 + k0) = o; }
}
__device__ __forceinline__ void p0b(Frame& F, const Args& AR) {
    unsigned char* ws = F.ws;
    const int gw = F.bid * NWAVES + F.wave, NGW = F.G * NWAVES;
    const int gt = F.bid * NTHR + F.tid, NGT = F.G * NTHR;
    {
        const float* modp = (const float*)(ws + WS_MODP); float* comb = (float*)(ws + WS_COMB); const float* ng = AR.in[I_NORMG];
        auto modval = [&](int l, int v, int j) { float s = AR.in[I_BMOD][l * MODW + j]; const float* q = modp + (size_t)(l * 3 + v) * MODW + j;
            for (int ch = 0; ch < MOD_CHUNKS; ++ch) s += q[(size_t)ch * DEPTH * 3 * MODW]; return s; };
        for (int e = gt; e < 13 * 3 * DM; e += NGT) { const int c = e % DM, v = (e / DM) % 3, idx = e / (3 * DM);
            float vg = 0.f, vs = 0.f, vh = 0.f;
            if (idx == 12) { vs = ng[c] * (1.0f + modval(0, v, 1 * DM + c)); vh = modval(0, v, c); }
            else { const int l = idx / 3, k = idx % 3;
                vg = (k == 1 ? 1.0f : 0.5f) * modval(l, v, (2 + 3 * k) * DM + c) * ng[(l * 6 + 1 + 2 * k) * DM + c];
                if (k < 2) { vs = ng[(l * 6 + 2 + 2 * k) * DM + c] * (1.0f + modval(l, v, (4 + 3 * k) * DM + c)); vh = modval(l, v, (3 + 3 * k) * DM + c); }
                else if (l < DEPTH - 1) { vs = ng[((l + 1) * 6) * DM + c] * (1.0f + modval(l + 1, v, 1 * DM + c)); vh = modval(l + 1, v, c); } }
            float* o = comb + ((size_t)(idx * 3 + v) * 3) * DM + c; o[0] = vg; o[DM] = vs; o[2 * DM] = vh; }
    }
    for (int it = F.bid; it < DEPTH * 32 * 2; it += F.G) ssm_build_mats(F, AR, it);
    __syncthreads();
    {
        LAS float* scr = (LAS float*)(F.lds + F.wave * TR_WAVE_BYTES);
        bf16* win_t = (bf16*)(ws + WS_WIN); const float* wf = (const float*)(ws + WS_WFOLD);
        for (int it = gw; it < CV_FOLD; it += NGW) { TrItem t; conv_decode(AR, ws, 0, CV_NOFOLD + it, t); f32x4 v[16]; tr_load(t, v, F.lane); tr_store(t, v, scr, F.lane); }
        (void)win_t; (void)wf;
    }
}
#ifndef NT_H
#define NT_H 1
#endif
#ifndef NT_X
#define NT_X 1
#endif
#ifndef NORM_CUS
#define NORM_CUS 0
#endif
__device__ __forceinline__ void norm_phase(Frame& F, const Args& AR, bool first, bool has_y, int nsplit, const float* comb, float res_mul, bool write_h, bool write_out, int nrows = R) {
    if (NORM_CUS && F.bid >= NORM_CUS) return;
    const int gw = F.bid * NWAVES + F.wave, NGW = (NORM_CUS ? NORM_CUS : F.G) * NWAVES;
    float* X = (float*)(F.ws + WS_X); const bf16* Y = (const bf16*)(F.ws + WS_Y); bf16* H = (bf16*)(F.ws + WS_H);
#pragma unroll 1
    for (int r = gw; r < nrows; r += NGW) {
        const int v = r < SEQ ? 0 : (r < R_LAT ? 1 : 2);
        const float* cb = comb + (size_t)v * 3 * DM + 4 * F.lane;
        const float* xr = (first ? (r < R_LAT ? AR.in[I_X] + (size_t)r * DM : AR.in[I_CTX] + (size_t)(r - R_LAT) * DM) : X + (size_t)r * DM) + 4 * F.lane;
        f32x4 x[8], y[8], vg[8], vs[8], vh[8];
#pragma unroll
        for (int j = 0; j < 8; ++j) x[j] = NT_X ? __builtin_nontemporal_load((const f32x4*)(xr + 256 * j)) : *(const f32x4*)(xr + 256 * j);
        if (has_y) {
            if (r < R_LAT) {
#pragma unroll
                for (int j = 0; j < 8; ++j) { const v2u w = __builtin_nontemporal_load((const v2u*)(Y + (size_t)r * DM + 4 * F.lane + 256 * j)); y[j] = (f32x4){bflo(w.x), bfhi(w.x), bflo(w.y), bfhi(w.y)}; }
            } else {
                const float* yp = (const float*)(F.ws + WS_YP) + (size_t)(r - R_LAT) * DM + 4 * F.lane;
#pragma unroll
                for (int j = 0; j < 8; ++j) y[j] = __builtin_nontemporal_load((const f32x4*)(yp + 256 * j));
#pragma unroll 1
                for (int s = 1; s < nsplit; ++s) {
#pragma unroll
                    for (int j = 0; j < 8; ++j) y[j] += __builtin_nontemporal_load((const f32x4*)(yp + (size_t)s * R_CTX * DM + 256 * j)); }
            }
#pragma unroll
            for (int j = 0; j < 8; ++j) vg[j] = *(const f32x4*)(cb + 256 * j);
        }
        if (write_h) {
#pragma unroll
            for (int j = 0; j < 8; ++j) { vs[j] = *(const f32x4*)(cb + DM + 256 * j); vh[j] = *(const f32x4*)(cb + 2 * DM + 256 * j); }
        }
        if (has_y) {
            float ss = 0.f;
#pragma unroll
            for (int j = 0; j < 8; ++j) ss += (y[j].x * y[j].x + y[j].y * y[j].y) + (y[j].z * y[j].z + y[j].w * y[j].w);
            const float rs = rsqrtf(wave_sum(ss) * (1.0f / DM) + 1e-6f) * res_mul;
#pragma unroll
            for (int j = 0; j < 8; ++j) x[j] += vg[j] * (y[j] * rs);
        }
        if (has_y && !write_out) {
#pragma unroll
            for (int j = 0; j < 8; ++j) { if (NT_X) __builtin_nontemporal_store(x[j], (f32x4*)(X + (size_t)r * DM + 4 * F.lane + 256 * j)); else *(f32x4*)(X + (size_t)r * DM + 4 * F.lane + 256 * j) = x[j]; }
        }
        if (write_out && r < R_LAT) {
#pragma unroll
            for (int j = 0; j < 8; ++j) *(f32x4*)(F.out + (size_t)r * DM + 4 * F.lane + 256 * j) = x[j];
        }
        if (write_h) {
            float ss = 0.f;
#pragma unroll
            for (int j = 0; j < 8; ++j) ss += (x[j].x * x[j].x + x[j].y * x[j].y) + (x[j].z * x[j].z + x[j].w * x[j].w);
            const float rs = rsqrtf(wave_sum(ss) * (1.0f / DM) + 1e-6f);
#pragma unroll
            for (int j = 0; j < 8; ++j) { const f32x4 hv = x[j] * rs * vs[j] + vh[j];
                v2u o; o.x = pk2(hv.x, hv.y); o.y = pk2(hv.z, hv.w); if (NT_H) __builtin_nontemporal_store(o, (v2u*)(H + (size_t)r * DM + 4 * F.lane + 256 * j)); else *(v2u*)(H + (size_t)r * DM + 4 * F.lane + 256 * j) = o; }
        }
    }
}

typedef short bf16x8v __attribute__((ext_vector_type(8)));
template <int K> __device__ __forceinline__ void wave_bfrags(const bf16* Bt, int kb, bf16x8v (&bfr)[8][2], int lane) {
    const int fr = lane & 15, fq = lane >> 4;
#pragma unroll
    for (int ks = 0; ks < 8; ++ks)
#pragma unroll
        for (int n = 0; n < 2; ++n) bfr[ks][n] = *(const bf16x8v*)(Bt + (size_t)(n * 16 + fr) * K + kb * 256 + ks * 32 + 8 * fq);
}
template <int K, int MT> __device__ __forceinline__ void wave_mma_batch(const LAS unsigned char* a_lds, int lda, int kb, const bf16x8v (&bfr)[8][2], f32x4 (&acc)[MT][2], int lane) {
    const int fr = lane & 15, fq = lane >> 4;
#pragma unroll
    for (int ks = 0; ks < 8; ++ks)
#pragma unroll
        for (int m = 0; m < MT; ++m) { const bf16x8v af = *(const LAS bf16x8v*)(a_lds + (m * 16 + fr) * lda + (kb * 256 + ks * 32 + 8 * fq) * 2);
#pragma unroll
            for (int n = 0; n < 2; ++n) acc[m][n] = __builtin_amdgcn_mfma_f32_16x16x32_bf16(bfr[ks][n], af, acc[m][n], 0, 0, 0); }
}
__device__ __forceinline__ void ssm_sgemm_item(Frame& F, const Args& AR, int l, int item) {
    constexpr int K = 256, LDA = K * 2 + 16, MT = 4, NROW = 64, SL_OFF = 36864, SLD = 260, EX_OFF = 104448;
    const int g = item & 31, rt = item >> 5, row0 = rt * 64;
    const bf16* P = (const bf16*)(F.ws + WS_P);
    LAS unsigned char* at = F.lds;
    LAS float* sl = (LAS float*)(F.lds + SL_OFF); LAS float* ex = (LAS float*)(F.lds + EX_OFF);
    const bf16* Bt = (const bf16*)(F.ws + WS_SSMWS) + (size_t)(l * 32 + g) * 256 * 256 + (size_t)(F.wave * 32) * K;
    bf16x8v b0[8][2];
    wave_bfrags<K>(Bt, 0, b0, F.lane);
    __syncthreads();
    for (int idx = F.tid; idx < NROW * 32; idx += NTHR) { const int piece = idx & 1, tok = (idx >> 1) & 15, row = idx >> 5, cr = row0 + row;
        v4u v = {0u, 0u, 0u, 0u}; if (cr < NCR) v = *(const v4u*)(P + (size_t)(cr * 16 + tok) * DIN + SSM_OFF + g * 16 + piece * 8);
        *(LAS v4u*)(at + row * LDA + (tok * 16 + piece * 8) * 2) = v; }
    __syncthreads();
    f32x4 acc[MT][2];
#pragma unroll
    for (int m = 0; m < MT; ++m)
#pragma unroll
        for (int n = 0; n < 2; ++n) acc[m][n] = (f32x4){0.f, 0.f, 0.f, 0.f};
    wave_mma_batch<K, MT>(at, LDA, 0, b0, acc, F.lane);
    { const int fr = F.lane & 15, fq = F.lane >> 4;
#pragma unroll
      for (int m = 0; m < MT; ++m)
#pragma unroll
        for (int n = 0; n < 2; ++n) *(LAS f32x4*)(sl + (m * 16 + fr) * SLD + F.wave * 32 + n * 16 + 4 * fq) = acc[m][n]; }
    __syncthreads();
    const int dir = F.wave & 1, cpos = F.wave >> 1, sub = dir ? 3 - cpos : cpos, p = F.lane;
    const f32x2 a = *(const f32x2*)((const float*)(F.ws + WS_A16) + ((size_t)((l * 2 + dir) * 32 + g) * 64 + p) * 2);
    float sr[16], si[16];
#pragma unroll
    for (int i = 0; i < 16; ++i) { const int row = sub * 16 + (dir ? 15 - i : i); sr[i] = sl[row * SLD + dir * 128 + p]; si[i] = sl[row * SLD + dir * 128 + 64 + p]; }
    float hr = 0.f, hi = 0.f;
#pragma unroll
    for (int i = 0; i < 16; ++i) { const float nr = a.x * hr - a.y * hi + sr[i], ni = a.x * hi + a.y * hr + si[i]; hr = nr; hi = ni; }
    ex[(F.wave * 64 + p) * 2] = hr; ex[(F.wave * 64 + p) * 2 + 1] = hi;
    float pr = a.x, pi = a.y;
#pragma unroll
    for (int i = 0; i < 4; ++i) { const float nr = pr * pr - pi * pi, ni = 2.0f * pr * pi; pr = nr; pi = ni; }
    __syncthreads();
    hr = 0.f; hi = 0.f;
    if (rt < 8) for (int c = 0; c < cpos; ++c) { const int ww = (c << 1) | dir; const float er = ex[(ww * 64 + p) * 2], ei = ex[(ww * 64 + p) * 2 + 1];
        const float nr = pr * hr - pi * hi + er, ni = pr * hi + pi * hr + ei; hr = nr; hi = ni; }
    const bool valid = rt < 8 || sub < 2;
    float* HL = (float*)(F.ws + WS_SSMS) + (size_t)g * 256 + dir * 128 + p;
#pragma unroll
    for (int i = 0; i < 16; ++i) { const int cr = row0 + sub * 16 + (dir ? 15 - i : i);
        if (valid) { HL[(size_t)cr * 8192] = hr; HL[(size_t)cr * 8192 + 64] = hi; }
        const float nr = a.x * hr - a.y * hi + sr[i], ni = a.x * hi + a.y * hr + si[i]; hr = nr; hi = ni; }
    float* ET = (float*)(F.ws + WS_ET) + (size_t)g * 256 + dir * 128 + p;
    if (rt < 8) { if (cpos == 3) { ET[(size_t)rt * 8192] = hr; ET[(size_t)rt * 8192 + 64] = hi; } }
    else if (sub < 2) { ET[(size_t)(8 + sub) * 8192] = hr; ET[(size_t)(8 + sub) * 8192 + 64] = hi; }
}
template <int PH, int MT> __device__ __forceinline__ void ssm_gemm_rows(Frame& F, const Args& AR, int l, int g, int row0) {
    static_assert(PH == 1, "Y phase only");
    constexpr int K = 512, LDA = K * 2 + 16, NROW = 16 * MT, HS_OFF = 100352;
    const bf16* P = (const bf16*)(F.ws + WS_P);
    LAS unsigned char* at = F.lds; LAS float* hs = (LAS float*)(F.lds + HS_OFF);
    const bf16* Bt = (const bf16*)(F.ws + WS_SSMWY) + (size_t)(l * 32 + g) * 256 * 512 + (size_t)(F.wave * 32) * K;
    const float* POW = (const float*)(F.ws + WS_POW);
    bf16x8v b0[8][2];
    wave_bfrags<K>(Bt, 0, b0, F.lane);
    __syncthreads();
    if (F.tid < 128) { const int dir = F.tid >> 6, p = F.tid & 63, t = row0 >> 6, b = t >> 2, i = t & 3;
        const float* ET = (const float*)(F.ws + WS_ET) + (size_t)g * 256 + dir * 128 + p;
        const f32x2 a64 = *(const f32x2*)(POW + ((((size_t)(l * 2 + dir) * 32 + g) * 65 + 64) * 64 + p) * 2);
        float hr = ET[(size_t)(8 + b) * 8192], hi = ET[(size_t)(8 + b) * 8192 + 64];
        if (dir == 0) { for (int j = 0; j < i; ++j) { const float er = ET[(size_t)(4 * b + j) * 8192], ei = ET[(size_t)(4 * b + j) * 8192 + 64];
                const float nr = a64.x * hr - a64.y * hi + er, ni = a64.x * hi + a64.y * hr + ei; hr = nr; hi = ni; } }
        else { for (int j = 3; j > i; --j) { const float er = ET[(size_t)(4 * b + j) * 8192], ei = ET[(size_t)(4 * b + j) * 8192 + 64];
                const float nr = a64.x * hr - a64.y * hi + er, ni = a64.x * hi + a64.y * hr + ei; hr = nr; hi = ni; } }
        hs[F.tid * 2] = hr; hs[F.tid * 2 + 1] = hi; }
    for (int idx = F.tid; idx < NROW * 32; idx += NTHR) { const int piece = idx & 1, tok = (idx >> 1) & 15, row = idx >> 5, cr = row0 + row;
        v4u v = {0u, 0u, 0u, 0u}; if (cr < NCR) v = *(const v4u*)(P + (size_t)(cr * 16 + tok) * DIN + SSM_OFF + g * 16 + piece * 8);
        *(LAS v4u*)(at + row * LDA + (tok * 16 + piece * 8) * 2) = v; }
    __syncthreads();
    { const float* HL = (const float*)(F.ws + WS_SSMS);
        for (int idx = F.tid; idx < NROW * 16; idx += NTHR) { const int oct = idx & 7, dir = (idx >> 3) & 1, row = idx >> 4, cr = row0 + row;
            const float* hl = HL + ((size_t)cr * 32 + g) * 256 + dir * 128 + oct * 8;
            f32x4 r0 = *(const f32x4*)hl, r1 = *(const f32x4*)(hl + 4), i0 = *(const f32x4*)(hl + 64), i1 = *(const f32x4*)(hl + 68);
            if (row < 64) { const int e = dir ? 63 - row : row;
                const float* pw = POW + ((((size_t)(l * 2 + dir) * 32 + g) * 65 + e) * 64 + oct * 8) * 2;
                const f32x4 w0 = *(const f32x4*)pw, w1 = *(const f32x4*)(pw + 4), w2 = *(const f32x4*)(pw + 8), w3 = *(const f32x4*)(pw + 12);
                const LAS float* hp = hs + (dir * 64 + oct * 8) * 2;
                const f32x4 h0 = *(const LAS f32x4*)hp, h1 = *(const LAS f32x4*)(hp + 4), h2 = *(const LAS f32x4*)(hp + 8), h3 = *(const LAS f32x4*)(hp + 12);
                r0.x += w0.x * h0.x - w0.y * h0.y; i0.x += w0.x * h0.y + w0.y * h0.x;  r0.y += w0.z * h0.z - w0.w * h0.w; i0.y += w0.z * h0.w + w0.w * h0.z;
                r0.z += w1.x * h1.x - w1.y * h1.y; i0.z += w1.x * h1.y + w1.y * h1.x;  r0.w += w1.z * h1.z - w1.w * h1.w; i0.w += w1.z * h1.w + w1.w * h1.z;
                r1.x += w2.x * h2.x - w2.y * h2.y; i1.x += w2.x * h2.y + w2.y * h2.x;  r1.y += w2.z * h2.z - w2.w * h2.w; i1.y += w2.z * h2.w + w2.w * h2.z;
                r1.z += w3.x * h3.x - w3.y * h3.y; i1.z += w3.x * h3.y + w3.y * h3.x;  r1.w += w3.z * h3.z - w3.w * h3.w; i1.w += w3.z * h3.w + w3.w * h3.z; }
            v4u vr, vi; vr.x = pk2(r0.x, r0.y); vr.y = pk2(r0.z, r0.w); vr.z = pk2(r1.x, r1.y); vr.w = pk2(r1.z, r1.w);
            vi.x = pk2(i0.x, i0.y); vi.y = pk2(i0.z, i0.w); vi.z = pk2(i1.x, i1.y); vi.w = pk2(i1.z, i1.w);
            *(LAS v4u*)(at + row * LDA + 512 + (dir * 128 + oct * 8) * 2) = vr; *(LAS v4u*)(at + row * LDA + 512 + (dir * 128 + 64 + oct * 8) * 2) = vi; } }
    __syncthreads();
    f32x4 acc[MT][2];
#pragma unroll
    for (int m = 0; m < MT; ++m)
#pragma unroll
        for (int n = 0; n < 2; ++n) acc[m][n] = (f32x4){0.f, 0.f, 0.f, 0.f};
    { bf16x8v b1[8][2]; wave_bfrags<K>(Bt, 1, b1, F.lane); wave_mma_batch<K, MT>(at, LDA, 0, b0, acc, F.lane); wave_mma_batch<K, MT>(at, LDA, 1, b1, acc, F.lane); }
    const int fr = F.lane & 15, fq = F.lane >> 4;
#pragma unroll
    for (int m = 0; m < MT; ++m) { const int cr = row0 + m * 16 + fr;
        if (cr < NCR) {
#pragma unroll
            for (int n = 0; n < 2; ++n) { const int col = F.wave * 32 + n * 16 + 4 * fq;
                const int i = col >> 4, hp = col & 15; float yv[4];
#pragma unroll
                for (int j = 0; j < 4; ++j) { const float y = acc[m][n][j]; const float z = 0.7978845608028654f * (y + 0.044715f * y * y * y);
                    const float th = 1.0f - 2.0f * __builtin_amdgcn_rcpf(1.0f + __expf(2.0f * z)); yv[j] = 0.5f * y * (1.0f + th); }
                v2u o; o.x = pk2(yv[0], yv[1]); o.y = pk2(yv[2], yv[3]);
                *(v2u*)((bf16*)(F.ws + WS_YG) + (size_t)(cr * 16 + i) * 512 + g * 16 + hp) = o; } } }
}
__device__ __forceinline__ void glu_item(Frame& F, const Args& AR, int l, int item) {
    constexpr int K = 512, LDA = K * 2 + 16, NROW = 68, MT = 5;
    const int half = item & 1, row0 = (item >> 1) * NROW;
    const bf16* YG = (const bf16*)(F.ws + WS_YG); bf16* CAT = (bf16*)(F.ws + WS_CAT);
    LAS unsigned char* at = F.lds;
    const int colw = half * 256 + F.wave * 32;
    const bf16* Bt = (const bf16*)(F.ws + WS_GLUW) + (size_t)l * 512 * 512 + (size_t)colw * K;
    bf16x8v b0[8][2];
    wave_bfrags<K>(Bt, 0, b0, F.lane);
    __syncthreads();
    for (int idx = F.tid; idx < 80 * 64; idx += NTHR) { const int pc = idx & 63, row = idx >> 6;
        v4u v = {0u, 0u, 0u, 0u}; if (row < NROW) v = *(const v4u*)(YG + (size_t)(row0 + row) * 512 + pc * 8);
        *(LAS v4u*)(at + row * LDA + pc * 16) = v; }
    __syncthreads();
    f32x4 acc[MT][2];
#pragma unroll
    for (int m = 0; m < MT; ++m)
#pragma unroll
        for (int n = 0; n < 2; ++n) acc[m][n] = (f32x4){0.f, 0.f, 0.f, 0.f};
    { bf16x8v b1[8][2]; wave_bfrags<K>(Bt, 1, b1, F.lane); wave_mma_batch<K, MT>(at, LDA, 0, b0, acc, F.lane); wave_mma_batch<K, MT>(at, LDA, 1, b1, acc, F.lane); }
    const int fr = F.lane & 15, fq = F.lane >> 4;
#pragma unroll
    for (int n = 0; n < 2; ++n) { const int col = colw + n * 16 + 4 * fq; const f32x4 bias = *(const f32x4*)(AR.in[I_GLUB] + l * 512 + col);
#pragma unroll
        for (int m = 0; m < MT; ++m) { const int row = m * 16 + fr;
            if (row < NROW) { const v2u yw = *(const LAS v2u*)(at + row * LDA + col * 2); const f32x4 z = acc[m][n] + bias;
                const float o0 = bflo(yw.x) * sigmoidf_(z.x), o1 = bfhi(yw.x) * sigmoidf_(z.y), o2 = bflo(yw.y) * sigmoidf_(z.z), o3 = bfhi(yw.y) * sigmoidf_(z.w);
                v2u o; o.x = pk2(o0, o1); o.y = pk2(o2, o3); *(v2u*)(CAT + (size_t)(row0 + row) * DM + 512 + col) = o; } } }
}
typedef float f32x16 __attribute__((ext_vector_type(16)));
constexpr int AT_ROW = 144, AT_KB = 64 * AT_ROW, AT_BUF = 2 * AT_KB;
__device__ __forceinline__ int crow16(int r, int hi) { return (r & 3) + 8 * (r >> 2) + 4 * hi; }
__device__ __forceinline__ void unpack8(const v4u w, float (&x)[8]) { x[0] = bflo(w.x); x[1] = bfhi(w.x); x[2] = bflo(w.y); x[3] = bfhi(w.y); x[4] = bflo(w.z); x[5] = bfhi(w.z); x[6] = bflo(w.w); x[7] = bfhi(w.w); }
__device__ __forceinline__ void attn_item_mfma(Frame& F, const Args& AR, int l, int item) {
    const bf16* P = (const bf16*)(F.ws + WS_P); bf16* CAT = (bf16*)(F.ws + WS_CAT); const float* rope = (const float*)(F.ws + WS_ROPE);
    const bool latent = item < 256;
    int b, kv, n, hq;
    if (latent) { hq = item & 1; n = (item >> 1) & 31; kv = (item >> 6) & 1; b = item >> 7; } else { const int c = item - 256; hq = c & 1; n = (c >> 1) & 1; kv = (c >> 2) & 1; b = c >> 3; }
    const int g = F.wave >> 1, wq = F.wave & 1, h = kv * 4 + g, r32 = F.lane & 31, hi = F.lane >> 5;
    constexpr float C2 = 0.125f * 1.4426950408889634f;
    const int qq = 32 * wq + r32;
    const int qpos = n * 128 + 64 * hq + qq;
    const int qrow = latent ? b * SEQ + qpos : R_LAT + b * CTXL + qpos;
    bf16x8v qf[4];
    {
        const bf16* qp = P + (size_t)qrow * DIN + Q_OFF + h * 64 + 8 * hi;
        float x[4][8];
#pragma unroll
        for (int ks = 0; ks < 4; ++ks) unpack8(*(const v4u*)(qp + 16 * ks), x[ks]);
        if (latent) {
#pragma unroll
            for (int part = 0; part < 2; ++part) { const int pos = part ? (qpos & 63) : (qpos >> 6);
#pragma unroll
                for (int t = 0; t < 8; ++t) { const f32x2 cs = *(const f32x2*)(rope + (pos * 16 + 8 * hi + t) * 2);
                    const float x1 = x[2 * part][t], x2 = x[2 * part + 1][t]; x[2 * part][t] = x1 * cs.x - x2 * cs.y; x[2 * part + 1][t] = x2 * cs.x + x1 * cs.y; } }
        }
#pragma unroll
        for (int ks = 0; ks < 4; ++ks) { v4u w; w.x = pk2(x[ks][0] * C2, x[ks][1] * C2); w.y = pk2(x[ks][2] * C2, x[ks][3] * C2); w.z = pk2(x[ks][4] * C2, x[ks][5] * C2); w.w = pk2(x[ks][6] * C2, x[ks][7] * C2);
            qf[ks] = __builtin_bit_cast(bf16x8v, w); }
    }
    float mrun = AR.in[I_SINK][l * 8 + h] * 1.4426950408889634f, lsum = hi == 0 ? 1.0f : 0.0f;
    f32x16 o[2];
#pragma unroll
    for (int db = 0; db < 2; ++db)
#pragma unroll
        for (int r = 0; r < 16; ++r) o[db][r] = 0.f;
    int tlo = hq, thi = hq + 4;
    if (latent) { if (n == 0 && tlo < 2) tlo = 2; if (n == 31 && thi > 3) thi = 3; } else { tlo = 0; thi = -1; }
    const int nloc = thi - tlo + 1, ntile = nloc + 4;
    const int sj = F.tid >> 3, sd0 = (F.tid & 7) * 8;
    v4u kw, kp, vw;
    { const bool lc = 0 < nloc; const int kp0 = lc ? 128 * (n - 1) + 64 * tlo : 0; const int krow = lc ? b * SEQ + kp0 + sj : R_LAT + b * CTXL + kp0 + sj;
      const bf16* kp_ = P + (size_t)krow * DIN + K_OFF + kv * 64; kw = *(const v4u*)(kp_ + sd0); kp = *(const v4u*)(kp_ + (sd0 ^ 16)); vw = *(const v4u*)(P + (size_t)krow * DIN + V_OFF + kv * 64 + sd0); }
    __syncthreads();
#pragma unroll 1
    for (int s = 0; s < ntile; ++s) {
        const bool local = s < nloc; const int kpos0 = local ? 128 * (n - 1) + 64 * (tlo + s) : 64 * (s - nloc);
        LAS unsigned char* kb_ = F.lds + (s & 1) * AT_BUF; LAS unsigned char* vb_ = kb_ + AT_KB;
        {
            float kk[8], kq[8], vv[8]; unpack8(kw, kk); unpack8(kp, kq); unpack8(vw, vv);
            if (local) { const int kpos = kpos0 + sj, part = sd0 >> 5, e0 = sd0 & 31; const bool firsth = e0 < 16; const int pp = part ? (kpos & 63) : (kpos >> 6);
#pragma unroll
                for (int t = 0; t < 8; ++t) { const f32x2 cs = *(const f32x2*)(rope + (pp * 16 + (e0 & 15) + t) * 2); kk[t] = firsth ? kk[t] * cs.x - kq[t] * cs.y : kk[t] * cs.x + kq[t] * cs.y; } }
            v4u w; w.x = pk2(kk[0], kk[1]); w.y = pk2(kk[2], kk[3]); w.z = pk2(kk[4], kk[5]); w.w = pk2(kk[6], kk[7]);
            *(LAS v4u*)(kb_ + sj * AT_ROW + sd0 * 2) = w;
#pragma unroll
            for (int t = 0; t < 8; ++t) *(LAS bf16*)(vb_ + (sd0 + t) * AT_ROW + sj * 2) = (bf16)f2bf(vv[t]);
        }
        __syncthreads();
        if (s + 1 < ntile) { const bool lc = s + 1 < nloc; const int kp0 = lc ? 128 * (n - 1) + 64 * (tlo + s + 1) : 64 * (s + 1 - nloc); const int krow = lc ? b * SEQ + kp0 + sj : R_LAT + b * CTXL + kp0 + sj;
            const bf16* kp_ = P + (size_t)krow * DIN + K_OFF + kv * 64; kw = *(const v4u*)(kp_ + sd0); kp = *(const v4u*)(kp_ + (sd0 ^ 16)); vw = *(const v4u*)(P + (size_t)krow * DIN + V_OFF + kv * 64 + sd0); }
        const int rel = local ? (tlo + s) - hq : 2;
        f32x16 st[2];
#pragma unroll
        for (int kb = 0; kb < 2; ++kb) {
#pragma unroll
            for (int r = 0; r < 16; ++r) st[kb][r] = 0.f;
#pragma unroll
            for (int ks = 0; ks < 4; ++ks) { const bf16x8v kf = *(const LAS bf16x8v*)(kb_ + (32 * kb + r32) * AT_ROW + (16 * ks + 8 * hi) * 2);
                st[kb] = __builtin_amdgcn_mfma_f32_32x32x16_bf16(kf, qf[ks], st[kb], 0, 0, 0); }
        }
        if (rel == 0 || rel == 4) {
#pragma unroll
            for (int kb = 0; kb < 2; ++kb)
#pragma unroll
                for (int r = 0; r < 16; ++r) { const int kk = 32 * kb + crow16(r, hi); const bool bad = rel == 0 ? kk < qq : kk > qq; st[kb][r] = bad ? -1e30f : st[kb][r]; } }
        float mx = st[0][0];
#pragma unroll
        for (int kb = 0; kb < 2; ++kb)
#pragma unroll
            for (int r = 0; r < 16; ++r) mx = fmaxf(mx, st[kb][r]);
        mx = fmaxf(mx, __shfl_xor(mx, 32));
        const float mnew = mx > mrun + 8.0f ? mx : mrun, corr = __builtin_amdgcn_exp2f(mrun - mnew);
        mrun = mnew;
        float ps = 0.f;
#pragma unroll
        for (int kb = 0; kb < 2; ++kb)
#pragma unroll
            for (int r = 0; r < 16; ++r) { st[kb][r] = __builtin_amdgcn_exp2f(st[kb][r] - mnew); ps += st[kb][r]; }
        lsum = lsum * corr + ps;
        if (__builtin_amdgcn_ballot_w64(corr != 1.0f) != 0ull) {
#pragma unroll
            for (int db = 0; db < 2; ++db)
#pragma unroll
                for (int r = 0; r < 16; ++r) o[db][r] *= corr; }
#pragma unroll
        for (int m = 0; m < 4; ++m) { const int kb = m >> 1, r0 = 8 * (m & 1); v4u pw;
            pw.x = pk2(st[kb][r0 + 0], st[kb][r0 + 1]); pw.y = pk2(st[kb][r0 + 2], st[kb][r0 + 3]); pw.z = pk2(st[kb][r0 + 4], st[kb][r0 + 5]); pw.w = pk2(st[kb][r0 + 6], st[kb][r0 + 7]);
            const bf16x8v pf = __builtin_bit_cast(bf16x8v, pw);
#pragma unroll
            for (int db = 0; db < 2; ++db) { const LAS unsigned char* vp = vb_ + (32 * db + r32) * AT_ROW + (16 * m + 4 * hi) * 2;
                const v2u lo = *(const LAS v2u*)vp, hh = *(const LAS v2u*)(vp + 16); const v4u w = {lo.x, lo.y, hh.x, hh.y};
                o[db] = __builtin_amdgcn_mfma_f32_32x32x16_bf16(__builtin_bit_cast(bf16x8v, w), pf, o[db], 0, 0, 0); } }
    }
    {
        const float lt = lsum + __shfl_xor(lsum, 32), inv = 1.0f / lt;
        bf16* op = CAT + (size_t)qrow * DM + h * 64;
#pragma unroll
        for (int db = 0; db < 2; ++db)
#pragma unroll
            for (int rq = 0; rq < 4; ++rq) { v2u w; w.x = pk2(o[db][4 * rq] * inv, o[db][4 * rq + 1] * inv); w.y = pk2(o[db][4 * rq + 2] * inv, o[db][4 * rq + 3] * inv);
                *(v2u*)(op + 32 * db + 8 * rq + 4 * hi) = w; }
    }
}
__device__ __forceinline__ void conv_tile_v1(Frame& F, const Args& AR, int l, int tile) {
    const bf16* P = (const bf16*)(F.ws + WS_P); bf16* CAT = (bf16*)(F.ws + WS_CAT);
    LAS float* hh = (LAS float*)F.lds;
    LAS float* red = hh + 47 * 512;
    const int c = F.tid;
    int base, t0, Ls;
    if (tile < R_LAT / 16) { const int b = tile / (SEQ / 16); t0 = (tile % (SEQ / 16)) * 16; base = b * SEQ; Ls = SEQ; }
    else { const int q = tile - R_LAT / 16; const int b = q / (CTXL / 16); t0 = (q % (CTXL / 16)) * 16; base = R_LAT + b * CTXL; Ls = CTXL; }
    __syncthreads();
#pragma unroll 1
    for (int kb = 0; kb < 6; kb += 3) {
        v4u vv[3], gg[3];
#pragma unroll
        for (int k = 0; k < 3; ++k) { const int q = F.tid + NTHR * (kb + k), i = q >> 6, c8 = (q & 63) * 8, t = t0 - 15 + i;
            vv[k] = (v4u){0u, 0u, 0u, 0u}; gg[k] = vv[k];
            if (i < 46 && t >= 0 && t < Ls) { const bf16* pr = P + (size_t)(base + t) * DIN + CONV_OFF + c8; vv[k] = *(const v4u*)pr; gg[k] = *(const v4u*)(pr + 512); } }
#pragma unroll
        for (int k = 0; k < 3; ++k) { const int q = F.tid + NTHR * (kb + k), i = q >> 6, c8 = (q & 63) * 8;
            if (i < 46) { float a[8], g[8]; unpack8(vv[k], a); unpack8(gg[k], g);
#pragma unroll
                for (int e = 0; e < 8; ++e) a[e] *= sigmoidf_(g[e]);
                *(LAS f32x4*)(hh + i * 512 + c8) = (f32x4){a[0], a[1], a[2], a[3]}; *(LAS f32x4*)(hh + i * 512 + c8 + 4) = (f32x4){a[4], a[5], a[6], a[7]}; } }
    }
    hh[46 * 512 + c] = 0.f;
    const float cb = AR.in[I_CONVB][l * 512 + c];
    __syncthreads();
    float ov[16];
#pragma unroll
    for (int i = 0; i < 16; ++i) ov[i] = cb;
    {
        const float* wp = AR.in[I_CONVW] + (size_t)l * 31 * 512 + c;
        float wc[8];
#pragma unroll
        for (int t = 0; t < 8; ++t) wc[t] = wp[t * 512];
#pragma unroll 1
        for (int kb = 0; kb < 4; ++kb) {
            float wn[8];
#pragma unroll
            for (int t = 0; t < 8; ++t) { const int k = 8 * (kb + 1) + t; wn[t] = wp[(k < 31 ? k : 30) * 512]; if (k >= 31) wn[t] = 0.f; }
            const LAS float* hb = hh + (8 * kb) * 512 + c;
            float hv[23];
#pragma unroll
            for (int j = 0; j < 23; ++j) hv[j] = hb[j * 512];
#pragma unroll
            for (int t = 0; t < 8; ++t)
#pragma unroll
                for (int i = 0; i < 16; ++i) ov[i] += hv[i + t] * wc[t];
#pragma unroll
            for (int t = 0; t < 8; ++t) wc[t] = wn[t];
        }
    }
    __syncthreads();
#pragma unroll
    for (int i = 0; i < 16; ++i) hh[i * 512 + c] = ov[i];
    __syncthreads();
    {
        float a0[8], a1[8]; float s0 = 0.f, s1 = 0.f;
#pragma unroll
        for (int j = 0; j < 8; ++j) { a0[j] = hh[(2 * F.wave) * 512 + F.lane + 64 * j]; a1[j] = hh[(2 * F.wave + 1) * 512 + F.lane + 64 * j]; s0 += a0[j]; s1 += a1[j]; }
        const float m0 = wave_sum(s0) * (1.0f / 512.0f), m1 = wave_sum(s1) * (1.0f / 512.0f);
        float q0 = 0.f, q1 = 0.f;
#pragma unroll
        for (int j = 0; j < 8; ++j) { const float d0 = a0[j] - m0, d1 = a1[j] - m1; q0 += d0 * d0; q1 += d1 * d1; }
        q0 = wave_sum(q0); q1 = wave_sum(q1);
        if (F.lane == 0) { red[4 * F.wave] = m0; red[4 * F.wave + 1] = rsqrtf(q0 * (1.0f / 512.0f) + 1e-5f); red[4 * F.wave + 2] = m1; red[4 * F.wave + 3] = rsqrtf(q1 * (1.0f / 512.0f) + 1e-5f); }
    }
    __syncthreads();
    const float lg = AR.in[I_LNG][l * 512 + c], lb = AR.in[I_LNB][l * 512 + c];
#pragma unroll
    for (int i = 0; i < 16; ++i) { const float mean = red[2 * i], rstd = red[2 * i + 1];
        const float y = (ov[i] - mean) * rstd * lg + lb;
        CAT[(size_t)(base + t0 + i) * DM + 1024 + c] = (bf16)f2bf(y * sigmoidf_(y)); }
}
__device__ __forceinline__ f32x2 cmul(f32x2 a, f32x2 b) { return (f32x2){a.x * b.x - a.y * b.y, a.x * b.y + a.y * b.x}; }
__device__ __forceinline__ void dft4(f32x2& a, f32x2& b, f32x2& c, f32x2& d) {
    const f32x2 s0 = a + c, s1 = a - c, s2 = b + d, s3 = b - d;
    a = s0 + s2; c = s0 - s2; b = (f32x2){s1.x + s3.y, s1.y - s3.x}; d = (f32x2){s1.x - s3.y, s1.y + s3.x};
}
__device__ __forceinline__ void dft16(f32x2 (&x)[16]) {
#pragma unroll
    for (int q0 = 0; q0 < 4; ++q0) dft4(x[q0], x[4 + q0], x[8 + q0], x[12 + q0]);
    const f32x2 w1 = {0.9238795325112867f, -0.3826834323650898f}, w2 = {0.7071067811865476f, -0.7071067811865476f}, w3 = {0.3826834323650898f, -0.9238795325112867f},
                w6 = {-0.7071067811865476f, -0.7071067811865476f}, w9 = {-0.9238795325112867f, 0.3826834323650898f};
    x[5] = cmul(x[5], w1); x[6] = cmul(x[6], w2); x[7] = cmul(x[7], w3);
    x[9] = cmul(x[9], w2); x[10] = (f32x2){x[10].y, -x[10].x}; x[11] = cmul(x[11], w6);
    x[13] = cmul(x[13], w3); x[14] = cmul(x[14], w6); x[15] = cmul(x[15], w9);
#pragma unroll
    for (int p1 = 0; p1 < 4; ++p1) dft4(x[4 * p1], x[4 * p1 + 1], x[4 * p1 + 2], x[4 * p1 + 3]);
}
template <int LOG2N> __device__ __forceinline__ void fft_item(Frame& F, const Args& AR, int item) {
    constexpr int N = 1 << LOG2N, TP = N / 16, PP = NTHR / TP, NST = LOG2N / 4, SLOTS = N + N / 16;
    const bf16* P = (const bf16*)(F.ws + WS_P); bf16* CAT = (bf16*)(F.ws + WS_CAT); const f32x2* twg = (const f32x2*)(F.ws + WS_TW);
    const int pr = F.tid / TP, j = F.tid % TP;
    int b, h, mA;
    if (LOG2N == 12) { const int grp = item & 15; h = (item >> 4) & 3; b = item >> 6; mA = 4 * grp + 2 * pr; } else { h = item & 3; b = item >> 2; mA = 2 * pr; }
    const int rbase = (LOG2N == 12) ? b * SEQ : R_LAT + b * CTXL;
    LAS f32x2* bufA = (LAS f32x2*)F.lds + (size_t)(2 * pr) * SLOTS; LAS f32x2* bufB = bufA + SLOTS;
    const float norm = (LOG2N == 12) ? 0.001381067932004975f : 0.005524271728019903f;
    f32x2 xa[16], xb[16];
    {
        const bf16* src = P + (size_t)(rbase + j) * DIN + FFT_OFF + 128 * h + 2 * mA;
#pragma unroll
        for (int q = 0; q < 16; ++q) { const v2u w = *(const v2u*)(src + (size_t)(TP * q) * DIN); xa[q] = (f32x2){bflo(w.x), bfhi(w.x)}; xb[q] = (f32x2){bflo(w.y), bfhi(w.y)}; }
        dft16(xa); dft16(xb);
    }
    __syncthreads();
#pragma unroll
    for (int st = 1; st < NST; ++st) {
        const int Ns0 = 1 << (4 * (st - 1));
        { const int k = j & (Ns0 - 1), o0 = (j - k) * 16 + k;
#pragma unroll
          for (int p1 = 0; p1 < 4; ++p1)
#pragma unroll
              for (int p0 = 0; p0 < 4; ++p0) { const int idx = o0 + (p1 + 4 * p0) * Ns0, s = idx + (idx >> 4); bufA[s] = xa[4 * p1 + p0]; bufB[s] = xb[4 * p1 + p0]; } }
        __syncthreads();
        const int Ns = Ns0 * 16, k = j & (Ns - 1);
#pragma unroll
        for (int q = 0; q < 16; ++q) { const int idx = j + TP * q, s = idx + (idx >> 4); xa[q] = bufA[s]; xb[q] = bufB[s]; }
        const f32x2 w1 = twg[k * (256 / Ns)]; f32x2 w = w1;
#pragma unroll
        for (int q = 1; q < 16; ++q) { xa[q] = cmul(xa[q], w); xb[q] = cmul(xb[q], w); w = cmul(w, w1); }
        dft16(xa); dft16(xb);
        __syncthreads();
    }
    const bool special = (mA == 0);
    if (LOG2N == 8 || (item & 15) == 0) {
        if (special) {
#pragma unroll
            for (int p1 = 0; p1 < 4; ++p1)
#pragma unroll
                for (int p0 = 0; p0 < 4; ++p0) { const int idx = j + TP * (p1 + 4 * p0); bufA[idx + (idx >> 4)] = xa[4 * p1 + p0]; } }
        __syncthreads();
        if (special) {
#pragma unroll
            for (int p1 = 0; p1 < 4; ++p1)
#pragma unroll
                for (int p0 = 0; p0 < 4; ++p0) { const int idx = j + TP * (p1 + 4 * p0), mi = (N - idx) & (N - 1); const f32x2 zr = bufA[mi + (mi >> 4)], z = xa[4 * p1 + p0];
                    xa[4 * p1 + p0] = (f32x2){(z.x + zr.x) * 0.5f, (z.y + zr.y) * 0.5f}; } }
        __syncthreads();
    }
#pragma unroll
    for (int p1 = 0; p1 < 4; ++p1)
#pragma unroll
        for (int p0 = 0; p0 < 4; ++p0) { const int idx = j + TP * (p1 + 4 * p0), mi = (N - idx) & (N - 1); const f32x2 za = xa[4 * p1 + p0], zb = xb[4 * p1 + p0];
            bf16* orow = CAT + (size_t)(rbase + idx) * DM + 1536 + 128 * h; bf16* mrow = CAT + (size_t)(rbase + mi) * DM + 1536 + 128 * h;
            if (special) { orow[0] = (bf16)f2bf(za.x * norm); orow[64] = (bf16)f2bf(za.y * norm); orow[1] = (bf16)f2bf(zb.x * norm); mrow[127] = (bf16)f2bf(zb.x * norm); }
            else { *(unsigned*)(orow + mA) = pk2(za.x * norm, zb.x * norm); mrow[128 - mA] = (bf16)f2bf(za.x * norm); mrow[127 - mA] = (bf16)f2bf(zb.x * norm); } }
}
#ifndef UP_ALIGN
#define UP_ALIGN true
#endif
#ifndef UP_SP2
#define UP_SP2 true
#endif

#ifndef NLAYER_RUN
#define NLAYER_RUN DEPTH
#endif
constexpr int N_PRO = 3, PH_PER_LAYER = 12, N_PHASES = N_PRO + DEPTH * PH_PER_LAYER;

__device__ __forceinline__ void ffn_up(Frame& F, int lf, int skip_epi) {
    pg8::Gemm g{(const bf16*)(F.ws + WS_H), (const bf16*)(F.ws + WS_WI) + (size_t)lf * 2 * DFF * DM, R, 2 * DFF, DM}; pg8::StaticOrderT<R, 2 * DFF, DM> S; S.init(F.G, F.bid);
    pg8::EpiSwiglu E{(bf16*)(F.ws + WS_ACT), DFF, skip_epi};
    pg8::gemm_phase<pg8::EpiSwiglu, pg8::StaticOrderT<R, 2 * DFF, DM>, UP_ALIGN, UP_SP2, DM>(F.lds, g, S, E);
}
template <int K, int NS> __device__ __forceinline__ void gemm_to_y(Frame& F, const bf16* A, const bf16* Bt, bool with_ctx = true) {
    pg8::Gemm g{A, Bt, R, DM, K}; pg8::SplitTailOrder<K, NS> S; S.init(F.G, F.bid, with_ctx);
    pg8::EpiYSplit E{(bf16*)(F.ws + WS_Y), (float*)(F.ws + WS_YP), DM};
    pg8::gemm_phase<pg8::EpiYSplit, pg8::SplitTailOrder<K, NS>, true, true, K>(F.lds, g, S, E);
}

__global__ void __launch_bounds__(NTHR, 2) fwd_kernel(Args args) {
    extern __shared__ __attribute__((aligned(16))) unsigned char lds_raw[];
    Frame F;
    F.lds = (LAS unsigned char*)lds_raw;
    F.tid = threadIdx.x; F.lane = F.tid & 63; F.wave = __builtin_amdgcn_readfirstlane(F.tid >> 6);
    F.G = gridDim.x; F.bid = blockIdx.x;
    F.out = args.out; F.ws = args.ws;
    volatile LAS unsigned* MISC = (volatile LAS unsigned*)(F.lds + MISC_OFF);
    if (F.tid < 32) MISC[F.tid] = 0u;
    __syncthreads();
    unsigned* ctl = (unsigned*)(F.ws + WS_CTL);
#if MK_PER_PHASE
    XcdBarrier bar; bar.bar = ctl + CW_BAR; bar.x = 0; bar.st = nullptr;
#define GRID_BAR() do { } while (0)
#else
    XcdBarrier bar = xcd_barrier_post(ctl + CW_BAR, MISC + 8);
#define GRID_BAR() xcd_barrier(bar)
#endif
    const int lo = args.ph_lo, hi = args.ph_hi;
    int ph = 0;
#ifndef BG_CONV
#define BG_CONV 1
#endif
#ifndef PROBE_SKIPEPI
#define PROBE_SKIPEPI 0
#endif
#ifndef PROBE_DUP
#define PROBE_DUP 0
#endif
#define PHASE(id, ...) if (ph >= lo && ph < hi) { { int t_ = threadIdx.x; asm volatile("" : "+v"(t_)); F.tid = t_; F.lane = t_ & 63; F.wave = __builtin_amdgcn_readfirstlane(t_ >> 6); } \
        { const int rep = 0; (void)rep; __VA_ARGS__; } if (PROBE_DUP != 0 && PROBE_DUP == (id)) { GRID_BAR(); { const int rep = 1; (void)rep; __VA_ARGS__; } } if (ph + 1 < hi) GRID_BAR(); } ++ph;

    PHASE(5, p0a(F, args))
    PHASE(10, p0b(F, args))
    const float* COMB = (const float*)(F.ws + WS_COMB);
    PHASE(0, norm_phase(F, args, true, false, 0, COMB + (size_t)12 * 9 * DM, 1.0f, true, false))

#pragma unroll 1
    for (int l = 0; l < NLAYER_RUN; ++l) {
        PHASE(1, { ffn_up(F, l * 2 + 0, (PROBE_SKIPEPI && rep && lo == 0) ? 1 : 0); if (BG_CONV && l < DEPTH - 1) bg_site(F, args, l + 1, BGB_UP1, 216, BG_UP); })
        PHASE(2, { gemm_to_y<DFF, 11>(F, (const bf16*)(F.ws + WS_ACT), (const bf16*)(F.ws + WS_WO) + (size_t)(l * 2 + 0) * DM * DFF); if (BG_CONV && l < DEPTH - 1) bg_site(F, args, l + 1, BGB_DN1, 176, BG_DN); })
        PHASE(11, norm_phase(F, args, l == 0, true, 11, COMB + (size_t)(l * 3 + 0) * 9 * DM, rep ? 0.0f : 1.0f, true, false))
        PHASE(3, {
            pg8::Gemm g{(const bf16*)(F.ws + WS_H), (const bf16*)(F.ws + WS_WIN) + (size_t)l * DIN * DM, R, DIN, DM}; pg8::StaticOrderT<R, DIN, DM> S; S.init(F.G, F.bid);
            pg8::EpiBf16<0> E{(bf16*)(F.ws + WS_P), DIN, nullptr, 0, 0, 1.f};
            pg8::gemm_phase<pg8::EpiBf16<0>, pg8::StaticOrderT<R, DIN, DM>, true, true, DM>(F.lds, g, S, E);
            if (BG_CONV && l < DEPTH - 1) bg_site(F, args, l + 1, BGB_IN, 118, BG_IN);
        })
        PHASE(6, {
            constexpr int W_ATT = 272, W_CFFT = W_ATT + 8, W_FFT = W_CFFT + 128, W_CONV = W_FFT + R / 16, W_SG = W_CONV + 32 * 9, W_END = W_SG;
            unsigned* qhead = ctl + CW_QUEUE + 64 * (l + 4 * rep);
            int it = F.bid;
            unsigned nxt = 0u;
            if (F.tid == 0) nxt = __hip_atomic_fetch_add(qhead, 1u, __ATOMIC_RELAXED, __HIP_MEMORY_SCOPE_AGENT) + (unsigned)F.G;
            while (it < W_END) {
                { int t_ = threadIdx.x; asm volatile("" : "+v"(t_)); F.tid = t_; F.lane = t_ & 63; F.wave = __builtin_amdgcn_readfirstlane(t_ >> 6); }
                if (it < W_ATT) { _Pragma("unroll 1") for (int rr = 0; rr < (PROBE_DUP == 61 ? 2 : 1); ++rr) attn_item_mfma(F, args, l, it); }
                else if (it < W_CFFT) fft_item<8>(F, args, it - W_ATT);
                else if (it < W_FFT) { _Pragma("unroll 1") for (int rr = 0; rr < (PROBE_DUP == 62 ? 2 : 1); ++rr) fft_item<12>(F, args, it - W_CFFT); }
                else if (it < W_CONV) { _Pragma("unroll 1") for (int rr = 0; rr < (PROBE_DUP == 63 ? 2 : 1); ++rr) conv_tile_v1(F, args, l, it - W_FFT); }
                else { ssm_sgemm_item(F, args, l, it - W_CONV); if (PROBE_DUP == 64) ssm_sgemm_item(F, args, l, it - W_CONV); }
                if (threadIdx.x == 0) MISC[0] = nxt;
                __syncthreads();
                it = __builtin_amdgcn_readfirstlane((int)MISC[0]);
                if (threadIdx.x == 0 && it < W_END) nxt = __hip_atomic_fetch_add(qhead, 1u, __ATOMIC_RELAXED, __HIP_MEMORY_SCOPE_AGENT) + (unsigned)F.G;
            }
            __syncthreads();
        })
        PHASE(8, {
            for (int it = F.bid; it < 32 * 8; it += F.G) {
                const int g = it & 31, rt = it >> 5;
                if (rt < 7) ssm_gemm_rows<1, 4>(F, args, l, g, rt * 64); else ssm_gemm_rows<1, 6>(F, args, l, g, 448);
            }
            __syncthreads();
        })
        PHASE(9, {
            for (int it = F.bid; it < 256; it += F.G) glu_item(F, args, l, it);
            __syncthreads();
        })
        PHASE(4, { gemm_to_y<DM, 4>(F, (const bf16*)(F.ws + WS_CAT), (const bf16*)(F.ws + WS_WOUT) + (size_t)l * DM * DM, l < DEPTH - 1); if (BG_CONV && l < DEPTH - 1) bg_site(F, args, l + 1, BGB_OUT, 64, BG_OUT); })
        PHASE(11, norm_phase(F, args, false, true, 4, COMB + (size_t)(l * 3 + 1) * 9 * DM, rep ? 0.0f : 1.0f, true, false, l < DEPTH - 1 ? R : R_LAT))
        PHASE(1, { ffn_up(F, l * 2 + 1, (PROBE_SKIPEPI && rep && lo == 0) ? 1 : 0); if (BG_CONV && l < DEPTH - 1) bg_site(F, args, l + 1, BGB_UP2, 216, BG_UP); })
        PHASE(2, { gemm_to_y<DFF, 11>(F, (const bf16*)(F.ws + WS_ACT), (const bf16*)(F.ws + WS_WO) + (size_t)(l * 2 + 1) * DM * DFF, l < DEPTH - 1); if (BG_CONV && l < DEPTH - 1) bg_site(F, args, l + 1, BGB_DN2, 176, BG_DN); })
        PHASE(11, {
            const bool last = (l == DEPTH - 1);
            if (BG_CONV && !last) bg_drain(F, args, l + 1);
            norm_phase(F, args, false, true, 11, COMB + (size_t)(l * 3 + 2) * 9 * DM, rep ? 0.0f : 1.0f, !last, last, last ? R_LAT : R);
        })
#ifdef PROBE_BARS
        if (l < DEPTH - 1) { _Pragma("unroll 1") for (int q = 0; q < PROBE_BARS; ++q) GRID_BAR(); }
#endif
    }
}

extern "C" void kernel_launch(void* const* d_in, const int* in_sizes, int n_in, void* d_out, int out_size, void* d_ws, size_t ws_size, hipStream_t stream) {
    static int grid = 0;
    if (grid == 0) {
        if (n_in != 26 || in_sizes[0] != R_LAT * DM || out_size != R_LAT * DM || ws_size < WS_END) {
            fprintf(stderr, "kernel_launch: unexpected shapes: n_in %d in0 %d out %d ws %zu (need %zu)\n", n_in, n_in > 0 ? in_sizes[0] : -1, out_size, ws_size, (size_t)WS_END); grid = -1; return; }
        int dev = 0, cus = 0, per_cu = 0;
        if (hipGetDevice(&dev) != hipSuccess || hipDeviceGetAttribute(&cus, hipDeviceAttributeMultiprocessorCount, dev) != hipSuccess) { fprintf(stderr, "kernel_launch: device query failed\n"); grid = -1; return; }
        if (hipFuncSetAttribute((const void*)fwd_kernel, hipFuncAttributeMaxDynamicSharedMemorySize, LDS_BYTES) != hipSuccess) { fprintf(stderr, "kernel_launch: hipFuncSetAttribute failed\n"); grid = -1; return; }
        if (hipOccupancyMaxActiveBlocksPerMultiprocessor(&per_cu, (const void*)fwd_kernel, NTHR, LDS_BYTES) != hipSuccess || per_cu < 1)
            fprintf(stderr, "kernel_launch: note: occupancy query reports %d workgroups per CU\n", per_cu);
        (void)hipGetLastError();
        grid = cus;
    }
    if (grid < 0) return;
    if (hipMemsetAsync((char*)d_ws + WS_CTL, 0, CTL_ZERO_BYTES, stream) != hipSuccess) { fprintf(stderr, "kernel_launch: memset failed\n"); return; }
    Args a{};
    for (int i = 0; i < 26; ++i) a.in[i] = (const float*)d_in[i];
    a.out = (float*)d_out; a.ws = (unsigned char*)d_ws;
#if MK_PER_PHASE
    for (int p = 0; p < N_PHASES; ++p) { a.ph_lo = p; a.ph_hi = p + 1; hipLaunchKernelGGL(fwd_kernel, dim3(grid), dim3(NTHR), LDS_BYTES, stream, a); }
#else
    a.ph_lo = 0; a.ph_hi = N_PHASES;
    hipLaunchKernelGGL(fwd_kernel, dim3(grid), dim3(NTHR), LDS_BYTES, stream, a);
#endif
    const hipError_t le = hipPeekAtLastError();
    if (le != hipSuccess) fprintf(stderr, "kernel_launch: launch failed: %s\n", hipGetErrorName(le));
}
```

```cpp
#include <hip/hip_runtime.h>
#include <cstdio>
#include <cstdint>
namespace pg8 {
#define PG8_LAS __attribute__((address_space(3)))
typedef unsigned short bf16_t;
typedef short bf16x8 __attribute__((ext_vector_type(8)));
typedef float f32x4 __attribute__((ext_vector_type(4)));
typedef unsigned u32x4 __attribute__((ext_vector_type(4)));
constexpr int BM = 256, BK = 64, HALF = 128, HTB = HALF * BK * 2  , STAGE_BYTES = 8 * HTB, NXCD = 8, WGM = 8;

__host__ __device__ __forceinline__ int lds_byte(int r, int c) { const int st = (r >> 4) * 2 + (c >> 5), rr = r & 15, cc = c & 31, ob = rr * 64 + cc * 2; return st * 1024 + (ob ^ (((ob >> 9) & 1) << 5)); }
__host__ __device__ __forceinline__ void stage_rc(int b, int& R, int& C) { const int st = b / 1024, sb = b % 1024, swz = sb ^ (((sb >> 9) & 1) << 5); R = (st >> 1) * 16 + swz / 64; C = (st & 1) * 32 + (swz % 64) / 2; }
__host__ __device__ __forceinline__ int perm32(int rho) { const int n = rho >> 4, i = rho & 15; return 8 * (i >> 2) + 4 * n + (i & 3); }

struct Unit { int pm, pn, k0, nt, ks; };
struct Gemm { const bf16_t* A; const bf16_t* Bt; int M, N, K; };

struct StaticOrder {
    int nM, nN, nwg, G, c, ntf;
    __host__ __device__ void init(int M, int N, int K, int G_, int c_) { nM = M / BM; nN = N / BM; nwg = nM * nN; G = G_; c = c_; ntf = K / BK; }
    __host__ __device__ __forceinline__ bool next(int i, Unit& u) const {
        const long L = (long)i * G + c; if (L >= nwg) return false;
        int wgid = (int)L; { const int q = nwg / NXCD, r = nwg % NXCD, xcd = wgid % NXCD, off = wgid / NXCD; wgid = (xcd < r ? xcd * (q + 1) : r * (q + 1) + (xcd - r) * q) + off; }
        const int nig = WGM * nN, gid = wgid / nig, fm = gid * WGM, gsz = (nM - fm) < WGM ? (nM - fm) : WGM;
        u.pm = fm + ((wgid % nig) % gsz); u.pn = (wgid % nig) / gsz; u.k0 = 0; u.nt = ntf; u.ks = 0; return true;
    }
    __device__ __forceinline__ void a_ready(const Unit&) const {}
    __device__ __forceinline__ void done(const Unit&) const {}
};

template <int M_, int N_, int K_> struct StaticOrderT {
    int G, c;
    __host__ __device__ void init(int G_, int c_) { G = G_; c = c_; }
    __host__ __device__ __forceinline__ bool next(int i, Unit& u) const {
        constexpr int nM = M_ / BM, nN = N_ / BM, nwg = nM * nN;
        const long L = (long)i * G + c; if (L >= nwg) return false;
        int wgid = (int)L; { constexpr int q = nwg / NXCD, r = nwg % NXCD; const int xcd = wgid % NXCD, off = wgid / NXCD; wgid = (xcd < r ? xcd * (q + 1) : r * (q + 1) + (xcd - r) * q) + off; }
        constexpr int nig = WGM * nN; const int gid = wgid / nig, fm = gid * WGM, gsz = (nM - fm) < WGM ? (nM - fm) : WGM;
        u.pm = fm + ((wgid % nig) % gsz); u.pn = (wgid % nig) / gsz; u.k0 = 0; u.nt = K_ / BK; u.ks = 0; return true;
    }
    __device__ __forceinline__ void a_ready(const Unit&) const {}
    __device__ __forceinline__ void done(const Unit&) const {}
};
template <int K_, int NS> struct SplitTailOrder {
    int G, c, ntail;
    __host__ __device__ void init(int G_, int c_, bool with_tail = true) { G = G_; c = c_; ntail = with_tail ? 16 * NS : 0; }
    __host__ __device__ __forceinline__ bool next(int i, Unit& u) const {
        constexpr int ntsub = K_ / BK / NS, nN = 8, nwg = 256, nig = WGM * nN;
        const int L = i * G + c;
        if (L >= 256 + ntail) return false;
        const bool tail = L >= 256;
        const int Lc = tail ? 0 : L; const int wgid = (Lc % NXCD) * (nwg / NXCD) + Lc / NXCD;
        const int gid = wgid / nig, fm = gid * WGM; const int pm0 = fm + ((wgid % nig) % WGM), pn0 = (wgid % nig) / WGM;
        const int j = tail ? L - 256 : 0, tile = j / NS, ks = j % NS;
        u.pm = tail ? 32 + tile / 8 : pm0; u.pn = tail ? tile % 8 : pn0; u.ks = tail ? ks : 0; u.nt = tail ? ntsub : K_ / BK; u.k0 = tail ? ks * ntsub * BK : 0;
        return true;
    }
    __device__ __forceinline__ void a_ready(const Unit&) const {}
    __device__ __forceinline__ void done(const Unit&) const {}
};

__device__ __forceinline__ unsigned cvt_pk_bf16(float lo, float hi) { unsigned r; asm volatile("v_cvt_pk_bf16_f32 %0, %1, %2" : "=v"(r) : "v"(lo), "v"(hi)); return r; }
typedef float f32x2 __attribute__((ext_vector_type(2)));
__device__ __forceinline__ f32x2 gelu_pk(f32x2 v) {
    const f32x2 av = __builtin_elementwise_abs(v), d = av * 0.2316418882f + 1.0f;
    f32x2 t; t.x = __builtin_amdgcn_rcpf(d.x); t.y = __builtin_amdgcn_rcpf(d.y);
    f32x2 q = t * 0.5307027145f + (-0.7265760135f); q = q * t + 0.7107068705f; q = q * t + (-0.142248368f); q = q * t + 0.127414796f; q = q * t;
    const f32x2 s = (v * v) * (-0.72134752044f);
    f32x2 e; e.x = __builtin_amdgcn_exp2f(s.x); e.y = __builtin_amdgcn_exp2f(s.y);
    const f32x2 m = v * (q * e), r = v - m;
    f32x2 o; o.x = v.x < 0.f ? m.x : r.x; o.y = v.y < 0.f ? m.y : r.y; return o;
}

template <int ACT  > struct EpiBf16 {
    static constexpr bool PERM = true, AFTER_DRAIN = false; static_assert(ACT == 0 || ACT == 1, "EpiBf16: ACT is 0 (none) or 1 (gelu_pk)");
    bf16_t* O; int ldc; const float* bias; int split_cols; size_t split_stride; float scale0;
    __device__ __forceinline__ void operator()(const f32x4 (&acc)[2][2][4][2], const Unit& u, int wr, int wc, int fr, int fq) const {
        const int row0 = u.pm * BM + wr * 64 + fr; int colt = u.pn * BM; bf16_t* base = O;
        float sc = 1.f; if (split_cols) { const int t = colt / split_cols; base += (size_t)t * split_stride; colt -= t * split_cols; if (t == 0) sc = scale0; }
        const int col0 = colt + wc * 32 + 8 * fq, bcol0 = u.pn * BM + wc * 32 + 8 * fq;
        f32x4 bv[2][2];
#pragma unroll
        for (int bj = 0; bj < 2; ++bj)
#pragma unroll
            for (int n = 0; n < 2; ++n) bv[bj][n] = bias ? *(const f32x4*)(bias + bcol0 + bj * HALF + 4 * n) : (f32x4){0.f, 0.f, 0.f, 0.f};
#pragma unroll
        for (int ai = 0; ai < 2; ++ai)
#pragma unroll
            for (int m = 0; m < 4; ++m) { bf16_t* rowp = base + (size_t)(row0 + ai * HALF + m * 16) * ldc + col0;
#pragma unroll
                for (int bj = 0; bj < 2; ++bj) { f32x4 v0 = acc[ai][bj][m][0] + bv[bj][0], v1 = acc[ai][bj][m][1] + bv[bj][1];
                    if (ACT == 1) { f32x2 a = gelu_pk((f32x2){v0[0], v0[1]}), b = gelu_pk((f32x2){v0[2], v0[3]}), c = gelu_pk((f32x2){v1[0], v1[1]}), d = gelu_pk((f32x2){v1[2], v1[3]});
                        v0 = (f32x4){a.x, a.y, b.x, b.y}; v1 = (f32x4){c.x, c.y, d.x, d.y}; }
                    v0 = v0 * sc; v1 = v1 * sc; u32x4 w; w.x = cvt_pk_bf16(v0[0], v0[1]); w.y = cvt_pk_bf16(v0[2], v0[3]); w.z = cvt_pk_bf16(v1[0], v1[1]); w.w = cvt_pk_bf16(v1[2], v1[3]);
                    *(u32x4*)(rowp + bj * HALF) = w; } }
    }
};
struct EpiF32 {
    static constexpr bool PERM = false, AFTER_DRAIN = false;
    float* C; int ldc; const float* bias;
    __device__ __forceinline__ void operator()(const f32x4 (&acc)[2][2][4][2], const Unit& u, int wr, int wc, int fr, int fq) const {
        const int row0 = u.pm * BM + wr * 64 + fr, col0 = u.pn * BM + wc * 32 + 4 * fq;
        f32x4 bv[2][2];
#pragma unroll
        for (int bj = 0; bj < 2; ++bj)
#pragma unroll
            for (int n = 0; n < 2; ++n) bv[bj][n] = bias ? *(const f32x4*)(bias + col0 + bj * HALF + n * 16) : (f32x4){0.f, 0.f, 0.f, 0.f};
#pragma unroll
        for (int ai = 0; ai < 2; ++ai)
#pragma unroll
            for (int m = 0; m < 4; ++m) { float* rowp = C + (size_t)(row0 + ai * HALF + m * 16) * ldc + col0;
#pragma unroll
                for (int bj = 0; bj < 2; ++bj)
#pragma unroll
                    for (int n = 0; n < 2; ++n) *(f32x4*)(rowp + bj * HALF + n * 16) = acc[ai][bj][m][n] + bv[bj][n]; }
    }
};
__device__ __forceinline__ void store16_wt(void* p, u32x4 v) { asm volatile("global_store_dwordx4 %0, %1, off sc1\n\ts_nop 1" :: "v"(p), "v"(v) : "memory");     }
#ifndef NT_ACT
#define NT_ACT 0
#endif
struct EpiSwiglu {
    static constexpr bool PERM = true, AFTER_DRAIN = false;
    bf16_t* O; int ldc; int skip;
    __device__ __forceinline__ void operator()(const f32x4 (&acc)[2][2][4][2], const Unit& u, int wr, int wc, int fr, int fq) const {
        if (skip) return;
        const int row0 = u.pm * BM + wr * 64 + fr, col0 = u.pn * HALF + wc * 32 + 8 * fq;
#pragma unroll
        for (int ai = 0; ai < 2; ++ai)
#pragma unroll
            for (int m = 0; m < 4; ++m) { bf16_t* rowp = O + (size_t)(row0 + ai * HALF + m * 16) * ldc + col0;
                float v[8];
#pragma unroll
                for (int n = 0; n < 2; ++n)
#pragma unroll
                    for (int j = 0; j < 4; ++j) { const float g = acc[ai][0][m][n][j], up = acc[ai][1][m][n][j];
                        v[n * 4 + j] = g * __builtin_amdgcn_rcpf(1.0f + __expf(-g)) * up; }
                u32x4 w; w.x = cvt_pk_bf16(v[0], v[1]); w.y = cvt_pk_bf16(v[2], v[3]); w.z = cvt_pk_bf16(v[4], v[5]); w.w = cvt_pk_bf16(v[6], v[7]);
                if (NT_ACT) __builtin_nontemporal_store(w, (u32x4*)rowp); else *(u32x4*)rowp = w; }
    }
};
struct EpiGlu {
    static constexpr bool PERM = true, AFTER_DRAIN = false;
    const bf16_t* YG; int ldy; bf16_t* O; int ldc; const float* bias;
    __device__ __forceinline__ void operator()(const f32x4 (&acc)[2][2][4][2], const Unit& u, int wr, int wc, int fr, int fq) const {
        const int row0 = u.pm * BM + wr * 64 + fr, col0 = u.pn * BM + wc * 32 + 8 * fq;
#pragma unroll
        for (int ai = 0; ai < 2; ++ai)
#pragma unroll
            for (int m = 0; m < 4; ++m) { const int row = row0 + ai * HALF + m * 16;
#pragma unroll
                for (int bj = 0; bj < 2; ++bj) { const int c = col0 + bj * HALF;
                    const u32x4 y = *(const u32x4*)(YG + (size_t)row * ldy + c);
                    const f32x4 b0 = *(const f32x4*)(bias + c), b1 = *(const f32x4*)(bias + c + 4);
                    const f32x4 z0 = acc[ai][bj][m][0] + b0, z1 = acc[ai][bj][m][1] + b1;
                    float v[8];
                    v[0] = __builtin_bit_cast(float, y.x << 16); v[1] = __builtin_bit_cast(float, y.x & 0xffff0000u); v[2] = __builtin_bit_cast(float, y.y << 16); v[3] = __builtin_bit_cast(float, y.y & 0xffff0000u);
                    v[4] = __builtin_bit_cast(float, y.z << 16); v[5] = __builtin_bit_cast(float, y.z & 0xffff0000u); v[6] = __builtin_bit_cast(float, y.w << 16); v[7] = __builtin_bit_cast(float, y.w & 0xffff0000u);
#pragma unroll
                    for (int j = 0; j < 4; ++j) { v[j] *= __builtin_amdgcn_rcpf(1.0f + __expf(-z0[j])); v[4 + j] *= __builtin_amdgcn_rcpf(1.0f + __expf(-z1[j])); }
                    u32x4 w; w.x = cvt_pk_bf16(v[0], v[1]); w.y = cvt_pk_bf16(v[2], v[3]); w.z = cvt_pk_bf16(v[4], v[5]); w.w = cvt_pk_bf16(v[6], v[7]);
                    *(u32x4*)(O + (size_t)row * ldc + c) = w; } }
    }
};
#ifndef NT_Y
#define NT_Y 0
#endif
struct EpiYSplit {
    static constexpr bool PERM = true, AFTER_DRAIN = false;
    bf16_t* C; float* CP; int ldc;
    __device__ __forceinline__ void operator()(const f32x4 (&acc)[2][2][4][2], const Unit& u, int wr, int wc, int fr, int fq) const {
        const int row0 = u.pm * BM + wr * 64 + fr, col0 = u.pn * BM + wc * 32 + 8 * fq;
        if (u.pm < 32) {
#pragma unroll
            for (int ai = 0; ai < 2; ++ai)
#pragma unroll
                for (int m = 0; m < 4; ++m) { bf16_t* rowp = C + (size_t)(row0 + ai * HALF + m * 16) * ldc + col0;
#pragma unroll
                    for (int bj = 0; bj < 2; ++bj) { const f32x4 v0 = acc[ai][bj][m][0], v1 = acc[ai][bj][m][1];
                        u32x4 w; w.x = cvt_pk_bf16(v0[0], v0[1]); w.y = cvt_pk_bf16(v0[2], v0[3]); w.z = cvt_pk_bf16(v1[0], v1[1]); w.w = cvt_pk_bf16(v1[2], v1[3]);
                        if (NT_Y) __builtin_nontemporal_store(w, (u32x4*)(rowp + bj * HALF)); else *(u32x4*)(rowp + bj * HALF) = w; } }
        } else {
            float* base = CP + ((size_t)u.ks * 512 + (row0 - 8192)) * ldc + col0;
#pragma unroll
            for (int ai = 0; ai < 2; ++ai)
#pragma unroll
                for (int m = 0; m < 4; ++m) { float* rowp = base + (size_t)(ai * HALF + m * 16) * ldc;
#pragma unroll
                    for (int bj = 0; bj < 2; ++bj) { *(f32x4*)(rowp + bj * HALF) = acc[ai][bj][m][0]; *(f32x4*)(rowp + bj * HALF + 4) = acc[ai][bj][m][1]; } }
        }
    }
};

template <class Epi, class Sched, bool ALIGN_EPI = false, bool SP2 = false, int KP = 0>
__device__ __forceinline__ void gemm_phase(PG8_LAS unsigned char* lds, const Gemm g, const Sched& S, const Epi& E) {
    int tid_ = threadIdx.x; asm volatile("" : "+v"(tid_)); const int tid = tid_, wid = __builtin_amdgcn_readfirstlane(tid >> 6), lane = tid & 63, wr = wid >> 2, wc = wid & 3, fr = lane & 15, fq = lane >> 4;
    const int K = KP ? KP : g.K;
    unsigned voffA[2], voffB[2];
#pragma unroll
    for (int i = 0; i < 2; ++i) { int R, C; stage_rc(tid * 16 + i * 8192, R, C); const int Rb = Epi::PERM ? ((R & ~31) + perm32(R & 31)) : R;
        voffA[i] = (unsigned)(R * K + C) * 2u; voffB[i] = (unsigned)(Rb * K + C) * 2u; }
    const size_t kstep = (size_t)(BK * 2);
    const size_t hstep = (size_t)HALF * K * 2;
    const size_t tstep = 2 * hstep;
    const unsigned ldsw = (unsigned)wid * 1024u;
    const int aoff = lds_byte(wr * 64 + fr, fq * 8), boff = lds_byte(wc * 32 + fr, fq * 8);
#define PG8_SA(b, h) (((b) * 2 + (h)) * HTB)
#define PG8_SB(b, h) ((4 + (b) * 2 + (h)) * HTB)
#ifndef PG8_AUX_voffB
#define PG8_AUX_voffB 0
#endif
#define PG8_AUX_voffA 0
#define PG8_STAGE(bufoff, gbase, voff) do { _Pragma("unroll") for (int _i = 0; _i < 2; ++_i) \
        __builtin_amdgcn_global_load_lds((const unsigned*)((const char*)(gbase) + (voff)[_i]), (PG8_LAS unsigned*)(lds + (bufoff) + ldsw + _i * 8192), 16, 0, PG8_AUX_##voff); } while (0)
#define PG8_LDA(dst, b, h) do { _Pragma("unroll") for (int m = 0; m < 4; ++m) _Pragma("unroll") for (int k = 0; k < 2; ++k) dst[m][k] = *(const PG8_LAS bf16x8*)(lds + PG8_SA(b, h) + aoff + m * 2048 + k * 1024); } while (0)
#define PG8_LDB(dst, b, h) do { _Pragma("unroll") for (int n = 0; n < 2; ++n) _Pragma("unroll") for (int k = 0; k < 2; ++k) dst[n][k] = *(const PG8_LAS bf16x8*)(lds + PG8_SB(b, h) + boff + n * 2048 + k * 1024); } while (0)
#define PG8_MMA(ai, bj, At, Bt) do { __builtin_amdgcn_s_setprio(1); _Pragma("unroll") for (int m = 0; m < 4; ++m) _Pragma("unroll") for (int n = 0; n < 2; ++n) _Pragma("unroll") for (int k = 0; k < 2; ++k) \
        acc[ai][bj][m][n] = __builtin_amdgcn_mfma_f32_16x16x32_bf16(Bt[n][k], At[m][k], acc[ai][bj][m][n], 0, 0, 0); __builtin_amdgcn_s_setprio(0); } while (0)
#define PG8_WAIT_V(n) asm volatile("s_waitcnt vmcnt(" #n ")" ::: "memory")
#define PG8_WAIT_L(n) asm volatile("s_waitcnt lgkmcnt(" #n ")" ::: "memory")
#define PG8_BAR __builtin_amdgcn_s_barrier()
#define PG8_SCHED __builtin_amdgcn_sched_barrier(0)
    Unit cur, nxt; int ui = 0;
    if (!S.next(0, cur)) return;
    f32x4 acc[2][2][4][2];
#pragma unroll
    for (int a = 0; a < 2; ++a)
#pragma unroll
        for (int b = 0; b < 2; ++b)
#pragma unroll
            for (int m = 0; m < 4; ++m)
#pragma unroll
                for (int n = 0; n < 2; ++n) acc[a][b][m][n] = (f32x4){0.f, 0.f, 0.f, 0.f};
    bf16x8 At[4][2], B0[2][2], B1[2][2];
    const char* cA = (const char*)g.A + (size_t)cur.pm * tstep + (size_t)cur.k0 * 2; const char* cB = (const char*)g.Bt + (size_t)cur.pn * tstep + (size_t)cur.k0 * 2;
    S.a_ready(cur);
    if constexpr (SP2) {
        PG8_STAGE(PG8_SB(0, 0), cB, voffB); PG8_STAGE(PG8_SB(0, 1), cB + hstep, voffB); PG8_STAGE(PG8_SA(0, 0), cA, voffA); PG8_STAGE(PG8_SA(0, 1), cA + hstep, voffA);
        if (wr == 1) PG8_BAR;
        PG8_WAIT_V(2); PG8_BAR;
        PG8_STAGE(PG8_SB(1, 0), cB + kstep, voffB); PG8_STAGE(PG8_SA(1, 0), cA + kstep, voffA); PG8_STAGE(PG8_SB(1, 1), cB + hstep + kstep, voffB);
        PG8_WAIT_V(6); PG8_BAR;
    } else {
        PG8_STAGE(PG8_SB(0, 0), cB, voffB); PG8_STAGE(PG8_SA(0, 0), cA, voffA); PG8_STAGE(PG8_SB(0, 1), cB + hstep, voffB); PG8_STAGE(PG8_SA(0, 1), cA + hstep, voffA);
        if (wr == 1) PG8_BAR;
        PG8_WAIT_V(4); PG8_BAR;
        PG8_STAGE(PG8_SB(1, 0), cB + kstep, voffB); PG8_STAGE(PG8_SA(1, 0), cA + kstep, voffA); PG8_STAGE(PG8_SB(1, 1), cB + hstep + kstep, voffB);
        PG8_WAIT_V(6); PG8_BAR;
    }
    for (;;) {
        const bool has_next = S.next(ui + 1, nxt);
        const char* nA = has_next ? (const char*)g.A + (size_t)nxt.pm * tstep + (size_t)nxt.k0 * 2 : cA; const char* nB = has_next ? (const char*)g.Bt + (size_t)nxt.pn * tstep + (size_t)nxt.k0 * 2 : cB;
        const int nt = cur.nt;
        for (int t = 0; t < nt; t += 2) {
            const bool last = (t == nt - 2);
            const char* a1 = cA + (size_t)(t + 1) * kstep;
            const char* a2 = last ? nA : cA + (size_t)(t + 2) * kstep; const char* b2 = last ? nB : cB + (size_t)(t + 2) * kstep;
            const char* a3 = a2 + kstep; const char* b3 = b2 + kstep;
            if (last && has_next) S.a_ready(nxt);
            if constexpr (SP2) {
            PG8_LDB(B0, 0, 0); PG8_LDB(B1, 0, 1); PG8_SCHED; PG8_LDA(At, 0, 0); PG8_STAGE(PG8_SA(1, 1), a1 + hstep, voffA);
            PG8_WAIT_V(8); PG8_WAIT_L(0); PG8_BAR; PG8_MMA(0, 0, At, B0); PG8_MMA(0, 1, At, B1); PG8_BAR; PG8_SCHED;
            PG8_LDA(At, 0, 1); PG8_STAGE(PG8_SB(0, 0), b2, voffB); PG8_STAGE(PG8_SB(0, 1), b2 + hstep, voffB); PG8_STAGE(PG8_SA(0, 0), a2, voffA);
            PG8_WAIT_V(8); PG8_WAIT_L(0); PG8_BAR; PG8_MMA(1, 0, At, B0); PG8_MMA(1, 1, At, B1); PG8_BAR; PG8_SCHED;
            PG8_LDB(B0, 1, 0); PG8_LDB(B1, 1, 1); PG8_SCHED; PG8_LDA(At, 1, 0); PG8_STAGE(PG8_SA(0, 1), a2 + hstep, voffA);
            PG8_WAIT_V(8); PG8_WAIT_L(0); PG8_BAR; PG8_MMA(0, 0, At, B0); PG8_MMA(0, 1, At, B1); PG8_BAR; PG8_SCHED;
            PG8_LDA(At, 1, 1); PG8_STAGE(PG8_SB(1, 0), b3, voffB); PG8_STAGE(PG8_SB(1, 1), b3 + hstep, voffB); PG8_STAGE(PG8_SA(1, 0), a3, voffA);
            PG8_WAIT_V(8); PG8_WAIT_L(0); PG8_BAR; PG8_MMA(1, 0, At, B0); PG8_MMA(1, 1, At, B1); PG8_BAR; PG8_SCHED;
            } else {
            PG8_LDB(B0, 0, 0); PG8_SCHED; PG8_LDA(At, 0, 0); PG8_STAGE(PG8_SA(1, 1), a1 + hstep, voffA);
            PG8_WAIT_L(8); PG8_BAR; PG8_WAIT_L(0); PG8_MMA(0, 0, At, B0); PG8_BAR; PG8_SCHED;
            PG8_LDB(B1, 0, 1); PG8_STAGE(PG8_SB(0, 0), b2, voffB);
            PG8_BAR; PG8_WAIT_L(0); PG8_MMA(0, 1, At, B1); PG8_BAR;
            PG8_LDA(At, 0, 1); PG8_STAGE(PG8_SA(0, 0), a2, voffA);
            PG8_BAR; PG8_WAIT_L(0); PG8_MMA(1, 0, At, B0); PG8_BAR; PG8_SCHED;
            PG8_STAGE(PG8_SB(0, 1), b2 + hstep, voffB);
            PG8_WAIT_V(6); PG8_BAR; PG8_MMA(1, 1, At, B1); PG8_BAR;
            PG8_LDB(B0, 1, 0); PG8_SCHED; PG8_LDA(At, 1, 0); PG8_STAGE(PG8_SA(0, 1), a2 + hstep, voffA);
            PG8_WAIT_L(8); PG8_BAR; PG8_WAIT_L(0); PG8_MMA(0, 0, At, B0); PG8_BAR; PG8_SCHED;
            PG8_LDB(B1, 1, 1); PG8_STAGE(PG8_SB(1, 0), b3, voffB);
            PG8_BAR; PG8_WAIT_L(0); PG8_MMA(0, 1, At, B1); PG8_BAR;
            PG8_LDA(At, 1, 1); PG8_STAGE(PG8_SA(1, 0), a3, voffA);
            PG8_BAR; PG8_WAIT_L(0); PG8_MMA(1, 0, At, B0); PG8_BAR; PG8_SCHED;
            PG8_STAGE(PG8_SB(1, 1), b3 + hstep, voffB);
            PG8_WAIT_V(6); PG8_BAR; PG8_MMA(1, 1, At, B1); PG8_BAR;
            }
        }
        if constexpr (ALIGN_EPI) { if (wr == 0) PG8_BAR; }
        if constexpr (!Epi::AFTER_DRAIN) { E(acc, cur, wr, wc, fr, fq); S.done(cur); }
        if (!has_next) break;
#pragma unroll
        for (int a = 0; a < 2; ++a)
#pragma unroll
            for (int b = 0; b < 2; ++b)
#pragma unroll
                for (int m = 0; m < 4; ++m)
#pragma unroll
                    for (int n = 0; n < 2; ++n) acc[a][b][m][n] = (f32x4){0.f, 0.f, 0.f, 0.f};
        cur = nxt; cA = nA; cB = nB; ++ui;
        if constexpr (ALIGN_EPI) { if (wr == 1) PG8_BAR; }
    }
    PG8_WAIT_V(0);
    if constexpr (!ALIGN_EPI) { if (wr == 0) PG8_BAR; }
    PG8_BAR;
    if constexpr (Epi::AFTER_DRAIN) { E.fused(acc, cur, wr, wc, fr, fq, lds, wid, lane); S.done(cur); }
#undef PG8_SA
#undef PG8_SB
#undef PG8_STAGE
#undef PG8_LDA
#undef PG8_LDB
#undef PG8_MMA
#undef PG8_WAIT_V
#undef PG8_WAIT_L
#undef PG8_BAR
#undef PG8_SCHED
}
}
#ifndef MK_PER_PHASE
#define MK_PER_PHASE 0
#endif
constexpr int DM = 2048, NBATCH = 2, SEQ = 4096, DEPTH = 4, CTXL = 256, DFF = 5632, DIN = 2816;
constexpr int R_LAT = NBATCH * SEQ, R_CTX = NBATCH * CTXL, R = R_LAT + R_CTX;
constexpr int K_OFF = 0, V_OFF = 128, SSM_OFF = 256, Q_OFF = 768, CONV_OFF = 1280, FFT_OFF = 2304;
constexpr int MODW = 9 * DM;
constexpr int NWAVES = 8, NTHR = 512;
constexpr int MOD_CHUNKS = 32;

constexpr size_t MiB = 1u << 20;
constexpr size_t WS_CTL = 0, CTL_ZERO_BYTES = 1 * MiB;
constexpr size_t WS_MOD = 1 * MiB;
constexpr size_t WS_ROPE = 2 * MiB;
constexpr size_t WS_TW = WS_ROPE + 65536;
constexpr size_t WS_SSMA = WS_ROPE + 131072;
constexpr size_t WS_SSMBB = 3 * MiB;
constexpr size_t WS_SSMCT = 5 * MiB;
constexpr size_t WS_WFOLD = 7 * MiB;
constexpr size_t WS_MODP = 23 * MiB;
constexpr size_t WS_WI = 50 * MiB;
constexpr size_t WS_WO = WS_WI + 352 * MiB;
constexpr size_t WS_WIN = WS_WO + 176 * MiB;
constexpr size_t WS_WOUT = WS_WIN + 44 * MiB;
constexpr size_t WS_X = WS_WOUT + 32 * MiB;
constexpr size_t WS_H = WS_X + 68 * MiB;
constexpr size_t WS_ACT = WS_H + 34 * MiB;
constexpr size_t WS_Y = WS_ACT + 94 * MiB;
constexpr size_t WS_P = WS_Y + 68 * MiB;
constexpr size_t WS_CAT = WS_P + 47 * MiB;
constexpr size_t WS_SSMWS = WS_CAT + 34 * MiB;
constexpr size_t WS_SSMWY = WS_SSMWS + 16 * MiB;
constexpr size_t WS_SSMS = WS_SSMWY + 32 * MiB;
constexpr size_t WS_POW = WS_SSMS + 17 * MiB;
constexpr size_t WS_YG = WS_POW + 9 * MiB;
constexpr size_t WS_GLUW = WS_YG + 9 * MiB;
constexpr size_t WS_A16 = WS_GLUW + 2 * MiB;
constexpr size_t WS_ET = WS_A16 + 256 * 1024;
constexpr size_t WS_YP = WS_A16 + 1 * MiB;
constexpr size_t WS_COMB = WS_YP + 44 * MiB;
constexpr size_t WS_END = WS_COMB + 1 * MiB;
constexpr int NCR = R / 16;
constexpr int CW_CONVQ = 10240, CW_DONE = 12288;
constexpr int CW_QUEUE = 8192;
constexpr int CW_BAR = 4096;

constexpr int RING_BYTES = 131072;
constexpr int MISC_OFF = 147456 - 256;
constexpr int LDS_BYTES = 147456;

#define GAS __attribute__((address_space(1)))
#define LAS __attribute__((address_space(3)))
typedef unsigned short bf16;
typedef unsigned v4u __attribute__((ext_vector_type(4)));
typedef unsigned v2u __attribute__((ext_vector_type(2)));
typedef float f32x4 __attribute__((ext_vector_type(4)));
typedef float f32x2 __attribute__((ext_vector_type(2)));
#define LDS_WAIT() asm volatile("s_waitcnt lgkmcnt(0)" ::: "memory")
#define VM_WAIT() asm volatile("s_waitcnt vmcnt(0)" ::: "memory")
typedef float f32x2cv __attribute__((ext_vector_type(2))); typedef __bf16 bf16x2cv __attribute__((ext_vector_type(2)));
__device__ __forceinline__ unsigned pk2(float lo, float hi) { const f32x2cv v = {lo, hi}; return __builtin_bit_cast(unsigned, __builtin_convertvector(v, bf16x2cv)); }
__device__ __forceinline__ unsigned f2bf(float f) { return pk2(f, 0.0f) & 0xffffu; }
__device__ __forceinline__ float bflo(unsigned w) { return __builtin_bit_cast(float, w << 16); }
__device__ __forceinline__ float bfhi(unsigned w) { return __builtin_bit_cast(float, w & 0xffff0000u); }
__device__ __forceinline__ float bf1(bf16 v) { return __builtin_bit_cast(float, (unsigned)v << 16); }
__device__ __forceinline__ float sigmoidf_(float x) { return __builtin_amdgcn_rcpf(1.0f + __expf(-x)); }
__device__ __forceinline__ float wave_sum(float v) {
#pragma unroll
    for (int o = 1; o < 64; o <<= 1) v += __shfl_xor(v, o);
    return v;
}

#define XB_TMO      128
#define XB_XCNT(j)  (256  + 64 * (j))
#define XB_XSUB(j)  (1280 + 64 * (j))
#define XB_XGEN(j)  (2304 + 64 * (j))
#define XB_TOP      3328
#define XB_TOPGEN   3392
#define XCD_BAR_WORDS 3456
#define XB_SPIN_CAP (1u << 18)

__device__ __forceinline__ unsigned xb_ld(unsigned* p)              { return __hip_atomic_load(p, __ATOMIC_RELAXED, __HIP_MEMORY_SCOPE_AGENT); }
__device__ __forceinline__ unsigned xb_add(unsigned* p, unsigned v) { return __hip_atomic_fetch_add(p, v, __ATOMIC_RELAXED, __HIP_MEMORY_SCOPE_AGENT); }
__device__ __forceinline__ unsigned xb_xcc_id() { return (unsigned)__builtin_amdgcn_s_getreg((3 << 11) | 20) & 0xFu; }
#define XB_SPIN(cond, bar) do { unsigned _sp = 0; while (cond) { __builtin_amdgcn_s_sleep(1); \
    if ((++_sp & 255u) == 0u) { if (xb_ld(&(bar)[XB_TMO])) break; if (_sp > XB_SPIN_CAP) { atomicAdd(&(bar)[XB_TMO], 1u); break; } } } } while (0)

struct XcdBarrier {
    unsigned* bar; unsigned x;
    volatile LAS unsigned* st;
};

__device__ __forceinline__ XcdBarrier xcd_barrier_post(unsigned* bar, volatile LAS unsigned* st) {
    XcdBarrier b; b.bar = bar; b.x = xb_xcc_id(); b.st = st;
    if (threadIdx.x == 0) (void)xb_add(&bar[XB_XCNT(b.x)], 1u);
    return b;
}
__device__ __forceinline__ void xcd_barrier_complete(unsigned* bar, unsigned x, unsigned& nloc, unsigned& nx) {
    const unsigned G = gridDim.x * gridDim.y * gridDim.z;
    unsigned sum, cnt, mine, sp = 0u;
    for (;;) {
        sum = 0u; cnt = 0u; mine = 0u;
#pragma unroll
        for (unsigned j = 0; j < 16; ++j) { const unsigned c = xb_ld(&bar[XB_XCNT(j)]); sum += c; cnt += (c > 0u) ? 1u : 0u; mine = (j == x) ? c : mine; }
        if (sum == G) break;
        __builtin_amdgcn_s_sleep(1);
        if ((++sp & 255u) == 0u) { if (xb_ld(&bar[XB_TMO])) break; if (sp > XB_SPIN_CAP) { atomicAdd(&bar[XB_TMO], 1u); break; } }
    }
    nloc = mine > 0u ? mine : 1u; nx = cnt > 0u ? cnt : 1u;
}

__device__ __forceinline__ void xcd_barrier(const XcdBarrier& b) {
    asm volatile("s_waitcnt vmcnt(0)" ::: "memory");
    __syncthreads();
    if (threadIdx.x == 0) {
        unsigned* bar = b.bar;
        __builtin_amdgcn_s_waitcnt(0);
        unsigned nloc = b.st[0], nx = b.st[1];
        if (nloc == 0u) { xcd_barrier_complete(bar, b.x, nloc, nx); b.st[0] = nloc; b.st[1] = nx; }
        const unsigned old = xb_add(&bar[XB_XSUB(b.x)], 1u);
        const unsigned gen = old / nloc;
        if (old + 1u == (gen + 1u) * nloc) {
            __builtin_amdgcn_fence(__ATOMIC_RELEASE, "agent");
            asm volatile("s_waitcnt vmcnt(0)" ::: "memory");
            const unsigned og = xb_add(&bar[XB_TOP], 1u);
            const unsigned tg = og / nx;
            if (og + 1u == (tg + 1u) * nx) xb_add(&bar[XB_TOPGEN], 1u);
            else XB_SPIN(xb_ld(&bar[XB_TOPGEN]) == tg, bar);
            __builtin_amdgcn_fence(__ATOMIC_ACQUIRE, "agent");
            xb_add(&bar[XB_XGEN(b.x)], 1u);
            asm volatile("s_waitcnt vmcnt(0)" ::: "memory");
        } else {
            XB_SPIN(xb_ld(&bar[XB_XGEN(b.x)]) == gen, bar);
            __builtin_amdgcn_fence(__ATOMIC_ACQUIRE, "agent");
            asm volatile("s_waitcnt vmcnt(0)" ::: "memory");
        }
    }
    __syncthreads();
}

struct Frame {
    LAS unsigned char* lds;
    int tid, lane, wave, G, bid;
    float* out; unsigned char* ws;
};
struct Args { const float* in[26]; float* out; unsigned char* ws; int ph_lo, ph_hi; };
enum { I_X = 0, I_C, I_CTX, I_CCTX, I_WMOD, I_BMOD, I_NORMG, I_WI, I_WO, I_WIN, I_WOUT, I_SINK, I_LAMRE, I_LAMIM, I_LOGDT, I_BRE, I_BIM, I_CRE, I_CIM, I_SSMD, I_GLUW, I_GLUB,
       I_CONVW, I_CONVB, I_LNG, I_LNB };

constexpr int TR_STRIDE = 65, TR_WAVE_BYTES = 64 * TR_STRIDE * 4;
#ifndef TR_NT
#define TR_NT 1
#endif
struct TrItem { const float* src; bf16* dst; int ldw, K; };
__device__ __forceinline__ void tr_load(const TrItem& t, f32x4 (&v)[16], int lane) {
    const int rr = lane >> 4, c4 = (lane & 15) * 4;
#pragma unroll
    for (int i = 0; i < 16; ++i) v[i] = TR_NT ? __builtin_nontemporal_load((const f32x4*)(t.src + (size_t)(4 * i + rr) * t.ldw + c4)) : *(const f32x4*)(t.src + (size_t)(4 * i + rr) * t.ldw + c4);
}
__device__ __forceinline__ void tr_store(const TrItem& t, const f32x4 (&v)[16], LAS float* scr, int lane) {
    const int rr = lane >> 4, c4 = (lane & 15) * 4;
#pragma unroll
    for (int i = 0; i < 16; ++i) { LAS float* d = scr + (4 * i + rr) * TR_STRIDE + c4; d[0] = v[i].x; d[1] = v[i].y; d[2] = v[i].z; d[3] = v[i].w; }
    LDS_WAIT(); asm volatile("" ::: "memory");
    const int c = lane & 7;
#pragma unroll
    for (int j = 0; j < 8; ++j) { const int n = (lane >> 3) + 8 * j; const LAS float* s = scr + (8 * c) * TR_STRIDE + n;
        v4u o; o.x = pk2(s[0 * TR_STRIDE], s[1 * TR_STRIDE]); o.y = pk2(s[2 * TR_STRIDE], s[3 * TR_STRIDE]); o.z = pk2(s[4 * TR_STRIDE], s[5 * TR_STRIDE]); o.w = pk2(s[6 * TR_STRIDE], s[7 * TR_STRIDE]);
        if (TR_NT) __builtin_nontemporal_store(o, (v4u*)(t.dst + (size_t)n * t.K + 8 * c)); else *(GAS v4u*)(t.dst + (size_t)n * t.K + 8 * c) = o; }
    LDS_WAIT(); asm volatile("" ::: "memory");
}
__device__ __forceinline__ void transpose_item(const float* W, int ldw, int k0, int n0, bf16* WT, int K, int drow0, LAS float* scr, int lane) {
    TrItem t{W + (size_t)k0 * ldw + n0, WT + (size_t)drow0 * K + k0, ldw, K}; f32x4 v[16]; tr_load(t, v, lane); tr_store(t, v, scr, lane);
}

constexpr int CV_WI = 32 * 176, CV_WO = 88 * 32, CV_WOUT = 32 * 32, CV_WIN = 32 * 36, CV_GLU = 8 * 8, CV_FOLD = 32 * 8;
constexpr int CV_NOFOLD = 2 * CV_WI + 2 * CV_WO + CV_WOUT + CV_WIN + CV_GLU, CV_TILES = CV_NOFOLD + CV_FOLD, CV_ITEMS = CV_TILES / 8;
static_assert(CV_TILES % 8 == 0, "workgroup items of 8 wave tiles");
__device__ __forceinline__ void conv_decode(const Args& AR, unsigned char* ws, int L, int it, TrItem& t) {
    int r = it;
    if (r < 2 * CV_WI) { const int mat = L * 2 + r / CV_WI, q = r % CV_WI, kb = q / 176, nb = q % 176, n0 = nb * 64, half = n0 / DFF, j = n0 % DFF, drow = (j / 128) * 256 + half * 128 + (j % 128);
        t.src = AR.in[I_WI] + (size_t)mat * DM * 2 * DFF + (size_t)(kb * 64) * (2 * DFF) + n0; t.dst = (bf16*)(ws + WS_WI) + (size_t)mat * 2 * DFF * DM + (size_t)drow * DM + kb * 64; t.ldw = 2 * DFF; t.K = DM; return; }
    r -= 2 * CV_WI;
    if (r < 2 * CV_WO) { const int mat = L * 2 + r / CV_WO, q = r % CV_WO, kb = q / 32, nb = q % 32;
        t.src = AR.in[I_WO] + (size_t)mat * DFF * DM + (size_t)(kb * 64) * DM + nb * 64; t.dst = (bf16*)(ws + WS_WO) + (size_t)mat * DM * DFF + (size_t)(nb * 64) * DFF + kb * 64; t.ldw = DM; t.K = DFF; return; }
    r -= 2 * CV_WO;
    if (r < CV_WOUT) { const int kb = r / 32, nb = r % 32;
        t.src = AR.in[I_WOUT] + (size_t)L * DM * DM + (size_t)(kb * 64) * DM + nb * 64; t.dst = (bf16*)(ws + WS_WOUT) + (size_t)L * DM * DM + (size_t)(nb * 64) * DM + kb * 64; t.ldw = DM; t.K = DM; return; }
    r -= CV_WOUT;
    if (r < CV_WIN) { const int kb = r / 36, nb = r % 36;
        t.src = AR.in[I_WIN] + (size_t)L * DM * DIN + (size_t)(kb * 64) * DIN + nb * 64; t.dst = (bf16*)(ws + WS_WIN) + (size_t)L * DIN * DM + (size_t)(nb * 64) * DM + kb * 64; t.ldw = DIN; t.K = DM; return; }
    r -= CV_WIN;
    if (r < CV_GLU) { const int kb = r / 8, nb = r % 8;
        t.src = AR.in[I_GLUW] + (size_t)L * 512 * 512 + (size_t)(kb * 64) * 512 + nb * 64; t.dst = (bf16*)(ws + WS_GLUW) + (size_t)L * 512 * 512 + (size_t)(nb * 64) * 512 + kb * 64; t.ldw = 512; t.K = 512; return; }
    r -= CV_GLU;
    { const int kb = r / 8, nb = r % 8;
        t.src = (const float*)(ws + WS_WFOLD) + (size_t)L * DM * 512 + (size_t)(kb * 64) * 512 + nb * 64; t.dst = (bf16*)(ws + WS_WIN) + (size_t)L * DIN * DM + (size_t)(FFT_OFF + nb * 64) * DM + kb * 64; t.ldw = 512; t.K = DM; }
}
__device__ __forceinline__ void bg_static(Frame& F, const Args& AR, int L, int first, int n, int stride) {
    __syncthreads();
    LAS float* scr = (LAS float*)(F.lds + F.wave * TR_WAVE_BYTES);
    int it = first, left = n;
    if (left <= 0 || it >= CV_ITEMS) return;
    TrItem cur; conv_decode(AR, F.ws, L, it * 8 + F.wave, cur); f32x4 va[16]; tr_load(cur, va, F.lane);
#pragma unroll 1
    for (;;) {
        const int nx = it + stride; const bool more = left > 1 && nx < CV_ITEMS;
        TrItem nxt = cur; f32x4 vb[16];
        if (more) { conv_decode(AR, F.ws, L, nx * 8 + F.wave, nxt); tr_load(nxt, vb, F.lane); }
        tr_store(cur, va, scr, F.lane);
        if (!more) break;
#pragma unroll
        for (int i = 0; i < 16; ++i) va[i] = vb[i];
        cur = nxt; it = nx; --left;
    }
}
constexpr int BG_UP = 8, BG_IN = 7, BG_DN = 1, BG_OUT = 1, BG_CA = 0;
constexpr int BGB_UP1 = 0, BGB_UP2 = BGB_UP1 + 40 * BG_UP, BGB_IN = BGB_UP2 + 40 * BG_UP, BGB_DN1 = BGB_IN + 138 * BG_IN, BGB_DN2 = BGB_DN1 + 80 * BG_DN, BGB_OUT = BGB_DN2 + 80 * BG_DN,
              BGB_CA = BGB_OUT + 192 * BG_OUT, BGB_REST = BGB_CA + 128 * BG_CA;
static_assert(BGB_REST <= CV_ITEMS, "background item map");
__device__ __forceinline__ void bg_site(Frame& F, const Args& AR, int L, int base, int c0, int n) {
    if (F.G == 256 && F.bid >= c0) bg_static(F, AR, L, base + (F.bid - c0) * n, n, 1);
}
__device__ __forceinline__ void bg_drain(Frame& F, const Args& AR, int L) {
    const int base = F.G == 256 ? BGB_REST : 0;
    bg_static(F, AR, L, base + F.bid, (CV_ITEMS - base - F.bid + F.G - 1) / F.G, F.G);
}

__device__ __forceinline__ void p0a(Frame& F, const Args& AR) {
    unsigned char* ws = F.ws;
    const int gw = F.bid * NWAVES + F.wave, NGW = F.G * NWAVES;
    const int gt = F.bid * NTHR + F.tid, NGT = F.G * NTHR;
    {
        float* rope = (float*)(ws + WS_ROPE);
        for (int i = gt; i < 64 * 16; i += NGT) { const int pos = i >> 4, j = i & 15;
            const double inv = exp(-(double)j * (9.210340371976184 / 16.0)); const double t = (double)pos * inv * 0.15915494309189535; const double fr = t - rint(t);
            rope[2 * i] = (float)cospi(2.0 * fr); rope[2 * i + 1] = (float)sinpi(2.0 * fr); }
        float* tw = (float*)(ws + WS_TW);
        for (int i = gt; i < 4096; i += NGT) { const double fr = (double)i / 4096.0; tw[2 * i] = (float)cospi(2.0 * fr); tw[2 * i + 1] = (float)(-sinpi(2.0 * fr)); }
        float* sa = (float*)(ws + WS_SSMA); float* sbb = (float*)(ws + WS_SSMBB);
        for (int i = gt; i < DEPTH * 2 * 32 * 64; i += NGT) {
            const int ldg = i >> 6;
            const double lr = fmin((double)AR.in[I_LAMRE][i], -1e-4), li = (double)AR.in[I_LAMIM][i], dt = exp((double)AR.in[I_LOGDT][ldg]);
            const double mag = exp(lr * dt); const double t = li * dt * 0.15915494309189535; const double fr = t - rint(t);
            const double are = mag * cospi(2.0 * fr), aim = mag * sinpi(2.0 * fr);
            const double den = lr * lr + li * li, nr = are - 1.0;
            const double cre = (nr * lr + aim * li) / den, cim = (aim * lr - nr * li) / den;
            sa[2 * i] = (float)are; sa[2 * i + 1] = (float)aim;
            { const double mag16 = exp(lr * dt * 16.0); const double t16 = li * dt * 16.0 * 0.15915494309189535; const double f16 = t16 - rint(t16);
              const double ar16 = mag16 * cospi(2.0 * f16), ai16 = mag16 * sinpi(2.0 * f16);
              float* a16 = (float*)(ws + WS_A16); a16[2 * i] = (float)ar16; a16[2 * i + 1] = (float)ai16;
              float* pw = (float*)(ws + WS_POW) + ((size_t)ldg * 65 * 64 + (i & 63)) * 2;
              double pr = 1.0, pi = 0.0;
              for (int k = 0; k <= 64; ++k) { pw[(size_t)k * 128] = (float)pr; pw[(size_t)k * 128 + 1] = (float)pi; const double nr = pr * ar16 - pi * ai16, ni = pr * ai16 + pi * ar16; pr = nr; pi = ni; } }
            for (int h = 0; h < 16; ++h) { const double br = (double)AR.in[I_BRE][(size_t)i * 16 + h], bi = (double)AR.in[I_BIM][(size_t)i * 16 + h];
                sbb[((size_t)i * 16 + h) * 2] = (float)(cre * br - cim * bi); sbb[((size_t)i * 16 + h) * 2 + 1] = (float)(cre * bi + cim * br); }
        }
        float* sct = (float*)(ws + WS_SSMCT);
        for (int i = gt; i < DEPTH * 2 * 64 * 512; i += NGT) { const int ch = i & 511, p = (i >> 9) & 63, ld = i >> 15;
            const size_t src = ((size_t)ld * 512 + ch) * 64 + p; sct[2 * (size_t)i] = AR.in[I_CRE][src]; sct[2 * (size_t)i + 1] = AR.in[I_CIM][src]; }
    }
    {
        LAS float* sv = (LAS float*)F.lds;
        for (int i = F.tid; i < 3 * DM; i += NTHR) { const int v = i / DM, d = i % DM; const float c = v < 2 ? AR.in[I_C][v * DM + d] : AR.in[I_CCTX][d]; sv[i] = c * sigmoidf_(c); }
        __syncthreads();
        float* modp = (float*)(ws + WS_MODP);
        constexpr int DCH = DM / MOD_CHUNKS;
        for (int it = F.bid; it < DEPTH * 9 * MOD_CHUNKS; it += F.G) {
            const int ch = it % MOD_CHUNKS, lj = it / MOD_CHUNKS, jg = lj % 9, l = lj / 9;
            const float* wp = AR.in[I_WMOD] + ((size_t)l * DM + (size_t)ch * DCH) * MODW + jg * 2048 + F.tid * 4;
            f32x4 a0 = {0.f, 0.f, 0.f, 0.f}, a1 = a0, a2 = a0;
#pragma unroll 8
            for (int d = 0; d < DCH; ++d) { const f32x4 w = __builtin_nontemporal_load((const f32x4*)(wp + (size_t)d * MODW)); const int dd = ch * DCH + d;
                a0 += w * sv[dd]; a1 += w * sv[DM + dd]; a2 += w * sv[2 * DM + dd]; }
            float* o = modp + ((size_t)(ch * DEPTH + l) * 3) * MODW + jg * 2048 + F.tid * 4;
            *(f32x4*)(o) = a0; *(f32x4*)(o + MODW) = a1; *(f32x4*)(o + 2 * MODW) = a2;
        }
        __syncthreads();
    }
    {
        LAS float* scr = (LAS float*)(F.lds + F.wave * 16384);
        scr[F.lane] = cospif((float)F.lane * (1.0f / 64.0f)); scr[F.lane + 64] = cospif((float)(F.lane + 64) * (1.0f / 64.0f));
        float* wf = (float*)(ws + WS_WFOLD);
        for (int it = gw; it < DEPTH * DM * 4; it += NGW) {
            const int h = it & 3, ld = it >> 2;
            const float* src = AR.in[I_WIN] + (size_t)ld * DIN + FFT_OFF + 128 * h;
            LDS_WAIT(); asm volatile("" ::: "memory");
            scr[128 + F.lane] = src[F.lane]; scr[192 + F.lane] = src[F.lane + 64];
            LDS_WAIT(); asm volatile("" ::: "memory");
#pragma unroll
            for (int q = 0; q < 2; ++q) { const int jj = F.lane + 64 * q, mp = jj >> 1, odd = jj & 1;
                const int mult = mp == 0 ? (odd ? 64 : 0) : mp, shift = (mp != 0 && odd) ? 96 : 0; const float sgn = (mp != 0 && odd) ? -1.f : 1.f;
                float s = 0.f;
                for (int c = 0; c < 128; ++c) s += scr[128 + c] * scr[(mult * c + shift) & 127];
                wf[(size_t)ld * 512 + 128 * h + jj] = s * sgn; }
        }
        LDS_WAIT(); asm volatile("" ::: "memory");
    }
    {
        __syncthreads();
        LAS float* scr = (LAS float*)(F.lds + F.wave * TR_WAVE_BYTES);
        constexpr int NIT = CV_NOFOLD;
        auto decode = [&](int it, TrItem& t) { conv_decode(AR, ws, 0, it, t); };
        int it = gw;
        if (it < NIT) {
            TrItem cur; decode(it, cur); f32x4 va[16]; tr_load(cur, va, F.lane);
#pragma unroll 1
            for (;;) {
                const int nx = it + NGW; const bool more = nx < NIT;
                TrItem nxt = cur; f32x4 vb[16];
                if (more) { decode(nx, nxt); tr_load(nxt, vb, F.lane); }
                tr_store(cur, va, scr, F.lane);
                if (!more) break;
#pragma unroll
                for (int i = 0; i < 16; ++i) va[i] = vb[i];
                cur = nxt; it = nx;
            }
        }
    }
}
__device__ __forceinline__ void ssm_build_mats(Frame& F, const Args& AR, int item2) {
    const int item = item2 >> 1, half = item2 & 1;
    const int l = item >> 5, g = item & 31;
    LAS float* apow = (LAS float*)F.lds;
    LAS float* cc = apow + 2 * 17 * 64 * 2;
    LAS float* bb = cc + 4096;
    LAS float* kt = bb + 4096;
    const float* ssmbb = (const float*)(F.ws + WS_SSMBB);
    __syncthreads();
    for (int i = F.tid; i < 2 * 17 * 64; i += NTHR) { const int p = i & 63, j = (i >> 6) % 17, dir = i / (17 * 64);
        const int idx = ((l * 2 + dir) * 32 + g) * 64 + p;
        const double lr = fmin((double)AR.in[I_LAMRE][idx], -1e-4), li = (double)AR.in[I_LAMIM][idx], dt = exp((double)AR.in[I_LOGDT][(l * 2 + dir) * 32 + g]);
        const double mag = exp(lr * dt * (double)j); const double t = li * dt * (double)j * 0.15915494309189535; const double fr = t - rint(t);
        apow[2 * i] = (float)(mag * cospi(2.0 * fr)); apow[2 * i + 1] = (float)(mag * sinpi(2.0 * fr)); }
    for (int i = F.tid; i < 2 * 16 * 64; i += NTHR) { const int p = i & 63, h = (i >> 6) & 15, dir = i >> 10;
        const size_t src = ((size_t)((l * 2 + dir) * 32 + g) * 16 + h) * 64 + p;
        cc[2 * i] = AR.in[I_CRE][src]; cc[2 * i + 1] = AR.in[I_CIM][src]; }
    for (int i = F.tid; i < 2 * 64 * 16; i += NTHR) { const int h = i & 15, p = (i >> 4) & 63, dir = i >> 10;
        const size_t src = ((size_t)((l * 2 + dir) * 32 + g) * 64 + p) * 16 + h;
        bb[2 * i] = ssmbb[2 * src]; bb[2 * i + 1] = ssmbb[2 * src + 1]; }
    __syncthreads();
    for (int i = F.tid; i < 8192; i += NTHR) { const int h = i & 15, hp = (i >> 4) & 15, j = (i >> 8) & 15, dir = i >> 12;
        float s = 0.f;
        for (int p = 0; p < 64; ++p) { const LAS float* c = cc + ((dir * 16 + hp) * 64 + p) * 2; const LAS float* a = apow + ((dir * 17 + j) * 64 + p) * 2; const LAS float* b = bb + ((dir * 64 + p) * 16 + h) * 2;
            const float car = c[0] * a[0] - c[1] * a[1], cai = c[0] * a[1] + c[1] * a[0]; s += car * b[0] - cai * b[1]; }
        kt[i] = s; }
    __syncthreads();
    bf16* wy = (bf16*)(F.ws + WS_SSMWY) + (size_t)item * 256 * 512;
    for (int e = half * 128 * 64 + F.tid; e < (half + 1) * 128 * 64; e += NTHR) { const int n = e >> 6, k0 = (e & 63) * 8, i = n >> 4, hp = n & 15;
        float v[8];
#pragma unroll
        for (int t = 0; t < 8; ++t) { const int k = k0 + t; float val;
            if (k < 256) { const int ip = k >> 4, h = k & 15; val = 0.f;
                if (ip <= i) val += kt[((0 * 16 + (i - ip)) * 16 + hp) * 16 + h];
                if (ip >= i) val += kt[((1 * 16 + (ip - i)) * 16 + hp) * 16 + h];
                if (ip == i && h == hp) val += AR.in[I_SSMD][l * 512 + g * 16 + h]; }
            else { const int kk = k - 256, dir = kk >> 7, part = (kk >> 6) & 1, p = kk & 63, ee = dir == 0 ? i + 1 : 16 - i;
                const LAS float* c = cc + ((dir * 16 + hp) * 64 + p) * 2; const LAS float* a = apow + ((dir * 17 + ee) * 64 + p) * 2;
                val = part == 0 ? c[0] * a[0] - c[1] * a[1] : -(c[0] * a[1] + c[1] * a[0]); }
            v[t] = val; }
        v4u o; o.x = pk2(v[0], v[1]); o.y = pk2(v[2], v[3]); o.z = pk2(v[4], v[5]); o.w = pk2(v[6], v[7]);
        *(v4u*)(wy + (size_t)n * 512 + k0) = o; }
    bf16* wsm = (bf16*)(F.ws + WS_SSMWS) + (size_t)item * 256 * 256;
    for (int e = half * 128 * 32 + F.tid; e < (half + 1) * 128 * 32; e += NTHR) { const int n = e >> 5, k0 = (e & 31) * 8, dir = n >> 7, part = (n >> 6) & 1, p = n & 63;
        float v[8];
#pragma unroll
        for (int t = 0; t < 8; ++t) { const int k = k0 + t, ip = k >> 4, h = k & 15, ee = dir == 0 ? 15 - ip : ip;
            const LAS float* a = apow + ((dir * 17 + ee) * 64 + p) * 2; const LAS float* b = bb + ((dir * 64 + p) * 16 + h) * 2;
            v[t] = part == 0 ? a[0] * b[0] - a[1] * b[1] : a[0] * b[1] + a[1] * b[0]; }
        v4u o; o.x = pk2(v[0], v[1]); o.y = pk2(v[2], v[3]); o.z = pk2(v[4], v[5]); o.w = pk2(v[6], v[7]);
        *(v4u*)(wsm + (size_t)n * 256 + k0) = o; }
}
__device__ __forceinline__ void p0b(Frame& F, const Args& AR) {
    unsigned char* ws = F.ws;
    const int gw = F.bid * NWAVES + F.wave, NGW = F.G * NWAVES;
    const int gt = F.bid * NTHR + F.tid, NGT = F.G * NTHR;
    {
        const float* modp = (const float*)(ws + WS_MODP); float* comb = (float*)(ws + WS_COMB); const float* ng = AR.in[I_NORMG];
        auto modval = [&](int l, int v, int j) { float s = AR.in[I_BMOD][l * MODW + j]; const float* q = modp + (size_t)(l * 3 + v) * MODW + j;
            for (int ch = 0; ch < MOD_CHUNKS; ++ch) s += q[(size_t)ch * DEPTH * 3 * MODW]; return s; };
        for (int e = gt; e < 13 * 3 * DM; e += NGT) { const int c = e % DM, v = (e / DM) % 3, idx = e / (3 * DM);
            float vg = 0.f, vs = 0.f, vh = 0.f;
            if (idx == 12) { vs = ng[c] * (1.0f + modval(0, v, 1 * DM + c)); vh = modval(0, v, c); }
            else { const int l = idx / 3, k = idx % 3;
                vg = (k == 1 ? 1.0f : 0.5f) * modval(l, v, (2 + 3 * k) * DM + c) * ng[(l * 6 + 1 + 2 * k) * DM + c];
                if (k < 2) { vs = ng[(l * 6 + 2 + 2 * k) * DM + c] * (1.0f + modval(l, v, (4 + 3 * k) * DM + c)); vh = modval(l, v, (3 + 3 * k) * DM + c); }
                else if (l < DEPTH - 1) { vs = ng[((l + 1) * 6) * DM + c] * (1.0f + modval(l + 1, v, 1 * DM + c)); vh = modval(l + 1, v, c); } }
            float* o = comb + ((size_t)(idx * 3 + v) * 3) * DM + c; o[0] = vg; o[DM] = vs; o[2 * DM] = vh; }
    }
    for (int it = F.bid; it < DEPTH * 32 * 2; it += F.G) ssm_build_mats(F, AR, it);
    __syncthreads();
    {
        LAS float* scr = (LAS float*)(F.lds + F.wave * TR_WAVE_BYTES);
        bf16* win_t = (bf16*)(ws + WS_WIN); const float* wf = (const float*)(ws + WS_WFOLD);
        for (int it = gw; it < CV_FOLD; it += NGW) { TrItem t; conv_decode(AR, ws, 0, CV_NOFOLD + it, t); f32x4 v[16]; tr_load(t, v, F.lane); tr_store(t, v, scr, F.lane); }
        (void)win_t; (void)wf;
    }
}
#ifndef NT_H
#define NT_H 1
#endif
#ifndef NT_X
#define NT_X 1
#endif
#ifndef XBF
#define XBF 1
#endif
#ifndef NORM_CUS
#define NORM_CUS 0
#endif
__device__ __forceinline__ void norm_phase(Frame& F, const Args& AR, bool first, bool has_y, int nsplit, const float* comb, float res_mul, bool write_h, bool write_out, int nrows = R) {
    if (NORM_CUS && F.bid >= NORM_CUS) return;
    const int gw = F.bid * NWAVES + F.wave, NGW = (NORM_CUS ? NORM_CUS : F.G) * NWAVES;
    float* X = (float*)(F.ws + WS_X); const bf16* Y = (const bf16*)(F.ws + WS_Y); bf16* H = (bf16*)(F.ws + WS_H);
#pragma unroll 1
    for (int r = gw; r < nrows; r += NGW) {
        const int v = r < SEQ ? 0 : (r < R_LAT ? 1 : 2);
        const float* cb = comb + (size_t)v * 3 * DM + 4 * F.lane;
        const float* xr = (first ? (r < R_LAT ? AR.in[I_X] + (size_t)r * DM : AR.in[I_CTX] + (size_t)(r - R_LAT) * DM) : X + (size_t)r * DM) + 4 * F.lane;
        f32x4 x[8], y[8], vg[8], vs[8], vh[8];
        if (XBF && !first) { const bf16* xb = (const bf16*)(F.ws + WS_X) + (size_t)r * DM + 4 * F.lane;
#pragma unroll
            for (int j = 0; j < 8; ++j) { const v2u w = __builtin_nontemporal_load((const v2u*)(xb + 256 * j)); x[j] = (f32x4){bflo(w.x), bfhi(w.x), bflo(w.y), bfhi(w.y)}; }
        } else {
#pragma unroll
        for (int j = 0; j < 8; ++j) x[j] = NT_X ? __builtin_nontemporal_load((const f32x4*)(xr + 256 * j)) : *(const f32x4*)(xr + 256 * j);
        }
        if (has_y) {
            if (r < R_LAT) {
#pragma unroll
                for (int j = 0; j < 8; ++j) { const v2u w = __builtin_nontemporal_load((const v2u*)(Y + (size_t)r * DM + 4 * F.lane + 256 * j)); y[j] = (f32x4){bflo(w.x), bfhi(w.x), bflo(w.y), bfhi(w.y)}; }
            } else {
                const float* yp = (const float*)(F.ws + WS_YP) + (size_t)(r - R_LAT) * DM + 4 * F.lane;
#pragma unroll
                for (int j = 0; j < 8; ++j) y[j] = __builtin_nontemporal_load((const f32x4*)(yp + 256 * j));
#pragma unroll 1
                for (int s = 1; s < nsplit; ++s) {
#pragma unroll
                    for (int j = 0; j < 8; ++j) y[j] += __builtin_nontemporal_load((const f32x4*)(yp + (size_t)s * R_CTX * DM + 256 * j)); }
            }
#pragma unroll
            for (int j = 0; j < 8; ++j) vg[j] = *(const f32x4*)(cb + 256 * j);
        }
        if (write_h) {
#pragma unroll
            for (int j = 0; j < 8; ++j) { vs[j] = *(const f32x4*)(cb + DM + 256 * j); vh[j] = *(const f32x4*)(cb + 2 * DM + 256 * j); }
        }
        if (has_y) {
            float ss = 0.f;
#pragma unroll
            for (int j = 0; j < 8; ++j) ss += (y[j].x * y[j].x + y[j].y * y[j].y) + (y[j].z * y[j].z + y[j].w * y[j].w);
            const float rs = rsqrtf(wave_sum(ss) * (1.0f / DM) + 1e-6f) * res_mul;
#pragma unroll
            for (int j = 0; j < 8; ++j) x[j] += vg[j] * (y[j] * rs);
        }
        if (has_y && !write_out) {
#pragma unroll
            for (int j = 0; j < 8; ++j) {
                if (XBF) { v2u o; o.x = pk2(x[j].x, x[j].y); o.y = pk2(x[j].z, x[j].w); __builtin_nontemporal_store(o, (v2u*)((bf16*)(F.ws + WS_X) + (size_t)r * DM + 4 * F.lane + 256 * j)); }
                else if (NT_X) __builtin_nontemporal_store(x[j], (f32x4*)(X + (size_t)r * DM + 4 * F.lane + 256 * j)); else *(f32x4*)(X + (size_t)r * DM + 4 * F.lane + 256 * j) = x[j]; }
        }
        if (write_out && r < R_LAT) {
#pragma unroll
            for (int j = 0; j < 8; ++j) *(f32x4*)(F.out + (size_t)r * DM + 4 * F.lane + 256 * j) = x[j];
        }
        if (write_h) {
            float ss = 0.f;
#pragma unroll
            for (int j = 0; j < 8; ++j) ss += (x[j].x * x[j].x + x[j].y * x[j].y) + (x[j].z * x[j].z + x[j].w * x[j].w);
            const float rs = rsqrtf(wave_sum(ss) * (1.0f / DM) + 1e-6f);
#pragma unroll
            for (int j = 0; j < 8; ++j) { const f32x4 hv = x[j] * rs * vs[j] + vh[j];
                v2u o; o.x = pk2(hv.x, hv.y); o.y = pk2(hv.z, hv.w); if (NT_H) __builtin_nontemporal_store(o, (v2u*)(H + (size_t)r * DM + 4 * F.lane + 256 * j)); else *(v2u*)(H + (size_t)r * DM + 4 * F.lane + 256 * j) = o; }
        }
    }
}

typedef short bf16x8v __attribute__((ext_vector_type(8)));
template <int K> __device__ __forceinline__ void wave_bfrags(const bf16* Bt, int kb, bf16x8v (&bfr)[8][2], int lane) {
    const int fr = lane & 15, fq = lane >> 4;
#pragma unroll
    for (int ks = 0; ks < 8; ++ks)
#pragma unroll
        for (int n = 0; n < 2; ++n) bfr[ks][n] = *(const bf16x8v*)(Bt + (size_t)(n * 16 + fr) * K + kb * 256 + ks * 32 + 8 * fq);
}
template <int K, int MT> __device__ __forceinline__ void wave_mma_batch(const LAS unsigned char* a_lds, int lda, int kb, const bf16x8v (&bfr)[8][2], f32x4 (&acc)[MT][2], int lane) {
    const int fr = lane & 15, fq = lane >> 4;
#pragma unroll
    for (int ks = 0; ks < 8; ++ks)
#pragma unroll
        for (int m = 0; m < MT; ++m) { const bf16x8v af = *(const LAS bf16x8v*)(a_lds + (m * 16 + fr) * lda + (kb * 256 + ks * 32 + 8 * fq) * 2);
#pragma unroll
            for (int n = 0; n < 2; ++n) acc[m][n] = __builtin_amdgcn_mfma_f32_16x16x32_bf16(bfr[ks][n], af, acc[m][n], 0, 0, 0); }
}
__device__ __forceinline__ void ssm_sgemm_item(Frame& F, const Args& AR, int l, int item) {
    constexpr int K = 256, LDA = K * 2 + 16, MT = 4, NROW = 64, SL_OFF = 36864, SLD = 260, EX_OFF = 104448;
    const int g = item & 31, rt = item >> 5, row0 = rt * 64;
    const bf16* P = (const bf16*)(F.ws + WS_P);
    LAS unsigned char* at = F.lds;
    LAS float* sl = (LAS float*)(F.lds + SL_OFF); LAS float* ex = (LAS float*)(F.lds + EX_OFF);
    const bf16* Bt = (const bf16*)(F.ws + WS_SSMWS) + (size_t)(l * 32 + g) * 256 * 256 + (size_t)(F.wave * 32) * K;
    bf16x8v b0[8][2];
    wave_bfrags<K>(Bt, 0, b0, F.lane);
    __syncthreads();
    for (int idx = F.tid; idx < NROW * 32; idx += NTHR) { const int piece = idx & 1, tok = (idx >> 1) & 15, row = idx >> 5, cr = row0 + row;
        v4u v = {0u, 0u, 0u, 0u}; if (cr < NCR) v = *(const v4u*)(P + (size_t)(cr * 16 + tok) * DIN + SSM_OFF + g * 16 + piece * 8);
        *(LAS v4u*)(at + row * LDA + (tok * 16 + piece * 8) * 2) = v; }
    __syncthreads();
    f32x4 acc[MT][2];
#pragma unroll
    for (int m = 0; m < MT; ++m)
#pragma unroll
        for (int n = 0; n < 2; ++n) acc[m][n] = (f32x4){0.f, 0.f, 0.f, 0.f};
    wave_mma_batch<K, MT>(at, LDA, 0, b0, acc, F.lane);
    { const int fr = F.lane & 15, fq = F.lane >> 4;
#pragma unroll
      for (int m = 0; m < MT; ++m)
#pragma unroll
        for (int n = 0; n < 2; ++n) *(LAS f32x4*)(sl + (m * 16 + fr) * SLD + F.wave * 32 + n * 16 + 4 * fq) = acc[m][n]; }
    __syncthreads();
    const int dir = F.wave & 1, cpos = F.wave >> 1, sub = dir ? 3 - cpos : cpos, p = F.lane;
    const f32x2 a = *(const f32x2*)((const float*)(F.ws + WS_A16) + ((size_t)((l * 2 + dir) * 32 + g) * 64 + p) * 2);
    float sr[16], si[16];
#pragma unroll
    for (int i = 0; i < 16; ++i) { const int row = sub * 16 + (dir ? 15 - i : i); sr[i] = sl[row * SLD + dir * 128 + p]; si[i] = sl[row * SLD + dir * 128 + 64 + p]; }
    float hr = 0.f, hi = 0.f;
#pragma unroll
    for (int i = 0; i < 16; ++i) { const float nr = a.x * hr - a.y * hi + sr[i], ni = a.x * hi + a.y * hr + si[i]; hr = nr; hi = ni; }
    ex[(F.wave * 64 + p) * 2] = hr; ex[(F.wave * 64 + p) * 2 + 1] = hi;
    float pr = a.x, pi = a.y;
#pragma unroll
    for (int i = 0; i < 4; ++i) { const float nr = pr * pr - pi * pi, ni = 2.0f * pr * pi; pr = nr; pi = ni; }
    __syncthreads();
    hr = 0.f; hi = 0.f;
    if (rt < 8) for (int c = 0; c < cpos; ++c) { const int ww = (c << 1) | dir; const float er = ex[(ww * 64 + p) * 2], ei = ex[(ww * 64 + p) * 2 + 1];
        const float nr = pr * hr - pi * hi + er, ni = pr * hi + pi * hr + ei; hr = nr; hi = ni; }
    const bool valid = rt < 8 || sub < 2;
    float* HL = (float*)(F.ws + WS_SSMS) + (size_t)g * 256 + dir * 128 + p;
#pragma unroll
    for (int i = 0; i < 16; ++i) { const int cr = row0 + sub * 16 + (dir ? 15 - i : i);
        if (valid) { HL[(size_t)cr * 8192] = hr; HL[(size_t)cr * 8192 + 64] = hi; }
        const float nr = a.x * hr - a.y * hi + sr[i], ni = a.x * hi + a.y * hr + si[i]; hr = nr; hi = ni; }
    float* ET = (float*)(F.ws + WS_ET) + (size_t)g * 256 + dir * 128 + p;
    if (rt < 8) { if (cpos == 3) { ET[(size_t)rt * 8192] = hr; ET[(size_t)rt * 8192 + 64] = hi; } }
    else if (sub < 2) { ET[(size_t)(8 + sub) * 8192] = hr; ET[(size_t)(8 + sub) * 8192 + 64] = hi; }
}
template <int PH, int MT> __device__ __forceinline__ void ssm_gemm_rows(Frame& F, const Args& AR, int l, int g, int row0) {
    static_assert(PH == 1, "Y phase only");
    constexpr int K = 512, LDA = K * 2 + 16, NROW = 16 * MT, HS_OFF = 100352;
    const bf16* P = (const bf16*)(F.ws + WS_P);
    LAS unsigned char* at = F.lds; LAS float* hs = (LAS float*)(F.lds + HS_OFF);
    const bf16* Bt = (const bf16*)(F.ws + WS_SSMWY) + (size_t)(l * 32 + g) * 256 * 512 + (size_t)(F.wave * 32) * K;
    const float* POW = (const float*)(F.ws + WS_POW);
    bf16x8v b0[8][2];
    wave_bfrags<K>(Bt, 0, b0, F.lane);
    __syncthreads();
    if (F.tid < 128) { const int dir = F.tid >> 6, p = F.tid & 63, t = row0 >> 6, b = t >> 2, i = t & 3;
        const float* ET = (const float*)(F.ws + WS_ET) + (size_t)g * 256 + dir * 128 + p;
        const f32x2 a64 = *(const f32x2*)(POW + ((((size_t)(l * 2 + dir) * 32 + g) * 65 + 64) * 64 + p) * 2);
        float hr = ET[(size_t)(8 + b) * 8192], hi = ET[(size_t)(8 + b) * 8192 + 64];
        if (dir == 0) { for (int j = 0; j < i; ++j) { const float er = ET[(size_t)(4 * b + j) * 8192], ei = ET[(size_t)(4 * b + j) * 8192 + 64];
                const float nr = a64.x * hr - a64.y * hi + er, ni = a64.x * hi + a64.y * hr + ei; hr = nr; hi = ni; } }
        else { for (int j = 3; j > i; --j) { const float er = ET[(size_t)(4 * b + j) * 8192], ei = ET[(size_t)(4 * b + j) * 8192 + 64];
                const float nr = a64.x * hr - a64.y * hi + er, ni = a64.x * hi + a64.y * hr + ei; hr = nr; hi = ni; } }
        hs[F.tid * 2] = hr; hs[F.tid * 2 + 1] = hi; }
    for (int idx = F.tid; idx < NROW * 32; idx += NTHR) { const int piece = idx & 1, tok = (idx >> 1) & 15, row = idx >> 5, cr = row0 + row;
        v4u v = {0u, 0u, 0u, 0u}; if (cr < NCR) v = *(const v4u*)(P + (size_t)(cr * 16 + tok) * DIN + SSM_OFF + g * 16 + piece * 8);
        *(LAS v4u*)(at + row * LDA + (tok * 16 + piece * 8) * 2) = v; }
    __syncthreads();
    { const float* HL = (const float*)(F.ws + WS_SSMS);
        for (int idx = F.tid; idx < NROW * 16; idx += NTHR) { const int oct = idx & 7, dir = (idx >> 3) & 1, row = idx >> 4, cr = row0 + row;
            const float* hl = HL + ((size_t)cr * 32 + g) * 256 + dir * 128 + oct * 8;
            f32x4 r0 = *(const f32x4*)hl, r1 = *(const f32x4*)(hl + 4), i0 = *(const f32x4*)(hl + 64), i1 = *(const f32x4*)(hl + 68);
            if (row < 64) { const int e = dir ? 63 - row : row;
                const float* pw = POW + ((((size_t)(l * 2 + dir) * 32 + g) * 65 + e) * 64 + oct * 8) * 2;
                const f32x4 w0 = *(const f32x4*)pw, w1 = *(const f32x4*)(pw + 4), w2 = *(const f32x4*)(pw + 8), w3 = *(const f32x4*)(pw + 12);
                const LAS float* hp = hs + (dir * 64 + oct * 8) * 2;
                const f32x4 h0 = *(const LAS f32x4*)hp, h1 = *(const LAS f32x4*)(hp + 4), h2 = *(const LAS f32x4*)(hp + 8), h3 = *(const LAS f32x4*)(hp + 12);
                r0.x += w0.x * h0.x - w0.y * h0.y; i0.x += w0.x * h0.y + w0.y * h0.x;  r0.y += w0.z * h0.z - w0.w * h0.w; i0.y += w0.z * h0.w + w0.w * h0.z;
                r0.z += w1.x * h1.x - w1.y * h1.y; i0.z += w1.x * h1.y + w1.y * h1.x;  r0.w += w1.z * h1.z - w1.w * h1.w; i0.w += w1.z * h1.w + w1.w * h1.z;
                r1.x += w2.x * h2.x - w2.y * h2.y; i1.x += w2.x * h2.y + w2.y * h2.x;  r1.y += w2.z * h2.z - w2.w * h2.w; i1.y += w2.z * h2.w + w2.w * h2.z;
                r1.z += w3.x * h3.x - w3.y * h3.y; i1.z += w3.x * h3.y + w3.y * h3.x;  r1.w += w3.z * h3.z - w3.w * h3.w; i1.w += w3.z * h3.w + w3.w * h3.z; }
            v4u vr, vi; vr.x = pk2(r0.x, r0.y); vr.y = pk2(r0.z, r0.w); vr.z = pk2(r1.x, r1.y); vr.w = pk2(r1.z, r1.w);
            vi.x = pk2(i0.x, i0.y); vi.y = pk2(i0.z, i0.w); vi.z = pk2(i1.x, i1.y); vi.w = pk2(i1.z, i1.w);
            *(LAS v4u*)(at + row * LDA + 512 + (dir * 128 + oct * 8) * 2) = vr; *(LAS v4u*)(at + row * LDA + 512 + (dir * 128 + 64 + oct * 8) * 2) = vi; } }
    __syncthreads();
    f32x4 acc[MT][2];
#pragma unroll
    for (int m = 0; m < MT; ++m)
#pragma unroll
        for (int n = 0; n < 2; ++n) acc[m][n] = (f32x4){0.f, 0.f, 0.f, 0.f};
    { bf16x8v b1[8][2]; wave_bfrags<K>(Bt, 1, b1, F.lane); wave_mma_batch<K, MT>(at, LDA, 0, b0, acc, F.lane); wave_mma_batch<K, MT>(at, LDA, 1, b1, acc, F.lane); }
    const int fr = F.lane & 15, fq = F.lane >> 4;
#pragma unroll
    for (int m = 0; m < MT; ++m) { const int cr = row0 + m * 16 + fr;
        if (cr < NCR) {
#pragma unroll
            for (int n = 0; n < 2; ++n) { const int col = F.wave * 32 + n * 16 + 4 * fq;
                const int i = col >> 4, hp = col & 15; float yv[4];
#pragma unroll
                for (int j = 0; j < 4; ++j) { const float y = acc[m][n][j]; const float z = 0.7978845608028654f * (y + 0.044715f * y * y * y);
                    const float th = 1.0f - 2.0f * __builtin_amdgcn_rcpf(1.0f + __expf(2.0f * z)); yv[j] = 0.5f * y * (1.0f + th); }
                v2u o; o.x = pk2(yv[0], yv[1]); o.y = pk2(yv[2], yv[3]);
                *(v2u*)((bf16*)(F.ws + WS_YG) + (size_t)(cr * 16 + i) * 512 + g * 16 + hp) = o; } } }
}
__device__ __forceinline__ void glu_item(Frame& F, const Args& AR, int l, int item) {
    constexpr int K = 512, LDA = K * 2 + 16, NROW = 68, MT = 5;
    const int half = item & 1, row0 = (item >> 1) * NROW;
    const bf16* YG = (const bf16*)(F.ws + WS_YG); bf16* CAT = (bf16*)(F.ws + WS_CAT);
    LAS unsigned char* at = F.lds;
    const int colw = half * 256 + F.wave * 32;
    const bf16* Bt = (const bf16*)(F.ws + WS_GLUW) + (size_t)l * 512 * 512 + (size_t)colw * K;
    bf16x8v b0[8][2];
    wave_bfrags<K>(Bt, 0, b0, F.lane);
    __syncthreads();
    for (int idx = F.tid; idx < 80 * 64; idx += NTHR) { const int pc = idx & 63, row = idx >> 6;
        v4u v = {0u, 0u, 0u, 0u}; if (row < NROW) v = *(const v4u*)(YG + (size_t)(row0 + row) * 512 + pc * 8);
        *(LAS v4u*)(at + row * LDA + pc * 16) = v; }
    __syncthreads();
    f32x4 acc[MT][2];
#pragma unroll
    for (int m = 0; m < MT; ++m)
#pragma unroll
        for (int n = 0; n < 2; ++n) acc[m][n] = (f32x4){0.f, 0.f, 0.f, 0.f};
    { bf16x8v b1[8][2]; wave_bfrags<K>(Bt, 1, b1, F.lane); wave_mma_batch<K, MT>(at, LDA, 0, b0, acc, F.lane); wave_mma_batch<K, MT>(at, LDA, 1, b1, acc, F.lane); }
    const int fr = F.lane & 15, fq = F.lane >> 4;
#pragma unroll
    for (int n = 0; n < 2; ++n) { const int col = colw + n * 16 + 4 * fq; const f32x4 bias = *(const f32x4*)(AR.in[I_GLUB] + l * 512 + col);
#pragma unroll
        for (int m = 0; m < MT; ++m) { const int row = m * 16 + fr;
            if (row < NROW) { const v2u yw = *(const LAS v2u*)(at + row * LDA + col * 2); const f32x4 z = acc[m][n] + bias;
                const float o0 = bflo(yw.x) * sigmoidf_(z.x), o1 = bfhi(yw.x) * sigmoidf_(z.y), o2 = bflo(yw.y) * sigmoidf_(z.z), o3 = bfhi(yw.y) * sigmoidf_(z.w);
                v2u o; o.x = pk2(o0, o1); o.y = pk2(o2, o3); *(v2u*)(CAT + (size_t)(row0 + row) * DM + 512 + col) = o; } } }
}
typedef float f32x16 __attribute__((ext_vector_type(16)));
constexpr int AT_ROW = 144, AT_KB = 64 * AT_ROW, AT_BUF = 2 * AT_KB;
__device__ __forceinline__ int crow16(int r, int hi) { return (r & 3) + 8 * (r >> 2) + 4 * hi; }
__device__ __forceinline__ void unpack8(const v4u w, float (&x)[8]) { x[0] = bflo(w.x); x[1] = bfhi(w.x); x[2] = bflo(w.y); x[3] = bfhi(w.y); x[4] = bflo(w.z); x[5] = bfhi(w.z); x[6] = bflo(w.w); x[7] = bfhi(w.w); }
__device__ __forceinline__ void attn_item_mfma(Frame& F, const Args& AR, int l, int item) {
    const bf16* P = (const bf16*)(F.ws + WS_P); bf16* CAT = (bf16*)(F.ws + WS_CAT); const float* rope = (const float*)(F.ws + WS_ROPE);
    const bool latent = item < 256;
    int b, kv, n, hq;
    if (latent) { hq = item & 1; n = (item >> 1) & 31; kv = (item >> 6) & 1; b = item >> 7; } else { const int c = item - 256; hq = c & 1; n = (c >> 1) & 1; kv = (c >> 2) & 1; b = c >> 3; }
    const int g = F.wave >> 1, wq = F.wave & 1, h = kv * 4 + g, r32 = F.lane & 31, hi = F.lane >> 5;
    constexpr float C2 = 0.125f * 1.4426950408889634f;
    const int qq = 32 * wq + r32;
    const int qpos = n * 128 + 64 * hq + qq;
    const int qrow = latent ? b * SEQ + qpos : R_LAT + b * CTXL + qpos;
    bf16x8v qf[4];
    {
        const bf16* qp = P + (size_t)qrow * DIN + Q_OFF + h * 64 + 8 * hi;
        float x[4][8];
#pragma unroll
        for (int ks = 0; ks < 4; ++ks) unpack8(*(const v4u*)(qp + 16 * ks), x[ks]);
        if (latent) {
#pragma unroll
            for (int part = 0; part < 2; ++part) { const int pos = part ? (qpos & 63) : (qpos >> 6);
#pragma unroll
                for (int t = 0; t < 8; ++t) { const f32x2 cs = *(const f32x2*)(rope + (pos * 16 + 8 * hi + t) * 2);
                    const float x1 = x[2 * part][t], x2 = x[2 * part + 1][t]; x[2 * part][t] = x1 * cs.x - x2 * cs.y; x[2 * part + 1][t] = x2 * cs.x + x1 * cs.y; } }
        }
#pragma unroll
        for (int ks = 0; ks < 4; ++ks) { v4u w; w.x = pk2(x[ks][0] * C2, x[ks][1] * C2); w.y = pk2(x[ks][2] * C2, x[ks][3] * C2); w.z = pk2(x[ks][4] * C2, x[ks][5] * C2); w.w = pk2(x[ks][6] * C2, x[ks][7] * C2);
            qf[ks] = __builtin_bit_cast(bf16x8v, w); }
    }
    float mrun = AR.in[I_SINK][l * 8 + h] * 1.4426950408889634f, lsum = hi == 0 ? 1.0f : 0.0f;
    f32x16 o[2];
#pragma unroll
    for (int db = 0; db < 2; ++db)
#pragma unroll
        for (int r = 0; r < 16; ++r) o[db][r] = 0.f;
    int tlo = hq, thi = hq + 4;
    if (latent) { if (n == 0 && tlo < 2) tlo = 2; if (n == 31 && thi > 3) thi = 3; } else { tlo = 0; thi = -1; }
    const int nloc = thi - tlo + 1, ntile = nloc + 4;
    const int sj = F.tid >> 3, sd0 = (F.tid & 7) * 8;
    v4u kw, kp, vw;
    { const bool lc = 0 < nloc; const int kp0 = lc ? 128 * (n - 1) + 64 * tlo : 0; const int krow = lc ? b * SEQ + kp0 + sj : R_LAT + b * CTXL + kp0 + sj;
      const bf16* kp_ = P + (size_t)krow * DIN + K_OFF + kv * 64; kw = *(const v4u*)(kp_ + sd0); kp = *(const v4u*)(kp_ + (sd0 ^ 16)); vw = *(const v4u*)(P + (size_t)krow * DIN + V_OFF + kv * 64 + sd0); }
    __syncthreads();
#pragma unroll 1
    for (int s = 0; s < ntile; ++s) {
        const bool local = s < nloc; const int kpos0 = local ? 128 * (n - 1) + 64 * (tlo + s) : 64 * (s - nloc);
        LAS unsigned char* kb_ = F.lds + (s & 1) * AT_BUF; LAS unsigned char* vb_ = kb_ + AT_KB;
        {
            float kk[8], kq[8], vv[8]; unpack8(kw, kk); unpack8(kp, kq); unpack8(vw, vv);
            if (local) { const int kpos = kpos0 + sj, part = sd0 >> 5, e0 = sd0 & 31; const bool firsth = e0 < 16; const int pp = part ? (kpos & 63) : (kpos >> 6);
#pragma unroll
                for (int t = 0; t < 8; ++t) { const f32x2 cs = *(const f32x2*)(rope + (pp * 16 + (e0 & 15) + t) * 2); kk[t] = firsth ? kk[t] * cs.x - kq[t] * cs.y : kk[t] * cs.x + kq[t] * cs.y; } }
            v4u w; w.x = pk2(kk[0], kk[1]); w.y = pk2(kk[2], kk[3]); w.z = pk2(kk[4], kk[5]); w.w = pk2(kk[6], kk[7]);
            *(LAS v4u*)(kb_ + sj * AT_ROW + sd0 * 2) = w;
#pragma unroll
            for (int t = 0; t < 8; ++t) *(LAS bf16*)(vb_ + (sd0 + t) * AT_ROW + sj * 2) = (bf16)f2bf(vv[t]);
        }
        __syncthreads();
        if (s + 1 < ntile) { const bool lc = s + 1 < nloc; const int kp0 = lc ? 128 * (n - 1) + 64 * (tlo + s + 1) : 64 * (s + 1 - nloc); const int krow = lc ? b * SEQ + kp0 + sj : R_LAT + b * CTXL + kp0 + sj;
            const bf16* kp_ = P + (size_t)krow * DIN + K_OFF + kv * 64; kw = *(const v4u*)(kp_ + sd0); kp = *(const v4u*)(kp_ + (sd0 ^ 16)); vw = *(const v4u*)(P + (size_t)krow * DIN + V_OFF + kv * 64 + sd0); }
        const int rel = local ? (tlo + s) - hq : 2;
        f32x16 st[2];
#pragma unroll
        for (int kb = 0; kb < 2; ++kb) {
#pragma unroll
            for (int r = 0; r < 16; ++r) st[kb][r] = 0.f;
#pragma unroll
            for (int ks = 0; ks < 4; ++ks) { const bf16x8v kf = *(const LAS bf16x8v*)(kb_ + (32 * kb + r32) * AT_ROW + (16 * ks + 8 * hi) * 2);
                st[kb] = __builtin_amdgcn_mfma_f32_32x32x16_bf16(kf, qf[ks], st[kb], 0, 0, 0); }
        }
        if (rel == 0 || rel == 4) {
#pragma unroll
            for (int kb = 0; kb < 2; ++kb)
#pragma unroll
                for (int r = 0; r < 16; ++r) { const int kk = 32 * kb + crow16(r, hi); const bool bad = rel == 0 ? kk < qq : kk > qq; st[kb][r] = bad ? -1e30f : st[kb][r]; } }
        float mx = st[0][0];
#pragma unroll
        for (int kb = 0; kb < 2; ++kb)
#pragma unroll
            for (int r = 0; r < 16; ++r) mx = fmaxf(mx, st[kb][r]);
        mx = fmaxf(mx, __shfl_xor(mx, 32));
        const float mnew = mx > mrun + 8.0f ? mx : mrun, corr = __builtin_amdgcn_exp2f(mrun - mnew);
        mrun = mnew;
        float ps = 0.f;
#pragma unroll
        for (int kb = 0; kb < 2; ++kb)
#pragma unroll
            for (int r = 0; r < 16; ++r) { st[kb][r] = __builtin_amdgcn_exp2f(st[kb][r] - mnew); ps += st[kb][r]; }
        lsum = lsum * corr + ps;
        if (__builtin_amdgcn_ballot_w64(corr != 1.0f) != 0ull) {
#pragma unroll
            for (int db = 0; db < 2; ++db)
#pragma unroll
                for (int r = 0; r < 16; ++r) o[db][r] *= corr; }
#pragma unroll
        for (int m = 0; m < 4; ++m) { const int kb = m >> 1, r0 = 8 * (m & 1); v4u pw;
            pw.x = pk2(st[kb][r0 + 0], st[kb][r0 + 1]); pw.y = pk2(st[kb][r0 + 2], st[kb][r0 + 3]); pw.z = pk2(st[kb][r0 + 4], st[kb][r0 + 5]); pw.w = pk2(st[kb][r0 + 6], st[kb][r0 + 7]);
            const bf16x8v pf = __builtin_bit_cast(bf16x8v, pw);
#pragma unroll
            for (int db = 0; db < 2; ++db) { const LAS unsigned char* vp = vb_ + (32 * db + r32) * AT_ROW + (16 * m + 4 * hi) * 2;
                const v2u lo = *(const LAS v2u*)vp, hh = *(const LAS v2u*)(vp + 16); const v4u w = {lo.x, lo.y, hh.x, hh.y};
                o[db] = __builtin_amdgcn_mfma_f32_32x32x16_bf16(__builtin_bit_cast(bf16x8v, w), pf, o[db], 0, 0, 0); } }
    }
    {
        const float lt = lsum + __shfl_xor(lsum, 32), inv = 1.0f / lt;
        bf16* op = CAT + (size_t)qrow * DM + h * 64;
#pragma unroll
        for (int db = 0; db < 2; ++db)
#pragma unroll
            for (int rq = 0; rq < 4; ++rq) { v2u w; w.x = pk2(o[db][4 * rq] * inv, o[db][4 * rq + 1] * inv); w.y = pk2(o[db][4 * rq + 2] * inv, o[db][4 * rq + 3] * inv);
                *(v2u*)(op + 32 * db + 8 * rq + 4 * hi) = w; }
    }
}
__device__ __forceinline__ void conv_tile_v1(Frame& F, const Args& AR, int l, int tile) {
    const bf16* P = (const bf16*)(F.ws + WS_P); bf16* CAT = (bf16*)(F.ws + WS_CAT);
    LAS float* hh = (LAS float*)F.lds;
    LAS float* red = hh + 47 * 512;
    const int c = F.tid;
    int base, t0, Ls;
    if (tile < R_LAT / 16) { const int b = tile / (SEQ / 16); t0 = (tile % (SEQ / 16)) * 16; base = b * SEQ; Ls = SEQ; }
    else { const int q = tile - R_LAT / 16; const int b = q / (CTXL / 16); t0 = (q % (CTXL / 16)) * 16; base = R_LAT + b * CTXL; Ls = CTXL; }
    __syncthreads();
#pragma unroll 1
    for (int kb = 0; kb < 6; kb += 3) {
        v4u vv[3], gg[3];
#pragma unroll
        for (int k = 0; k < 3; ++k) { const int q = F.tid + NTHR * (kb + k), i = q >> 6, c8 = (q & 63) * 8, t = t0 - 15 + i;
            vv[k] = (v4u){0u, 0u, 0u, 0u}; gg[k] = vv[k];
            if (i < 46 && t >= 0 && t < Ls) { const bf16* pr = P + (size_t)(base + t) * DIN + CONV_OFF + c8; vv[k] = *(const v4u*)pr; gg[k] = *(const v4u*)(pr + 512); } }
#pragma unroll
        for (int k = 0; k < 3; ++k) { const int q = F.tid + NTHR * (kb + k), i = q >> 6, c8 = (q & 63) * 8;
            if (i < 46) { float a[8], g[8]; unpack8(vv[k], a); unpack8(gg[k], g);
#pragma unroll
                for (int e = 0; e < 8; ++e) a[e] *= sigmoidf_(g[e]);
                *(LAS f32x4*)(hh + i * 512 + c8) = (f32x4){a[0], a[1], a[2], a[3]}; *(LAS f32x4*)(hh + i * 512 + c8 + 4) = (f32x4){a[4], a[5], a[6], a[7]}; } }
    }
    hh[46 * 512 + c] = 0.f;
    const float cb = AR.in[I_CONVB][l * 512 + c];
    __syncthreads();
    float ov[16];
#pragma unroll
    for (int i = 0; i < 16; ++i) ov[i] = cb;
    {
        const float* wp = AR.in[I_CONVW] + (size_t)l * 31 * 512 + c;
        float wc[8];
#pragma unroll
        for (int t = 0; t < 8; ++t) wc[t] = wp[t * 512];
#pragma unroll 1
        for (int kb = 0; kb < 4; ++kb) {
            float wn[8];
#pragma unroll
            for (int t = 0; t < 8; ++t) { const int k = 8 * (kb + 1) + t; wn[t] = wp[(k < 31 ? k : 30) * 512]; if (k >= 31) wn[t] = 0.f; }
            const LAS float* hb = hh + (8 * kb) * 512 + c;
            float hv[23];
#pragma unroll
            for (int j = 0; j < 23; ++j) hv[j] = hb[j * 512];
#pragma unroll
            for (int t = 0; t < 8; ++t)
#pragma unroll
                for (int i = 0; i < 16; ++i) ov[i] += hv[i + t] * wc[t];
#pragma unroll
            for (int t = 0; t < 8; ++t) wc[t] = wn[t];
        }
    }
    __syncthreads();
#pragma unroll
    for (int i = 0; i < 16; ++i) hh[i * 512 + c] = ov[i];
    __syncthreads();
    {
        float a0[8], a1[8]; float s0 = 0.f, s1 = 0.f;
#pragma unroll
        for (int j = 0; j < 8; ++j) { a0[j] = hh[(2 * F.wave) * 512 + F.lane + 64 * j]; a1[j] = hh[(2 * F.wave + 1) * 512 + F.lane + 64 * j]; s0 += a0[j]; s1 += a1[j]; }
        const float m0 = wave_sum(s0) * (1.0f / 512.0f), m1 = wave_sum(s1) * (1.0f / 512.0f);
        float q0 = 0.f, q1 = 0.f;
#pragma unroll
        for (int j = 0; j < 8; ++j) { const float d0 = a0[j] - m0, d1 = a1[j] - m1; q0 += d0 * d0; q1 += d1 * d1; }
        q0 = wave_sum(q0); q1 = wave_sum(q1);
        if (F.lane == 0) { red[4 * F.wave] = m0; red[4 * F.wave + 1] = rsqrtf(q0 * (1.0f / 512.0f) + 1e-5f); red[4 * F.wave + 2] = m1; red[4 * F.wave + 3] = rsqrtf(q1 * (1.0f / 512.0f) + 1e-5f); }
    }
    __syncthreads();
    const float lg = AR.in[I_LNG][l * 512 + c], lb = AR.in[I_LNB][l * 512 + c];
#pragma unroll
    for (int i = 0; i < 16; ++i) { const float mean = red[2 * i], rstd = red[2 * i + 1];
        const float y = (ov[i] - mean) * rstd * lg + lb;
        CAT[(size_t)(base + t0 + i) * DM + 1024 + c] = (bf16)f2bf(y * sigmoidf_(y)); }
}
__device__ __forceinline__ f32x2 cmul(f32x2 a, f32x2 b) { return (f32x2){a.x * b.x - a.y * b.y, a.x * b.y + a.y * b.x}; }
__device__ __forceinline__ void dft4(f32x2& a, f32x2& b, f32x2& c, f32x2& d) {
    const f32x2 s0 = a + c, s1 = a - c, s2 = b + d, s3 = b - d;
    a = s0 + s2; c = s0 - s2; b = (f32x2){s1.x + s3.y, s1.y - s3.x}; d = (f32x2){s1.x - s3.y, s1.y + s3.x};
}
__device__ __forceinline__ void dft16(f32x2 (&x)[16]) {
#pragma unroll
    for (int q0 = 0; q0 < 4; ++q0) dft4(x[q0], x[4 + q0], x[8 + q0], x[12 + q0]);
    const f32x2 w1 = {0.9238795325112867f, -0.3826834323650898f}, w2 = {0.7071067811865476f, -0.7071067811865476f}, w3 = {0.3826834323650898f, -0.9238795325112867f},
                w6 = {-0.7071067811865476f, -0.7071067811865476f}, w9 = {-0.9238795325112867f, 0.3826834323650898f};
    x[5] = cmul(x[5], w1); x[6] = cmul(x[6], w2); x[7] = cmul(x[7], w3);
    x[9] = cmul(x[9], w2); x[10] = (f32x2){x[10].y, -x[10].x}; x[11] = cmul(x[11], w6);
    x[13] = cmul(x[13], w3); x[14] = cmul(x[14], w6); x[15] = cmul(x[15], w9);
#pragma unroll
    for (int p1 = 0; p1 < 4; ++p1) dft4(x[4 * p1], x[4 * p1 + 1], x[4 * p1 + 2], x[4 * p1 + 3]);
}
template <int LOG2N> __device__ __forceinline__ void fft_item(Frame& F, const Args& AR, int item) {
    constexpr int N = 1 << LOG2N, TP = N / 16, PP = NTHR / TP, NST = LOG2N / 4, SLOTS = N + N / 16;
    const bf16* P = (const bf16*)(F.ws + WS_P); bf16* CAT = (bf16*)(F.ws + WS_CAT); const f32x2* twg = (const f32x2*)(F.ws + WS_TW);
    const int pr = F.tid / TP, j = F.tid % TP;
    int b, h, mA;
    if (LOG2N == 12) { const int grp = item & 15; h = (item >> 4) & 3; b = item >> 6; mA = 4 * grp + 2 * pr; } else { h = item & 3; b = item >> 2; mA = 2 * pr; }
    const int rbase = (LOG2N == 12) ? b * SEQ : R_LAT + b * CTXL;
    LAS f32x2* bufA = (LAS f32x2*)F.lds + (size_t)(2 * pr) * SLOTS; LAS f32x2* bufB = bufA + SLOTS;
    const float norm = (LOG2N == 12) ? 0.001381067932004975f : 0.005524271728019903f;
    f32x2 xa[16], xb[16];
    {
        const bf16* src = P + (size_t)(rbase + j) * DIN + FFT_OFF + 128 * h + 2 * mA;
#pragma unroll
        for (int q = 0; q < 16; ++q) { const v2u w = *(const v2u*)(src + (size_t)(TP * q) * DIN); xa[q] = (f32x2){bflo(w.x), bfhi(w.x)}; xb[q] = (f32x2){bflo(w.y), bfhi(w.y)}; }
        dft16(xa); dft16(xb);
    }
    __syncthreads();
#pragma unroll
    for (int st = 1; st < NST; ++st) {
        const int Ns0 = 1 << (4 * (st - 1));
        { const int k = j & (Ns0 - 1), o0 = (j - k) * 16 + k;
#pragma unroll
          for (int p1 = 0; p1 < 4; ++p1)
#pragma unroll
              for (int p0 = 0; p0 < 4; ++p0) { const int idx = o0 + (p1 + 4 * p0) * Ns0, s = idx + (idx >> 4); bufA[s] = xa[4 * p1 + p0]; bufB[s] = xb[4 * p1 + p0]; } }
        __syncthreads();
        const int Ns = Ns0 * 16, k = j & (Ns - 1);
#pragma unroll
        for (int q = 0; q < 16; ++q) { const int idx = j + TP * q, s = idx + (idx >> 4); xa[q] = bufA[s]; xb[q] = bufB[s]; }
        const f32x2 w1 = twg[k * (256 / Ns)]; f32x2 w = w1;
#pragma unroll
        for (int q = 1; q < 16; ++q) { xa[q] = cmul(xa[q], w); xb[q] = cmul(xb[q], w); w = cmul(w, w1); }
        dft16(xa); dft16(xb);
        __syncthreads();
    }
    const bool special = (mA == 0);
    if (LOG2N == 8 || (item & 15) == 0) {
        if (special) {
#pragma unroll
            for (int p1 = 0; p1 < 4; ++p1)
#pragma unroll
                for (int p0 = 0; p0 < 4; ++p0) { const int idx = j + TP * (p1 + 4 * p0); bufA[idx + (idx >> 4)] = xa[4 * p1 + p0]; } }
        __syncthreads();
        if (special) {
#pragma unroll
            for (int p1 = 0; p1 < 4; ++p1)
#pragma unroll
                for (int p0 = 0; p0 < 4; ++p0) { const int idx = j + TP * (p1 + 4 * p0), mi = (N - idx) & (N - 1); const f32x2 zr = bufA[mi + (mi >> 4)], z = xa[4 * p1 + p0];
                    xa[4 * p1 + p0] = (f32x2){(z.x + zr.x) * 0.5f, (z.y + zr.y) * 0.5f}; } }
        __syncthreads();
    }
#pragma unroll
    for (int p1 = 0; p1 < 4; ++p1)
#pragma unroll
        for (int p0 = 0; p0 < 4; ++p0) { const int idx = j + TP * (p1 + 4 * p0), mi = (N - idx) & (N - 1); const f32x2 za = xa[4 * p1 + p0], zb = xb[4 * p1 + p0];
            bf16* orow = CAT + (size_t)(rbase + idx) * DM + 1536 + 128 * h; bf16* mrow = CAT + (size_t)(rbase + mi) * DM + 1536 + 128 * h;
            if (special) { orow[0] = (bf16)f2bf(za.x * norm); orow[64] = (bf16)f2bf(za.y * norm); orow[1] = (bf16)f2bf(zb.x * norm); mrow[127] = (bf16)f2bf(zb.x * norm); }
            else { *(unsigned*)(orow + mA) = pk2(za.x * norm, zb.x * norm); mrow[128 - mA] = (bf16)f2bf(za.x * norm); mrow[127 - mA] = (bf16)f2bf(zb.x * norm); } }
}
#ifndef UP_ALIGN
#define UP_ALIGN true
#endif
#ifndef UP_SP2
#define UP_SP2 true
#endif

#ifndef NLAYER_RUN
#define NLAYER_RUN DEPTH
#endif
constexpr int N_PRO = 3, PH_PER_LAYER = 12, N_PHASES = N_PRO + DEPTH * PH_PER_LAYER;

__device__ __forceinline__ void ffn_up(Frame& F, int lf, int skip_epi) {
    pg8::Gemm g{(const bf16*)(F.ws + WS_H), (const bf16*)(F.ws + WS_WI) + (size_t)lf * 2 * DFF * DM, R, 2 * DFF, DM}; pg8::StaticOrderT<R, 2 * DFF, DM> S; S.init(F.G, F.bid);
    pg8::EpiSwiglu E{(bf16*)(F.ws + WS_ACT), DFF, skip_epi};
    pg8::gemm_phase<pg8::EpiSwiglu, pg8::StaticOrderT<R, 2 * DFF, DM>, UP_ALIGN, UP_SP2, DM>(F.lds, g, S, E);
}
template <int K, int NS> __device__ __forceinline__ void gemm_to_y(Frame& F, const bf16* A, const bf16* Bt, bool with_ctx = true) {
    pg8::Gemm g{A, Bt, R, DM, K}; pg8::SplitTailOrder<K, NS> S; S.init(F.G, F.bid, with_ctx);
    pg8::EpiYSplit E{(bf16*)(F.ws + WS_Y), (float*)(F.ws + WS_YP), DM};
    pg8::gemm_phase<pg8::EpiYSplit, pg8::SplitTailOrder<K, NS>, true, true, K>(F.lds, g, S, E);
}

__global__ void __launch_bounds__(NTHR, 2) fwd_kernel(Args args) {
    extern __shared__ __attribute__((aligned(16))) unsigned char lds_raw[];
    Frame F;
    F.lds = (LAS unsigned char*)lds_raw;
    F.tid = threadIdx.x; F.lane = F.tid & 63; F.wave = __builtin_amdgcn_readfirstlane(F.tid >> 6);
    F.G = gridDim.x; F.bid = blockIdx.x;
    F.out = args.out; F.ws = args.ws;
    volatile LAS unsigned* MISC = (volatile LAS unsigned*)(F.lds + MISC_OFF);
    if (F.tid < 32) MISC[F.tid] = 0u;
    __syncthreads();
    unsigned* ctl = (unsigned*)(F.ws + WS_CTL);
#if MK_PER_PHASE
    XcdBarrier bar; bar.bar = ctl + CW_BAR; bar.x = 0; bar.st = nullptr;
#define GRID_BAR() do { } while (0)
#else
    XcdBarrier bar = xcd_barrier_post(ctl + CW_BAR, MISC + 8);
#define GRID_BAR() xcd_barrier(bar)
#endif
    const int lo = args.ph_lo, hi = args.ph_hi;
    int ph = 0;
#ifndef BG_CONV
#define BG_CONV 1
#endif
#ifndef PROBE_SKIPEPI
#define PROBE_SKIPEPI 0
#endif
#ifndef PROBE_DUP
#define PROBE_DUP 0
#endif
#define PHASE(id, ...) if (ph >= lo && ph < hi) { { int t_ = threadIdx.x; asm volatile("" : "+v"(t_)); F.tid = t_; F.lane = t_ & 63; F.wave = __builtin_amdgcn_readfirstlane(t_ >> 6); } \
        { const int rep = 0; (void)rep; __VA_ARGS__; } if (PROBE_DUP != 0 && PROBE_DUP == (id)) { GRID_BAR(); { const int rep = 1; (void)rep; __VA_ARGS__; } } if (ph + 1 < hi) GRID_BAR(); } ++ph;

    PHASE(5, p0a(F, args))
    PHASE(10, p0b(F, args))
    const float* COMB = (const float*)(F.ws + WS_COMB);
    PHASE(0, norm_phase(F, args, true, false, 0, COMB + (size_t)12 * 9 * DM, 1.0f, true, false))

#pragma unroll 1
    for (int l = 0; l < NLAYER_RUN; ++l) {
        PHASE(1, { ffn_up(F, l * 2 + 0, (PROBE_SKIPEPI && rep && lo == 0) ? 1 : 0); if (BG_CONV && l < DEPTH - 1) bg_site(F, args, l + 1, BGB_UP1, 216, BG_UP); })
        PHASE(2, { gemm_to_y<DFF, 11>(F, (const bf16*)(F.ws + WS_ACT), (const bf16*)(F.ws + WS_WO) + (size_t)(l * 2 + 0) * DM * DFF); if (BG_CONV && l < DEPTH - 1) bg_site(F, args, l + 1, BGB_DN1, 176, BG_DN); })
        PHASE(11, norm_phase(F, args, l == 0, true, 11, COMB + (size_t)(l * 3 + 0) * 9 * DM, rep ? 0.0f : 1.0f, true, false))
        PHASE(3, {
            pg8::Gemm g{(const bf16*)(F.ws + WS_H), (const bf16*)(F.ws + WS_WIN) + (size_t)l * DIN * DM, R, DIN, DM}; pg8::StaticOrderT<R, DIN, DM> S; S.init(F.G, F.bid);
            pg8::EpiBf16<0> E{(bf16*)(F.ws + WS_P), DIN, nullptr, 0, 0, 1.f};
            pg8::gemm_phase<pg8::EpiBf16<0>, pg8::StaticOrderT<R, DIN, DM>, true, true, DM>(F.lds, g, S, E);
            if (BG_CONV && l < DEPTH - 1) bg_site(F, args, l + 1, BGB_IN, 118, BG_IN);
        })
        PHASE(6, {
            constexpr int W_ATT = 272, W_CFFT = W_ATT + 8, W_FFT = W_CFFT + 128, W_CONV = W_FFT + R / 16, W_SG = W_CONV + 32 * 9, W_END = W_SG;
            unsigned* qhead = ctl + CW_QUEUE + 64 * (l + 4 * rep);
            int it = F.bid;
            unsigned nxt = 0u;
            if (F.tid == 0) nxt = __hip_atomic_fetch_add(qhead, 1u, __ATOMIC_RELAXED, __HIP_MEMORY_SCOPE_AGENT) + (unsigned)F.G;
            while (it < W_END) {
                { int t_ = threadIdx.x; asm volatile("" : "+v"(t_)); F.tid = t_; F.lane = t_ & 63; F.wave = __builtin_amdgcn_readfirstlane(t_ >> 6); }
                if (it < W_ATT) { _Pragma("unroll 1") for (int rr = 0; rr < (PROBE_DUP == 61 ? 2 : 1); ++rr) attn_item_mfma(F, args, l, it); }
                else if (it < W_CFFT) fft_item<8>(F, args, it - W_ATT);
                else if (it < W_FFT) { _Pragma("unroll 1") for (int rr = 0; rr < (PROBE_DUP == 62 ? 2 : 1); ++rr) fft_item<12>(F, args, it - W_CFFT); }
                else if (it < W_CONV) { _Pragma("unroll 1") for (int rr = 0; rr < (PROBE_DUP == 63 ? 2 : 1); ++rr) conv_tile_v1(F, args, l, it - W_FFT); }
                else { ssm_sgemm_item(F, args, l, it - W_CONV); if (PROBE_DUP == 64) ssm_sgemm_item(F, args, l, it - W_CONV); }
                if (threadIdx.x == 0) MISC[0] = nxt;
                __syncthreads();
                it = __builtin_amdgcn_readfirstlane((int)MISC[0]);
                if (threadIdx.x == 0 && it < W_END) nxt = __hip_atomic_fetch_add(qhead, 1u, __ATOMIC_RELAXED, __HIP_MEMORY_SCOPE_AGENT) + (unsigned)F.G;
            }
            __syncthreads();
        })
        PHASE(8, {
            for (int it = F.bid; it < 32 * 8; it += F.G) {
                const int g = it & 31, rt = it >> 5;
                if (rt < 7) ssm_gemm_rows<1, 4>(F, args, l, g, rt * 64); else ssm_gemm_rows<1, 6>(F, args, l, g, 448);
            }
            __syncthreads();
        })
        PHASE(9, {
            for (int it = F.bid; it < 256; it += F.G) glu_item(F, args, l, it);
            __syncthreads();
        })
        PHASE(4, { gemm_to_y<DM, 4>(F, (const bf16*)(F.ws + WS_CAT), (const bf16*)(F.ws + WS_WOUT) + (size_t)l * DM * DM, l < DEPTH - 1); if (BG_CONV && l < DEPTH - 1) bg_site(F, args, l + 1, BGB_OUT, 64, BG_OUT); })
        PHASE(11, norm_phase(F, args, false, true, 4, COMB + (size_t)(l * 3 + 1) * 9 * DM, rep ? 0.0f : 1.0f, true, false, l < DEPTH - 1 ? R : R_LAT))
        PHASE(1, { ffn_up(F, l * 2 + 1, (PROBE_SKIPEPI && rep && lo == 0) ? 1 : 0); if (BG_CONV && l < DEPTH - 1) bg_site(F, args, l + 1, BGB_UP2, 216, BG_UP); })
        PHASE(2, { gemm_to_y<DFF, 11>(F, (const bf16*)(F.ws + WS_ACT), (const bf16*)(F.ws + WS_WO) + (size_t)(l * 2 + 1) * DM * DFF, l < DEPTH - 1); if (BG_CONV && l < DEPTH - 1) bg_site(F, args, l + 1, BGB_DN2, 176, BG_DN); })
        PHASE(11, {
            const bool last = (l == DEPTH - 1);
            if (BG_CONV && !last) bg_drain(F, args, l + 1);
            norm_phase(F, args, false, true, 11, COMB + (size_t)(l * 3 + 2) * 9 * DM, rep ? 0.0f : 1.0f, !last, last, last ? R_LAT : R);
        })
#ifdef PROBE_BARS
        if (l < DEPTH - 1) { _Pragma("unroll 1") for (int q = 0; q < PROBE_BARS; ++q) GRID_BAR(); }
#endif
    }
}

extern "C" void kernel_launch(void* const* d_in, const int* in_sizes, int n_in, void* d_out, int out_size, void* d_ws, size_t ws_size, hipStream_t stream) {
    static int grid = 0;
    if (grid == 0) {
        if (n_in != 26 || in_sizes[0] != R_LAT * DM || out_size != R_LAT * DM || ws_size < WS_END) {
            fprintf(stderr, "kernel_launch: unexpected shapes: n_in %d in0 %d out %d ws %zu (need %zu)\n", n_in, n_in > 0 ? in_sizes[0] : -1, out_size, ws_size, (size_t)WS_END); grid = -1; return; }
        int dev = 0, cus = 0, per_cu = 0;
        if (hipGetDevice(&dev) != hipSuccess || hipDeviceGetAttribute(&cus, hipDeviceAttributeMultiprocessorCount, dev) != hipSuccess) { fprintf(stderr, "kernel_launch: device query failed\n"); grid = -1; return; }
        if (hipFuncSetAttribute((const void*)fwd_kernel, hipFuncAttributeMaxDynamicSharedMemorySize, LDS_BYTES) != hipSuccess) { fprintf(stderr, "kernel_launch: hipFuncSetAttribute failed\n"); grid = -1; return; }
        if (hipOccupancyMaxActiveBlocksPerMultiprocessor(&per_cu, (const void*)fwd_kernel, NTHR, LDS_BYTES) != hipSuccess || per_cu < 1)
            fprintf(stderr, "kernel_launch: note: occupancy query reports %d workgroups per CU\n", per_cu);
        (void)hipGetLastError();
        grid = cus;
    }
    if (grid < 0) return;
    if (hipMemsetAsync((char*)d_ws + WS_CTL, 0, CTL_ZERO_BYTES, stream) != hipSuccess) { fprintf(stderr, "kernel_launch: memset failed\n"); return; }
    Args a{};
    for (int i = 0; i < 26; ++i) a.in[i] = (const float*)d_in[i];
    a.out = (float*)d_out; a.ws = (unsigned char*)d_ws;
#if MK_PER_PHASE
    for (int p = 0; p < N_PHASES; ++p) { a.ph_lo = p; a.ph_hi = p + 1; hipLaunchKernelGGL(fwd_kernel, dim3(grid), dim3(NTHR), LDS_BYTES, stream, a); }
#else
    a.ph_lo = 0; a.ph_hi = N_PHASES;
    hipLaunchKernelGGL(fwd_kernel, dim3(grid), dim3(NTHR), LDS_BYTES, stream, a);
#endif
    const hipError_t le = hipPeekAtLastError();
    if (le != hipSuccess) fprintf(stderr, "kernel_launch: launch failed: %s\n", hipGetErrorName(le));
}
```
